# Optimizing an MI355X kernel written in HIP

```python
import jax, jax.numpy as jnp
from jax import lax
import numpy as np

D_MODEL = 1024
BATCH = 4
SEQ = 8192
DEPTH = 4

MLA_HEADS = 4
MLA_Q_LORA = 384
MLA_KV_LORA = 256
MLA_NOPE_DIM = 128
MLA_ROPE_DIM = 64
MLA_V_DIM = 128
MLA_WIDTH = MLA_HEADS * MLA_V_DIM
ROPE_THETA = 10000.0
Q_BLOCK = 128
MLSTM_HEADS = 4
MLSTM_HEAD_DIM = 64
MLSTM_WIDTH = MLSTM_HEADS * MLSTM_HEAD_DIM
MLSTM_CONV = 5
MLSTM_CHUNK = 64
FNET_GROUPS = 4
FNET_GROUP_DIM = 64
FNET_WIDTH = FNET_GROUPS * FNET_GROUP_DIM
MIX_WIDTH = MLA_WIDTH + MLSTM_WIDTH + FNET_WIDTH
IN_SPLITS = (MLA_Q_LORA, MLA_KV_LORA, MLA_ROPE_DIM, MLSTM_WIDTH, MLSTM_WIDTH, MLSTM_WIDTH, 4 * MLSTM_HEADS, FNET_WIDTH)
D_IN = MLA_Q_LORA + MLA_KV_LORA + MLA_ROPE_DIM + 3 * MLSTM_WIDTH + 4 * MLSTM_HEADS + FNET_WIDTH
D_FF = 2816
PLE_DIM = 256
EPS = 1e-6

kernel_name = 'hybrid_mla_mlstm_fnet_macaron_encoder'


def rmsnorm(x, g):
    xf = x.astype(jnp.float32)
    y = xf * lax.rsqrt(jnp.mean(xf * xf, axis=-1, keepdims=True) + EPS)
    return (y * g.astype(jnp.float32)).astype(x.dtype)


def swiglu(x, w_gate, w_up, w_down):
    return (jax.nn.silu(x @ w_gate) * (x @ w_up)) @ w_down


def split_cols(z, sizes):
    offs = [int(o) for o in np.cumsum(sizes)[:-1]]
    return jnp.split(z, offs, axis=-1)


def rope_tables(positions):
    inv = 1.0 / (ROPE_THETA ** (jnp.arange(0, MLA_ROPE_DIM, 2, dtype=jnp.float32) / MLA_ROPE_DIM))
    ang = positions.astype(jnp.float32)[..., None] * inv
    return jnp.cos(ang), jnp.sin(ang)


def apply_rope(x, cos, sin):
    xf = x.astype(jnp.float32)
    x1, x2 = jnp.split(xf, 2, axis=-1)
    out = jnp.concatenate([x1 * cos - x2 * sin, x2 * cos + x1 * sin], axis=-1)
    return out.astype(x.dtype)


def mla_mixer(c_q, c_kv, k_rope, cos, sin, q_norm, w_uq, kv_norm, w_ukv):
    B, S, _ = c_q.shape
    q = (rmsnorm(c_q, q_norm) @ w_uq).reshape(B, S, MLA_HEADS, MLA_NOPE_DIM + MLA_ROPE_DIM)
    q_nope, q_rope = q[..., :MLA_NOPE_DIM], q[..., MLA_NOPE_DIM:]
    q_rope = apply_rope(q_rope, cos[:, :, None, :], sin[:, :, None, :])
    kv = (rmsnorm(c_kv, kv_norm) @ w_ukv).reshape(B, S, MLA_HEADS, MLA_NOPE_DIM + MLA_V_DIM)
    k_nope, v = kv[..., :MLA_NOPE_DIM], kv[..., MLA_NOPE_DIM:]
    k_rope = apply_rope(k_rope, cos, sin)
    scale = (MLA_NOPE_DIM + MLA_ROPE_DIM) ** -0.5
    nb = S // Q_BLOCK

    def attend(args):
        qn, qr = args
        s = jnp.einsum('bqhd,bkhd->bhqk', qn, k_nope) + jnp.einsum('bqhr,bkr->bhqk', qr, k_rope)
        pr = jax.nn.softmax(s.astype(jnp.float32) * scale, axis=-1).astype(v.dtype)
        return jnp.einsum('bhqk,bkhd->bqhd', pr, v)

    qn_b = jnp.moveaxis(q_nope.reshape(B, nb, Q_BLOCK, MLA_HEADS, MLA_NOPE_DIM), 1, 0)
    qr_b = jnp.moveaxis(q_rope.reshape(B, nb, Q_BLOCK, MLA_HEADS, MLA_ROPE_DIM), 1, 0)
    o = lax.map(attend, (qn_b, qr_b))
    return jnp.moveaxis(o, 0, 1).reshape(B, S, MLA_WIDTH)


def mlstm_chunkwise(q, k, v, i_pre, f_pre):
    B, H, S, d = q.shape
    L = MLSTM_CHUNK
    nc = S // L
    q = q * d ** -0.5
    lf = jax.nn.log_sigmoid(f_pre)
    causal = jnp.tril(jnp.ones((L, L), dtype=bool))

    def chunks(t):
        return jnp.moveaxis(t.reshape((B, H, nc, L) + t.shape[3:]), 2, 0)

    def step(carry, xs):
        C, n, m = carry
        qc, kc, vc, ic, lfc = xs
        b = jnp.cumsum(lfc, axis=-1)
        D = jnp.where(causal, b[..., :, None] - b[..., None, :] + ic[..., None, :], -jnp.inf)
        m_inter = b + m[..., None]
        m_t = jnp.maximum(m_inter, jnp.max(D, axis=-1))
        w_intra = jnp.exp(D - m_t[..., None])
        w_state = jnp.exp(m_inter - m_t)
        s = jnp.einsum('bhtd,bhsd->bhts', qc, kc) * w_intra
        numer = jnp.einsum('bhts,bhsd->bhtd', s, vc) + w_state[..., None] * jnp.einsum('bhvk,bhtk->bhtv', C, qc)
        denom = jnp.sum(s, axis=-1) + w_state * jnp.einsum('bhk,bhtk->bht', n, qc)
        h = numer / jnp.maximum(jnp.abs(denom), jnp.exp(-m_t))[..., None]
        bL = b[..., -1]
        lw = bL[..., None] - b + ic
        m_new = jnp.maximum(bL + m, jnp.max(lw, axis=-1))
        ws = jnp.exp(lw - m_new[..., None])
        dec = jnp.exp(bL + m - m_new)
        C = dec[..., None, None] * C + jnp.einsum('bhs,bhsv,bhsk->bhvk', ws, vc, kc)
        n = dec[..., None] * n + jnp.einsum('bhs,bhsk->bhk', ws, kc)
        return (C, n, m_new), h

    init = (jnp.zeros((B, H, d, d), jnp.float32), jnp.zeros((B, H, d), jnp.float32), jnp.zeros((B, H), jnp.float32))
    _, h = lax.scan(step, init, (chunks(q), chunks(k), chunks(v), chunks(i_pre), chunks(lf)))
    return jnp.moveaxis(h, 0, 2).reshape(B, H, S, d)


def mlstm_mixer(m_x, m_v, m_o, m_if, conv_w, conv_b, w_q, w_k, i_bias, f_bias, head_norm, skip):
    B, S, _ = m_x.shape
    pad = MLSTM_CONV // 2
    xc = lax.conv_general_dilated(m_x, conv_w[:, None, :], window_strides=(1,), padding=[(pad, pad)],
                                  dimension_numbers=('NWC', 'WIO', 'NWC'), feature_group_count=MLSTM_WIDTH)
    xc = jax.nn.silu(xc + conv_b)
    xh = xc.reshape(B, S, MLSTM_HEADS, MLSTM_HEAD_DIM)
    q = jnp.einsum('bshd,hde->bhse', xh, w_q).astype(jnp.float32)
    k = jnp.einsum('bshd,hde->bhse', xh, w_k).astype(jnp.float32)
    v = m_v.reshape(B, S, MLSTM_HEADS, MLSTM_HEAD_DIM).transpose(0, 2, 1, 3).astype(jnp.float32)
    g = m_if.astype(jnp.float32).reshape(B, S, 2, 2, MLSTM_HEADS)
    i_pre = jnp.transpose(g[:, :, 0] + i_bias.astype(jnp.float32), (2, 0, 3, 1))
    f_pre = jnp.transpose(g[:, :, 1] + f_bias.astype(jnp.float32), (2, 0, 3, 1))
    h_fwd = mlstm_chunkwise(q, k, v, i_pre[0], f_pre[0])
    flip = lambda t: jnp.flip(t, axis=2)
    h_bwd = flip(mlstm_chunkwise(flip(q), flip(k), flip(v), flip(i_pre[1]), flip(f_pre[1])))
    h = (h_fwd + h_bwd).transpose(0, 2, 1, 3)
    h = h * lax.rsqrt(jnp.mean(h * h, axis=-1, keepdims=True) + EPS)
    h = h.reshape(B, S, MLSTM_WIDTH) * head_norm.astype(jnp.float32)
    out = (h + skip.astype(jnp.float32) * xc.astype(jnp.float32)) * jax.nn.sigmoid(m_o.astype(jnp.float32))
    return out.astype(m_x.dtype)


def fnet_mixer(z, w, b):
    B, S, _ = z.shape
    zg = z.reshape(B, S, FNET_GROUPS, FNET_GROUP_DIM).astype(jnp.float32)
    y = jnp.fft.fftn(zg, axes=(1, 3), norm='ortho').real.astype(z.dtype)
    return jnp.einsum('bsgc,gce->bsge', y, w).reshape(B, S, FNET_WIDTH) + b


def setup_inputs(seed: int = 0) -> dict:
    key = jax.random.key(seed)
    ks = iter(jax.random.split(key, 40))
    f32 = jnp.float32

    def nrm(shape, fan_in):
        return jax.random.normal(next(ks), shape, f32) * fan_in ** -0.5

    def gain(shape):
        return 1.0 + 0.02 * jax.random.normal(next(ks), shape, f32)

    Ld = DEPTH
    x = jax.random.normal(next(ks), (BATCH, SEQ, D_MODEL), f32)
    p = jax.random.normal(next(ks), (DEPTH, BATCH, SEQ, PLE_DIM), f32)
    offsets = jax.random.randint(next(ks), (BATCH, 1), 0, 4096, dtype=jnp.int32)
    positions = offsets + jnp.arange(SEQ, dtype=jnp.int32)[None, :]
    f_lin = jnp.linspace(3.0, 6.0, MLSTM_HEADS, dtype=f32)
    return {
        'x': x,
        'p': p,
        'positions': positions,
        'ffn1_norm': gain((Ld, D_MODEL)),
        'ffn1_w_gate': nrm((Ld, D_MODEL, D_FF), D_MODEL),
        'ffn1_w_up': nrm((Ld, D_MODEL, D_FF), D_MODEL),
        'ffn1_w_down': nrm((Ld, D_FF, D_MODEL), D_FF),
        'mix_norm': gain((Ld, D_MODEL)),
        'w_in': nrm((Ld, D_MODEL, D_IN), D_MODEL),
        'mla_q_norm': gain((Ld, MLA_Q_LORA)),
        'mla_w_uq': nrm((Ld, MLA_Q_LORA, MLA_HEADS * (MLA_NOPE_DIM + MLA_ROPE_DIM)), MLA_Q_LORA),
        'mla_kv_norm': gain((Ld, MLA_KV_LORA)),
        'mla_w_ukv': nrm((Ld, MLA_KV_LORA, MLA_HEADS * (MLA_NOPE_DIM + MLA_V_DIM)), MLA_KV_LORA),
        'mlstm_conv_w': nrm((Ld, MLSTM_CONV, MLSTM_WIDTH), MLSTM_CONV),
        'mlstm_conv_b': 0.02 * jax.random.normal(next(ks), (Ld, MLSTM_WIDTH), f32),
        'mlstm_w_q': nrm((Ld, MLSTM_HEADS, MLSTM_HEAD_DIM, MLSTM_HEAD_DIM), MLSTM_HEAD_DIM),
        'mlstm_w_k': nrm((Ld, MLSTM_HEADS, MLSTM_HEAD_DIM, MLSTM_HEAD_DIM), MLSTM_HEAD_DIM),
        'mlstm_i_bias': 0.1 * jax.random.normal(next(ks), (Ld, 2, MLSTM_HEADS), f32),
        'mlstm_f_bias': f_lin + 0.1 * jax.random.normal(next(ks), (Ld, 2, MLSTM_HEADS), f32),
        'mlstm_head_norm': gain((Ld, MLSTM_WIDTH)),
        'mlstm_skip': gain((Ld, MLSTM_WIDTH)),
        'fnet_w': nrm((Ld, FNET_GROUPS, FNET_GROUP_DIM, FNET_GROUP_DIM), FNET_GROUP_DIM),
        'fnet_b': 0.02 * jax.random.normal(next(ks), (Ld, FNET_WIDTH), f32),
        'w_out': nrm((Ld, MIX_WIDTH, D_MODEL), MIX_WIDTH),
        'ffn2_norm': gain((Ld, D_MODEL)),
        'ffn2_w_gate': nrm((Ld, D_MODEL, D_FF), D_MODEL),
        'ffn2_w_up': nrm((Ld, D_MODEL, D_FF), D_MODEL),
        'ffn2_w_down': nrm((Ld, D_FF, D_MODEL), D_FF),
        'ple_gate_norm': gain((Ld, D_MODEL)),
        'ple_w_gate': nrm((Ld, D_MODEL, D_MODEL), D_MODEL),
        'ple_w_proj': nrm((Ld, PLE_DIM, D_MODEL), PLE_DIM),
        'ple_post_norm': gain((Ld, D_MODEL)),
        'final_norm': gain((D_MODEL,)),
    }


def reference(x, p, positions, ffn1_norm, ffn1_w_gate, ffn1_w_up, ffn1_w_down, mix_norm, w_in,
              mla_q_norm, mla_w_uq, mla_kv_norm, mla_w_ukv, mlstm_conv_w, mlstm_conv_b, mlstm_w_q, mlstm_w_k,
              mlstm_i_bias, mlstm_f_bias, mlstm_head_norm, mlstm_skip, fnet_w, fnet_b, w_out,
              ffn2_norm, ffn2_w_gate, ffn2_w_up, ffn2_w_down, ple_gate_norm, ple_w_gate, ple_w_proj,
              ple_post_norm, final_norm):
    cos, sin = rope_tables(positions)
    h = x
    for i in range(DEPTH):
        h = h + 0.5 * swiglu(rmsnorm(h, ffn1_norm[i]), ffn1_w_gate[i], ffn1_w_up[i], ffn1_w_down[i])
        u = rmsnorm(h, mix_norm[i]) @ w_in[i]
        c_q, c_kv, k_rope, m_x, m_v, m_o, m_if, f_in = split_cols(u, IN_SPLITS)
        y_mla = mla_mixer(c_q, c_kv, k_rope, cos, sin, mla_q_norm[i], mla_w_uq[i], mla_kv_norm[i], mla_w_ukv[i])
        y_mlstm = mlstm_mixer(m_x, m_v, m_o, m_if, mlstm_conv_w[i], mlstm_conv_b[i], mlstm_w_q[i], mlstm_w_k[i],
                              mlstm_i_bias[i], mlstm_f_bias[i], mlstm_head_norm[i], mlstm_skip[i])
        y_fnet = fnet_mixer(f_in, fnet_w[i], fnet_b[i])
        y = jnp.concatenate([y_mla, y_mlstm, y_fnet], axis=-1)
        h = h + y @ w_out[i]
        h = h + 0.5 * swiglu(rmsnorm(h, ffn2_norm[i]), ffn2_w_gate[i], ffn2_w_up[i], ffn2_w_down[i])
        e = rmsnorm(p[i] @ ple_w_proj[i], ple_post_norm[i])
        gate = jax.nn.sigmoid(rmsnorm(h, ple_gate_norm[i]) @ ple_w_gate[i])
        h = h + gate * e
    return rmsnorm(h, final_norm)
```

```cpp
#include <hip/hip_runtime.h>
#include <cstdio>
#include <cstdint>

#ifndef PH_STEP
#define PH_STEP 1
#endif

#define GAS __attribute__((address_space(1)))
#define LAS __attribute__((address_space(3)))

constexpr int NB = 4, SEQ = 8192, DM = 1024, MTOK = NB * SEQ, DEPTH = 4;
constexpr int DFF = 2816, NGU = 2 * DFF;
constexpr int DIN = 1744, DINP = 1792;
constexpr int QL = 384, KVL = 256, NQ = 768, NKV = 1024;
constexpr int KOUT = 1280;
constexpr int PLE = 256;
constexpr float EPS = 1e-6f;
constexpr int NCHUNK = 128, NCHAIN = 32;

constexpr size_t MiB = 1u << 20;
constexpr size_t WS_CTL = 0, CTL_BYTES = 1 * MiB;
constexpr size_t WS_WOUT = 1 * MiB;
constexpr size_t WS_BOUT = 11 * MiB;
constexpr size_t WS_ROPEC = 12 * MiB, WS_ROPES = 16 * MiB;
constexpr size_t WS_SS = 20 * MiB;
constexpr size_t WS_XB0 = 24 * MiB;
constexpr size_t WS_WL = 88 * MiB;
constexpr size_t WS_BIG = 132 * MiB;
constexpr size_t WL_GU1 = 0;
constexpr size_t WL_D1  = WL_GU1 + (size_t)NGU * DM * 2;
constexpr size_t WL_GU2 = WL_D1 + (size_t)DM * DFF * 2;
constexpr size_t WL_D2  = WL_GU2 + (size_t)NGU * DM * 2;
constexpr size_t WL_IN  = WL_D2 + (size_t)DM * DFF * 2;
constexpr size_t WL_UQ  = WL_IN + (size_t)DINP * DM * 2;
constexpr size_t WL_UKV = WL_UQ + (size_t)NQ * QL * 2;
constexpr size_t WL_PG  = WL_UKV + (size_t)NKV * KVL * 2;
constexpr size_t WL_PP  = WL_PG + (size_t)DM * DM * 2;
constexpr size_t WL_END = WL_PP + (size_t)DM * PLE * 2;
static_assert(WL_END <= 44 * MiB, "per-layer weights fit");
constexpr size_t B_HID = WS_BIG;
constexpr size_t B_XB1 = WS_BIG + 176 * MiB;
constexpr size_t B_PB  = WS_BIG + 240 * MiB;
constexpr size_t B_E   = WS_BIG + 256 * MiB;
constexpr size_t B_SSE = WS_BIG + 320 * MiB;
constexpr size_t B_CQ  = WS_BIG + 0 * MiB;
constexpr size_t B_CKV = WS_BIG + 24 * MiB;
constexpr size_t B_KR  = WS_BIG + 40 * MiB;
constexpr size_t B_MX  = WS_BIG + 44 * MiB;
constexpr size_t B_MV  = WS_BIG + 60 * MiB;
constexpr size_t B_MO  = WS_BIG + 76 * MiB;
constexpr size_t B_MIF = WS_BIG + 92 * MiB;
constexpr size_t B_FQ  = WS_BIG + 94 * MiB;
constexpr size_t B_SSQ = WS_BIG + 110 * MiB;
constexpr size_t B_Q   = WS_BIG + 114 * MiB;
constexpr size_t B_KN  = WS_BIG + 162 * MiB;
constexpr size_t B_V   = WS_BIG + 194 * MiB;
constexpr size_t B_Y   = WS_BIG + 226 * MiB;
constexpr size_t B_QM  = WS_BIG + 306 * MiB;
constexpr size_t B_KM  = WS_BIG + 322 * MiB;
constexpr size_t B_XC  = WS_BIG + 338 * MiB;
constexpr size_t B_CST = WS_BIG + 354 * MiB;
constexpr size_t B_NST = WS_BIG + 386 * MiB;
constexpr size_t B_SCL = WS_BIG + 387 * MiB;
constexpr size_t B_FO  = WS_BIG + 388 * MiB;
constexpr size_t B_F1  = WS_BIG + 0 * MiB;
constexpr size_t WS_END = WS_BIG + 420 * MiB;

constexpr int RING_BYTES = 131072;
constexpr int LDS_BYTES = 147456;
constexpr int MISC_OFF = LDS_BYTES - 1024;

typedef unsigned short bf16;
typedef unsigned v4u __attribute__((ext_vector_type(4)));
typedef unsigned v2u __attribute__((ext_vector_type(2)));
typedef GAS unsigned gu32;
#define RLX_AGENT __ATOMIC_RELAXED, __HIP_MEMORY_SCOPE_AGENT
#define LDS_WAIT() asm volatile("s_waitcnt lgkmcnt(0)" ::: "memory")
#define VM_WAIT() asm volatile("s_waitcnt vmcnt(0)" ::: "memory")

__device__ __forceinline__ unsigned f2bf(float f) { unsigned u = __builtin_bit_cast(unsigned, f); return (u + 0x7fffu + ((u >> 16) & 1u)) >> 16; }
__device__ __forceinline__ unsigned pk2(float lo, float hi) { return f2bf(lo) | (f2bf(hi) << 16); }
__device__ __forceinline__ float bf2f(unsigned short b) { return __builtin_bit_cast(float, (unsigned)b << 16); }
__device__ __forceinline__ float bflo(unsigned w) { return __builtin_bit_cast(float, w << 16); }
__device__ __forceinline__ float bfhi(unsigned w) { return __builtin_bit_cast(float, w & 0xffff0000u); }
__device__ __forceinline__ float fast_rcp(float x) { return __builtin_amdgcn_rcpf(x); }
__device__ __forceinline__ float sigmoidf_(float x) { return fast_rcp(1.0f + __expf(-x)); }
__device__ __forceinline__ float siluf_(float x) { return x * fast_rcp(1.0f + __expf(-x)); }

__device__ __forceinline__ int opaque_tid() { int t = threadIdx.x; asm volatile("" : "+v"(t)); return t; }

__device__ __forceinline__ float sum_xor16(float s) { auto r = __builtin_amdgcn_permlane16_swap(__float_as_uint(s), __float_as_uint(s), false, false); return __uint_as_float(r[0]) + __uint_as_float(r[1]); }
__device__ __forceinline__ float sum_xor32(float s) { auto r = __builtin_amdgcn_permlane32_swap(__float_as_uint(s), __float_as_uint(s), false, false); return __uint_as_float(r[0]) + __uint_as_float(r[1]); }
__device__ __forceinline__ float sum_fq(float s) { return sum_xor32(sum_xor16(s)); }
__device__ __forceinline__ float bperm(int src_lane, float v) { return __int_as_float(__builtin_amdgcn_ds_bpermute(src_lane << 2, __float_as_int(v))); }

#ifndef ATT_SDEPTH
#define ATT_SDEPTH 1
#endif
#ifndef ATT_NQR
#define ATT_NQR 6
#endif
namespace pg8 {
#define PG8_LAS __attribute__((address_space(3)))
typedef unsigned short bf16_t;
typedef short bf16x8 __attribute__((ext_vector_type(8)));
typedef float f32x4 __attribute__((ext_vector_type(4)));
typedef unsigned u32x4 __attribute__((ext_vector_type(4)));
constexpr int BM = 256, BK = 64, HALF = 128, HTB = HALF * BK * 2  , STAGE_BYTES = 8 * HTB, NXCD = 8, WGM = 8;

__host__ __device__ __forceinline__ int lds_byte(int r, int c) { const int st = (r >> 4) * 2 + (c >> 5), rr = r & 15, cc = c & 31, ob = rr * 64 + cc * 2; return st * 1024 + (ob ^ (((ob >> 9) & 1) << 5)); }
__host__ __device__ __forceinline__ void stage_rc(int b, int& R, int& C) { const int st = b / 1024, sb = b % 1024, swz = sb ^ (((sb >> 9) & 1) << 5); R = (st >> 1) * 16 + swz / 64; C = (st & 1) * 32 + (swz % 64) / 2; }
__host__ __device__ __forceinline__ int perm32(int rho) { const int n = rho >> 4, i = rho & 15; return 8 * (i >> 2) + 4 * n + (i & 3); }

struct Unit { int pm, pn; };
struct Gemm { const bf16_t* A; const bf16_t* Bt; int M, N, K; };

struct StaticOrder {
    int nM, nN, nwg, G, c;
    __host__ __device__ void init(int M, int N, int G_, int c_) { nM = M / BM; nN = N / BM; nwg = nM * nN; G = G_; c = c_; }
    __host__ __device__ bool next(int i, Unit& u) const {
        const long L = (long)i * G + c; if (L >= nwg) return false;
        int wgid = (int)L; { const int q = nwg / NXCD, r = nwg % NXCD, xcd = wgid % NXCD, off = wgid / NXCD; wgid = (xcd < r ? xcd * (q + 1) : r * (q + 1) + (xcd - r) * q) + off; }
        const int nig = WGM * nN, gid = wgid / nig, fm = gid * WGM, gsz = (nM - fm) < WGM ? (nM - fm) : WGM;
        u.pm = fm + ((wgid % nig) % gsz); u.pn = (wgid % nig) / gsz; return true;
    }
    __device__ __forceinline__ void a_ready(const Unit&) const {}
    __device__ __forceinline__ void done(const Unit&) const {}
};

__device__ __forceinline__ unsigned cvt_pk_bf16(float lo, float hi) { unsigned r; asm volatile("v_cvt_pk_bf16_f32 %0, %1, %2" : "=v"(r) : "v"(lo), "v"(hi)); return r; }
typedef float f32x2 __attribute__((ext_vector_type(2)));
typedef unsigned u32x2 __attribute__((ext_vector_type(2)));
__device__ __forceinline__ float row_partial_sum(const float* p, int ns4, int fq) {
    float s = 0.f;
    if (fq < ns4) { const f32x4 v = *(const f32x4*)(p + 4 * fq); s = (v[0] + v[1]) + (v[2] + v[3]); }
    s = sum_fq(s);
    return s;
}
__device__ __forceinline__ float rowscale(const float* p, int ns4, int fq, float inv_n) { return rsqrtf(row_partial_sum(p, ns4, fq) * inv_n + 1e-6f); }

struct EpiSwiGLU {
    static constexpr bool PERM = true, AFTER_DRAIN = false;
    unsigned char* ws; size_t ss_off;
    __device__ __forceinline__ void operator()(const f32x4 (&acc)[2][2][4][2], const Unit& u, int wr, int wc, int fr, int fq) const {
        bf16_t* HID = (bf16_t*)(ws + B_HID); const float* SS = (const float*)(ws + ss_off);
        const int row0 = u.pm * BM + wr * 64 + fr, hc0 = u.pn * 128 + wc * 16 + 4 * fq;
#pragma unroll
        for (int ai = 0; ai < 2; ++ai)
#pragma unroll
            for (int m = 0; m < 4; ++m) { asm volatile("" ::: "memory");
                const int row = row0 + ai * HALF + m * 16; const float rs = rowscale(SS + (size_t)row * 16, 4, fq, 1.0f / 1024.0f);
#pragma unroll
                for (int bj = 0; bj < 2; ++bj) {
                    const f32x4 v0 = acc[ai][bj][m][0] * rs, v1 = acc[ai][bj][m][1] * rs;
                    const float h0 = siluf_(v0[0]) * v0[1], h1 = siluf_(v0[2]) * v0[3], h2 = siluf_(v1[0]) * v1[1], h3 = siluf_(v1[2]) * v1[3];
                    u32x2 w; w.x = cvt_pk_bf16(h0, h1); w.y = cvt_pk_bf16(h2, h3);
                    *(u32x2*)(HID + (size_t)row * 2816 + hc0 + bj * 64) = w;
                }
            }
    }
};

struct EpiResid {
    static constexpr bool PERM = false, AFTER_DRAIN = false;
    float* H; unsigned char* ws; size_t sso_off, bias_off; float alpha;
    __device__ __forceinline__ void operator()(const f32x4 (&acc)[2][2][4][2], const Unit& u, int wr, int wc, int fr, int fq) const {
        bf16_t* XB = (bf16_t*)(ws + WS_XB0); float* SSo = (float*)(ws + sso_off); const float* bias = bias_off ? (const float*)(ws + bias_off) : nullptr;
        const int row0 = u.pm * BM + wr * 64 + fr, col0 = u.pn * BM + wc * 32 + 4 * fq;
#pragma unroll
        for (int ai = 0; ai < 2; ++ai)
#pragma unroll
            for (int m = 0; m < 4; ++m) { asm volatile("" ::: "memory");
                const int row = row0 + ai * HALF + m * 16; float ssq = 0.f;
#pragma unroll
                for (int bj = 0; bj < 2; ++bj)
#pragma unroll
                    for (int n = 0; n < 2; ++n) {
                        const int col = col0 + bj * HALF + n * 16; const size_t off = (size_t)row * 1024 + col;
                        f32x4 hv = *(const f32x4*)(H + off);
                        f32x4 a = acc[ai][bj][m][n] * alpha; if (bias) a = a + *(const f32x4*)(bias + col);
                        hv = hv + a; *(f32x4*)(H + off) = hv;
                        u32x2 w; w.x = cvt_pk_bf16(hv[0], hv[1]); w.y = cvt_pk_bf16(hv[2], hv[3]); *(u32x2*)(XB + off) = w;
                        ssq += (hv[0] * hv[0] + hv[1] * hv[1]) + (hv[2] * hv[2] + hv[3] * hv[3]);
                    }
                ssq = sum_fq(ssq);
                if (fq == 0) SSo[(size_t)row * 16 + u.pn * 4 + wc] = ssq;
            }
    }
};

struct EpiWin {
    static constexpr bool PERM = true, AFTER_DRAIN = false;
    unsigned char* ws;
    __device__ __forceinline__ void operator()(const f32x4 (&acc)[2][2][4][2], const Unit& u, int wr, int wc, int fr, int fq) const {
        const float* SS = (const float*)(ws + WS_SS) + (size_t)MTOK * 16;
        bf16_t* CQ = (bf16_t*)(ws + B_CQ); bf16_t* CKV = (bf16_t*)(ws + B_CKV); bf16_t* KR = (bf16_t*)(ws + B_KR); bf16_t* MX = (bf16_t*)(ws + B_MX); bf16_t* MV = (bf16_t*)(ws + B_MV);
        bf16_t* MO = (bf16_t*)(ws + B_MO); bf16_t* FQ = (bf16_t*)(ws + B_FQ); float* MIF = (float*)(ws + B_MIF); float* SSQ = (float*)(ws + B_SSQ);
        const float* ropec = (const float*)(ws + WS_ROPEC); const float* ropes = (const float*)(ws + WS_ROPES);
        const int row0 = u.pm * BM + wr * 64 + fr; const int pn = u.pn;
#pragma unroll
        for (int ai = 0; ai < 2; ++ai)
#pragma unroll
            for (int m = 0; m < 4; ++m) { asm volatile("" ::: "memory");
                const int row = row0 + ai * HALF + m * 16; const float rs = rowscale(SS + (size_t)row * 16, 4, fq, 1.0f / 1024.0f);
#pragma unroll
                for (int bj = 0; bj < 2; ++bj) {
                    const f32x4 v0 = acc[ai][bj][m][0] * rs, v1 = acc[ai][bj][m][1] * rs;
                    const int cl = bj * HALF + wc * 32 + 8 * fq;
                    u32x4 w; w.x = cvt_pk_bf16(v0[0], v0[1]); w.y = cvt_pk_bf16(v0[2], v0[3]); w.z = cvt_pk_bf16(v1[0], v1[1]); w.w = cvt_pk_bf16(v1[2], v1[3]);
                    float ssq = (v0[0] * v0[0] + v0[1] * v0[1]) + (v0[2] * v0[2] + v0[3] * v0[3]) + (v1[0] * v1[0] + v1[1] * v1[1]) + (v1[2] * v1[2] + v1[3] * v1[3]);
                    const int gcol = pn * BM + cl;
                    if (pn <= 2 && gcol < 640) {
                        ssq = sum_fq(ssq);
                        const int grp = pn * 2 + bj;
                        if (fq == 0) SSQ[(size_t)row * 32 + grp * 4 + wc] = ssq;
                        if (gcol < 384) *(u32x4*)(CQ + (size_t)row * 384 + gcol) = w;
                        else *(u32x4*)(CKV + (size_t)row * 256 + (gcol - 384)) = w;
                    } else if (pn == 2) {
                        if (gcol < 704) {
                            const int j0 = (gcol - 640) >> 1;
                            const f32x4 c = *(const f32x4*)(ropec + (size_t)row * 32 + j0), s = *(const f32x4*)(ropes + (size_t)row * 32 + j0);
                            u32x4 o; o.x = cvt_pk_bf16(v0[0] * c[0] - v0[1] * s[0], v0[1] * c[0] + v0[0] * s[0]);
                            o.y = cvt_pk_bf16(v0[2] * c[1] - v0[3] * s[1], v0[3] * c[1] + v0[2] * s[1]);
                            o.z = cvt_pk_bf16(v1[0] * c[2] - v1[1] * s[2], v1[1] * c[2] + v1[0] * s[2]);
                            o.w = cvt_pk_bf16(v1[2] * c[3] - v1[3] * s[3], v1[3] * c[3] + v1[2] * s[3]);
                            *(u32x4*)(KR + (size_t)row * 64 + (gcol - 640)) = o;
                        } else if (gcol < 720) {
                            *(f32x4*)(MIF + (size_t)row * 16 + (gcol - 704)) = v0; *(f32x4*)(MIF + (size_t)row * 16 + (gcol - 704) + 4) = v1;
                        }
                    } else if (pn == 3) { *(u32x4*)(MX + (size_t)row * 256 + cl) = w;
                    } else if (pn == 4) { *(u32x4*)(MV + (size_t)row * 256 + cl) = w;
                    } else if (pn == 5) { *(u32x4*)(MO + (size_t)row * 256 + cl) = w;
                    } else {
                        const int b = row >> 13, s_ = row & 8191, quad = cl >> 2;
                        bf16_t* p = FQ + (((size_t)(b * 64 + quad) * 8192 + s_) << 2);
                        u32x2 lo, hi; lo.x = w.x; lo.y = w.y; hi.x = w.z; hi.y = w.w;
                        *(u32x2*)p = lo; *(u32x2*)(p + (size_t)8192 * 4) = hi;
                    }
                }
            }
    }
};

struct EpiQ {
    static constexpr bool PERM = true, AFTER_DRAIN = false;
    unsigned char* ws;
    __device__ __forceinline__ void operator()(const f32x4 (&acc)[2][2][4][2], const Unit& u, int wr, int wc, int fr, int fq) const {
        const float* SSQ = (const float*)(ws + B_SSQ); bf16_t* Q = (bf16_t*)(ws + B_Q); const float* ropec = (const float*)(ws + WS_ROPEC); const float* ropes = (const float*)(ws + WS_ROPES);
        const int row0 = u.pm * BM + wr * 64 + fr;
#pragma unroll
        for (int ai = 0; ai < 2; ++ai)
#pragma unroll
            for (int m = 0; m < 4; ++m) { asm volatile("" ::: "memory");
                const int row = row0 + ai * HALF + m * 16; const float rs = rowscale(SSQ + (size_t)row * 32, 3, fq, 1.0f / 384.0f);
#pragma unroll
                for (int bj = 0; bj < 2; ++bj) {
                    const f32x4 v0 = acc[ai][bj][m][0] * rs, v1 = acc[ai][bj][m][1] * rs;
                    const int gcol = u.pn * BM + bj * HALF + wc * 32 + 8 * fq; const int hc = gcol % 192;
                    u32x4 o;
                    if (hc >= 128) {
                        const int j0 = (hc - 128) >> 1;
                        const f32x4 c = *(const f32x4*)(ropec + (size_t)row * 32 + j0), s = *(const f32x4*)(ropes + (size_t)row * 32 + j0);
                        o.x = cvt_pk_bf16(v0[0] * c[0] - v0[1] * s[0], v0[1] * c[0] + v0[0] * s[0]);
                        o.y = cvt_pk_bf16(v0[2] * c[1] - v0[3] * s[1], v0[3] * c[1] + v0[2] * s[1]);
                        o.z = cvt_pk_bf16(v1[0] * c[2] - v1[1] * s[2], v1[1] * c[2] + v1[0] * s[2]);
                        o.w = cvt_pk_bf16(v1[2] * c[3] - v1[3] * s[3], v1[3] * c[3] + v1[2] * s[3]);
                    } else { o.x = cvt_pk_bf16(v0[0], v0[1]); o.y = cvt_pk_bf16(v0[2], v0[3]); o.z = cvt_pk_bf16(v1[0], v1[1]); o.w = cvt_pk_bf16(v1[2], v1[3]); }
                    *(u32x4*)(Q + (size_t)row * 768 + gcol) = o;
                }
            }
    }
};

struct EpiKV {
    static constexpr bool PERM = true, AFTER_DRAIN = false;
    unsigned char* ws;
    __device__ __forceinline__ void operator()(const f32x4 (&acc)[2][2][4][2], const Unit& u, int wr, int wc, int fr, int fq) const {
        const float* SSQ = (const float*)(ws + B_SSQ); bf16_t* KN = (bf16_t*)(ws + B_KN); bf16_t* V = (bf16_t*)(ws + B_V);
        const int row0 = u.pm * BM + wr * 64 + fr;
#pragma unroll
        for (int ai = 0; ai < 2; ++ai)
#pragma unroll
            for (int m = 0; m < 4; ++m) { asm volatile("" ::: "memory");
                const int row = row0 + ai * HALF + m * 16; const float rs = rowscale(SSQ + (size_t)row * 32 + 12, 2, fq, 1.0f / 256.0f);
#pragma unroll
                for (int bj = 0; bj < 2; ++bj) {
                    const f32x4 v0 = acc[ai][bj][m][0] * rs, v1 = acc[ai][bj][m][1] * rs;
                    u32x4 o; o.x = cvt_pk_bf16(v0[0], v0[1]); o.y = cvt_pk_bf16(v0[2], v0[3]); o.z = cvt_pk_bf16(v1[0], v1[1]); o.w = cvt_pk_bf16(v1[2], v1[3]);
                    bf16_t* dst = (bj == 0 ? KN : V) + (size_t)row * 512 + u.pn * 128 + wc * 32 + 8 * fq;
                    *(u32x4*)dst = o;
                }
            }
    }
};

struct EpiE {
    static constexpr bool PERM = true, AFTER_DRAIN = false;
    unsigned char* ws;
    __device__ __forceinline__ void operator()(const f32x4 (&acc)[2][2][4][2], const Unit& u, int wr, int wc, int fr, int fq) const {
        bf16_t* E = (bf16_t*)(ws + B_E); float* SSE = (float*)(ws + B_SSE);
        const int row0 = u.pm * BM + wr * 64 + fr;
#pragma unroll
        for (int ai = 0; ai < 2; ++ai)
#pragma unroll
            for (int m = 0; m < 4; ++m) { asm volatile("" ::: "memory");
                const int row = row0 + ai * HALF + m * 16; float ssq = 0.f;
#pragma unroll
                for (int bj = 0; bj < 2; ++bj) {
                    const f32x4 v0 = acc[ai][bj][m][0], v1 = acc[ai][bj][m][1];
                    u32x4 o; o.x = cvt_pk_bf16(v0[0], v0[1]); o.y = cvt_pk_bf16(v0[2], v0[3]); o.z = cvt_pk_bf16(v1[0], v1[1]); o.w = cvt_pk_bf16(v1[2], v1[3]);
                    ssq += (v0[0] * v0[0] + v0[1] * v0[1]) + (v0[2] * v0[2] + v0[3] * v0[3]) + (v1[0] * v1[0] + v1[1] * v1[1]) + (v1[2] * v1[2] + v1[3] * v1[3]);
                    *(u32x4*)(E + (size_t)row * 1024 + u.pn * BM + bj * HALF + wc * 32 + 8 * fq) = o;
                }
                ssq = sum_fq(ssq);
                if (fq == 0) SSE[(size_t)row * 16 + u.pn * 4 + wc] = ssq;
            }
    }
};

struct EpiPle {
    static constexpr bool PERM = false, AFTER_DRAIN = false;
    float* H; unsigned char* ws; const float* gpost;
    __device__ __forceinline__ void operator()(const f32x4 (&acc)[2][2][4][2], const Unit& u, int wr, int wc, int fr, int fq) const {
        bf16_t* XB = (bf16_t*)(ws + B_XB1); float* SSo = (float*)(ws + WS_SS); const float* SSi = SSo + (size_t)MTOK * 16; const bf16_t* E = (const bf16_t*)(ws + B_E); const float* SSE = (const float*)(ws + B_SSE);
        const int row0 = u.pm * BM + wr * 64 + fr, col0 = u.pn * BM + wc * 32 + 4 * fq;
#pragma unroll
        for (int ai = 0; ai < 2; ++ai)
#pragma unroll
            for (int m = 0; m < 4; ++m) { asm volatile("" ::: "memory");
                const int row = row0 + ai * HALF + m * 16; float ssq = 0.f;
                const float rs = rowscale(SSi + (size_t)row * 16, 4, fq, 1.0f / 1024.0f), re = rowscale(SSE + (size_t)row * 16, 4, fq, 1.0f / 1024.0f);
#pragma unroll
                for (int bj = 0; bj < 2; ++bj)
#pragma unroll
                    for (int n = 0; n < 2; ++n) {
                        const int col = col0 + bj * HALF + n * 16; const size_t off = (size_t)row * 1024 + col;
                        f32x4 hv = *(const f32x4*)(H + off); const u32x2 ew = *(const u32x2*)(E + off); const f32x4 gp = *(const f32x4*)(gpost + col);
                        const f32x4 a = acc[ai][bj][m][n] * rs;
                        hv[0] += sigmoidf_(a[0]) * (__builtin_bit_cast(float, ew.x << 16) * re * gp[0]);
                        hv[1] += sigmoidf_(a[1]) * (__builtin_bit_cast(float, ew.x & 0xffff0000u) * re * gp[1]);
                        hv[2] += sigmoidf_(a[2]) * (__builtin_bit_cast(float, ew.y << 16) * re * gp[2]);
                        hv[3] += sigmoidf_(a[3]) * (__builtin_bit_cast(float, ew.y & 0xffff0000u) * re * gp[3]);
                        *(f32x4*)(H + off) = hv;
                        u32x2 w; w.x = cvt_pk_bf16(hv[0], hv[1]); w.y = cvt_pk_bf16(hv[2], hv[3]); *(u32x2*)(XB + off) = w;
                        ssq += (hv[0] * hv[0] + hv[1] * hv[1]) + (hv[2] * hv[2] + hv[3] * hv[3]);
                    }
                ssq = sum_fq(ssq);
                if (fq == 0) SSo[(size_t)row * 16 + u.pn * 4 + wc] = ssq;
            }
    }
};

template <class Epi, class Sched, bool ALIGN_EPI = false, bool SP2 = false>
__device__ __forceinline__ void gemm_phase(PG8_LAS unsigned char* lds, const Gemm g, const Sched& S, const Epi& E) {
    const int tid = opaque_tid(), wid = __builtin_amdgcn_readfirstlane(tid >> 6), lane = tid & 63, wr = wid >> 2, wc = wid & 3, fr = lane & 15, fq = lane >> 4;
    int K_ = g.K; asm volatile("" : "+s"(K_)); const int K = K_, nt = K / BK;
    unsigned voffA[2], voffB[2];
#pragma unroll
    for (int i = 0; i < 2; ++i) { int R, C; stage_rc(tid * 16 + i * 8192, R, C); const int Rb = Epi::PERM ? ((R & ~31) + perm32(R & 31)) : R;
        voffA[i] = (unsigned)(R * K + C) * 2u; voffB[i] = (unsigned)(Rb * K + C) * 2u; }
    const size_t kstep = (size_t)(BK * 2);
    const size_t hstep = (size_t)HALF * K * 2;
    const size_t tstep = 2 * hstep;
    const unsigned ldsw = (unsigned)wid * 1024u;
    const int aoff = lds_byte(wr * 64 + fr, fq * 8), boff = lds_byte(wc * 32 + fr, fq * 8);
#define PG8_SA(b, h) (((b) * 2 + (h)) * HTB)
#define PG8_SB(b, h) ((4 + (b) * 2 + (h)) * HTB)
#define PG8_STAGE(bufoff, gbase, voff) do { _Pragma("unroll") for (int _i = 0; _i < 2; ++_i) \
        __builtin_amdgcn_global_load_lds((const unsigned*)((const char*)(gbase) + (voff)[_i]), (PG8_LAS unsigned*)(lds + (bufoff) + ldsw + _i * 8192), 16, 0, 0); } while (0)
#define PG8_LDA(dst, b, h) do { _Pragma("unroll") for (int m = 0; m < 4; ++m) _Pragma("unroll") for (int k = 0; k < 2; ++k) dst[m][k] = *(const PG8_LAS bf16x8*)(lds + PG8_SA(b, h) + aoff + m * 2048 + k * 1024); } while (0)
#define PG8_LDB(dst, b, h) do { _Pragma("unroll") for (int n = 0; n < 2; ++n) _Pragma("unroll") for (int k = 0; k < 2; ++k) dst[n][k] = *(const PG8_LAS bf16x8*)(lds + PG8_SB(b, h) + boff + n * 2048 + k * 1024); } while (0)
#define PG8_MMA(ai, bj, At, Bt) do { __builtin_amdgcn_s_setprio(1); _Pragma("unroll") for (int m = 0; m < 4; ++m) _Pragma("unroll") for (int n = 0; n < 2; ++n) _Pragma("unroll") for (int k = 0; k < 2; ++k) \
        acc[ai][bj][m][n] = __builtin_amdgcn_mfma_f32_16x16x32_bf16(Bt[n][k], At[m][k], acc[ai][bj][m][n], 0, 0, 0); __builtin_amdgcn_s_setprio(0); } while (0)
#define PG8_WAIT_V(n) asm volatile("s_waitcnt vmcnt(" #n ")" ::: "memory")
#define PG8_WAIT_L(n) asm volatile("s_waitcnt lgkmcnt(" #n ")" ::: "memory")
#define PG8_BAR __builtin_amdgcn_s_barrier()
#define PG8_SCHED __builtin_amdgcn_sched_barrier(0)
    Unit cur, nxt; int ui = 0;
    if (!S.next(0, cur)) return;
    f32x4 acc[2][2][4][2];
#pragma unroll
    for (int a = 0; a < 2; ++a)
#pragma unroll
        for (int b = 0; b < 2; ++b)
#pragma unroll
            for (int m = 0; m < 4; ++m)
#pragma unroll
                for (int n = 0; n < 2; ++n) acc[a][b][m][n] = (f32x4){0.f, 0.f, 0.f, 0.f};
    bf16x8 At[4][2], B0[2][2], B1[2][2];
    const char* cA = (const char*)g.A + (size_t)cur.pm * tstep; const char* cB = (const char*)g.Bt + (size_t)cur.pn * tstep;
    S.a_ready(cur);
    if constexpr (SP2) {
        PG8_STAGE(PG8_SB(0, 0), cB, voffB); PG8_STAGE(PG8_SB(0, 1), cB + hstep, voffB); PG8_STAGE(PG8_SA(0, 0), cA, voffA); PG8_STAGE(PG8_SA(0, 1), cA + hstep, voffA);
        if (wr == 1) PG8_BAR;
        PG8_WAIT_V(2); PG8_BAR;
        PG8_STAGE(PG8_SB(1, 0), cB + kstep, voffB); PG8_STAGE(PG8_SA(1, 0), cA + kstep, voffA); PG8_STAGE(PG8_SB(1, 1), cB + hstep + kstep, voffB);
        PG8_WAIT_V(6); PG8_BAR;
    } else {
        PG8_STAGE(PG8_SB(0, 0), cB, voffB); PG8_STAGE(PG8_SA(0, 0), cA, voffA); PG8_STAGE(PG8_SB(0, 1), cB + hstep, voffB); PG8_STAGE(PG8_SA(0, 1), cA + hstep, voffA);
        if (wr == 1) PG8_BAR;
        PG8_WAIT_V(4); PG8_BAR;
        PG8_STAGE(PG8_SB(1, 0), cB + kstep, voffB); PG8_STAGE(PG8_SA(1, 0), cA + kstep, voffA); PG8_STAGE(PG8_SB(1, 1), cB + hstep + kstep, voffB);
        PG8_WAIT_V(6); PG8_BAR;
    }
    for (;;) {
        const bool has_next = S.next(ui + 1, nxt);
        const char* nA = has_next ? (const char*)g.A + (size_t)nxt.pm * tstep : cA; const char* nB = has_next ? (const char*)g.Bt + (size_t)nxt.pn * tstep : cB;
        for (int t = 0; t < nt; t += 2) {
            const bool last = (t == nt - 2);
            const char* a1 = cA + (size_t)(t + 1) * kstep;
            const char* a2 = last ? nA : cA + (size_t)(t + 2) * kstep; const char* b2 = last ? nB : cB + (size_t)(t + 2) * kstep;
            const char* a3 = a2 + kstep; const char* b3 = b2 + kstep;
            if (last && has_next) S.a_ready(nxt);
            if constexpr (SP2) {
            PG8_LDB(B0, 0, 0); PG8_LDB(B1, 0, 1); PG8_SCHED; PG8_LDA(At, 0, 0); PG8_STAGE(PG8_SA(1, 1), a1 + hstep, voffA);
            PG8_WAIT_V(8); PG8_WAIT_L(0); PG8_BAR; PG8_MMA(0, 0, At, B0); PG8_MMA(0, 1, At, B1); PG8_BAR; PG8_SCHED;
            PG8_LDA(At, 0, 1); PG8_STAGE(PG8_SB(0, 0), b2, voffB); PG8_STAGE(PG8_SB(0, 1), b2 + hstep, voffB); PG8_STAGE(PG8_SA(0, 0), a2, voffA);
            PG8_WAIT_V(8); PG8_WAIT_L(0); PG8_BAR; PG8_MMA(1, 0, At, B0); PG8_MMA(1, 1, At, B1); PG8_BAR; PG8_SCHED;
            PG8_LDB(B0, 1, 0); PG8_LDB(B1, 1, 1); PG8_SCHED; PG8_LDA(At, 1, 0); PG8_STAGE(PG8_SA(0, 1), a2 + hstep, voffA);
            PG8_WAIT_V(8); PG8_WAIT_L(0); PG8_BAR; PG8_MMA(0, 0, At, B0); PG8_MMA(0, 1, At, B1); PG8_BAR; PG8_SCHED;
            PG8_LDA(At, 1, 1); PG8_STAGE(PG8_SB(1, 0), b3, voffB); PG8_STAGE(PG8_SB(1, 1), b3 + hstep, voffB); PG8_STAGE(PG8_SA(1, 0), a3, voffA);
            PG8_WAIT_V(8); PG8_WAIT_L(0); PG8_BAR; PG8_MMA(1, 0, At, B0); PG8_MMA(1, 1, At, B1); PG8_BAR; PG8_SCHED;
            } else {
            PG8_LDB(B0, 0, 0); PG8_SCHED; PG8_LDA(At, 0, 0); PG8_STAGE(PG8_SA(1, 1), a1 + hstep, voffA);
            PG8_WAIT_L(8); PG8_BAR; PG8_WAIT_L(0); PG8_MMA(0, 0, At, B0); PG8_BAR; PG8_SCHED;
            PG8_LDB(B1, 0, 1); PG8_STAGE(PG8_SB(0, 0), b2, voffB);
            PG8_BAR; PG8_WAIT_L(0); PG8_MMA(0, 1, At, B1); PG8_BAR;
            PG8_LDA(At, 0, 1); PG8_STAGE(PG8_SA(0, 0), a2, voffA);
            PG8_BAR; PG8_WAIT_L(0); PG8_MMA(1, 0, At, B0); PG8_BAR; PG8_SCHED;
            PG8_STAGE(PG8_SB(0, 1), b2 + hstep, voffB);
            PG8_WAIT_V(6); PG8_BAR; PG8_MMA(1, 1, At, B1); PG8_BAR;
            PG8_LDB(B0, 1, 0); PG8_SCHED; PG8_LDA(At, 1, 0); PG8_STAGE(PG8_SA(0, 1), a2 + hstep, voffA);
            PG8_WAIT_L(8); PG8_BAR; PG8_WAIT_L(0); PG8_MMA(0, 0, At, B0); PG8_BAR; PG8_SCHED;
            PG8_LDB(B1, 1, 1); PG8_STAGE(PG8_SB(1, 0), b3, voffB);
            PG8_BAR; PG8_WAIT_L(0); PG8_MMA(0, 1, At, B1); PG8_BAR;
            PG8_LDA(At, 1, 1); PG8_STAGE(PG8_SA(1, 0), a3, voffA);
            PG8_BAR; PG8_WAIT_L(0); PG8_MMA(1, 0, At, B0); PG8_BAR; PG8_SCHED;
            PG8_STAGE(PG8_SB(1, 1), b3 + hstep, voffB);
            PG8_WAIT_V(6); PG8_BAR; PG8_MMA(1, 1, At, B1); PG8_BAR;
            }
        }
        if constexpr (ALIGN_EPI) { if (wr == 0) PG8_BAR; }
        if constexpr (!Epi::AFTER_DRAIN) { E(acc, cur, wr, wc, fr, fq); S.done(cur); }
        if (!has_next) break;
#pragma unroll
        for (int a = 0; a < 2; ++a)
#pragma unroll
            for (int b = 0; b < 2; ++b)
#pragma unroll
                for (int m = 0; m < 4; ++m)
#pragma unroll
                    for (int n = 0; n < 2; ++n) acc[a][b][m][n] = (f32x4){0.f, 0.f, 0.f, 0.f};
        cur = nxt; cA = nA; cB = nB; ++ui;
        if constexpr (ALIGN_EPI) { if (wr == 1) PG8_BAR; }
    }
    PG8_WAIT_V(0);
    if constexpr (!ALIGN_EPI) { if (wr == 0) PG8_BAR; }
    PG8_BAR;
    if constexpr (Epi::AFTER_DRAIN) { E.fused(acc, cur, wr, wc, fr, fq, lds, wid, lane); S.done(cur); }
#undef PG8_SA
#undef PG8_SB
#undef PG8_STAGE
#undef PG8_LDA
#undef PG8_LDB
#undef PG8_MMA
#undef PG8_WAIT_V
#undef PG8_WAIT_L
#undef PG8_BAR
#undef PG8_SCHED
}
}
#define XB_TMO      128
#define XB_XCNT(j)  (256  + 64 * (j))
#define XB_XSUB(j)  (1280 + 64 * (j))
#define XB_XGEN(j)  (2304 + 64 * (j))
#define XB_TOP      3328
#define XB_TOPGEN   3392
#define XCD_BAR_WORDS 3456
#define XB_SPIN_CAP (1u << 18)

__device__ __forceinline__ unsigned xb_ld(unsigned* p)              { return __hip_atomic_load(p, __ATOMIC_RELAXED, __HIP_MEMORY_SCOPE_AGENT); }
__device__ __forceinline__ unsigned xb_add(unsigned* p, unsigned v) { return __hip_atomic_fetch_add(p, v, __ATOMIC_RELAXED, __HIP_MEMORY_SCOPE_AGENT); }
__device__ __forceinline__ unsigned xb_xcc_id() { return (unsigned)__builtin_amdgcn_s_getreg((3 << 11) | 20) & 0xFu; }
#define XB_SPIN(cond, bar) do { unsigned _sp = 0; while (cond) { __builtin_amdgcn_s_sleep(1); \
    if ((++_sp & 255u) == 0u) { if (xb_ld(&(bar)[XB_TMO])) break; if (_sp > XB_SPIN_CAP) { atomicAdd(&(bar)[XB_TMO], 1u); break; } } } } while (0)

struct XcdBarrier {
    unsigned* bar; unsigned x;
    volatile LAS unsigned* st;
};

__device__ __forceinline__ XcdBarrier xcd_barrier_post(unsigned* bar, volatile LAS unsigned* st) {
    XcdBarrier b; b.bar = bar; b.x = xb_xcc_id(); b.st = st;
    if (threadIdx.x == 0) (void)xb_add(&bar[XB_XCNT(b.x)], 1u);
    return b;
}
__device__ __forceinline__ void xcd_barrier_complete(unsigned* bar, unsigned x, unsigned& nloc, unsigned& nx) {
    const unsigned G = gridDim.x * gridDim.y * gridDim.z;
    unsigned sum, cnt, mine, sp = 0u;
    for (;;) {
        sum = 0u; cnt = 0u; mine = 0u;
#pragma unroll
        for (unsigned j = 0; j < 16; ++j) { const unsigned c = xb_ld(&bar[XB_XCNT(j)]); sum += c; cnt += (c > 0u) ? 1u : 0u; mine = (j == x) ? c : mine; }
        if (sum == G) break;
        __builtin_amdgcn_s_sleep(1);
        if ((++sp & 255u) == 0u) { if (xb_ld(&bar[XB_TMO])) break; if (sp > XB_SPIN_CAP) { atomicAdd(&bar[XB_TMO], 1u); break; } }
    }
    nloc = mine > 0u ? mine : 1u; nx = cnt > 0u ? cnt : 1u;
}

__device__ __forceinline__ void xcd_barrier(const XcdBarrier& b) {
    asm volatile("s_waitcnt vmcnt(0)" ::: "memory");
    __syncthreads();
    if (threadIdx.x == 0) {
        unsigned* bar = b.bar;
        __builtin_amdgcn_s_waitcnt(0);
        unsigned nloc = b.st[0], nx = b.st[1];
        if (nloc == 0u) { xcd_barrier_complete(bar, b.x, nloc, nx); b.st[0] = nloc; b.st[1] = nx; }
        const unsigned old = xb_add(&bar[XB_XSUB(b.x)], 1u);
        const unsigned gen = old / nloc;
        if (old + 1u == (gen + 1u) * nloc) {
            __builtin_amdgcn_fence(__ATOMIC_RELEASE, "agent");
            asm volatile("s_waitcnt vmcnt(0)" ::: "memory");
            const unsigned og = xb_add(&bar[XB_TOP], 1u);
            const unsigned tg = og / nx;
            if (og + 1u == (tg + 1u) * nx) xb_add(&bar[XB_TOPGEN], 1u);
            else XB_SPIN(xb_ld(&bar[XB_TOPGEN]) == tg, bar);
            __builtin_amdgcn_fence(__ATOMIC_ACQUIRE, "agent");
            xb_add(&bar[XB_XGEN(b.x)], 1u);
            asm volatile("s_waitcnt vmcnt(0)" ::: "memory");
        } else {
            XB_SPIN(xb_ld(&bar[XB_XGEN(b.x)]) == gen, bar);
            __builtin_amdgcn_fence(__ATOMIC_ACQUIRE, "agent");
            asm volatile("s_waitcnt vmcnt(0)" ::: "memory");
        }
    }
    __syncthreads();
}
typedef short bf16x8 __attribute__((ext_vector_type(8)));
typedef float f32x4 __attribute__((ext_vector_type(4)));
typedef float f32x16 __attribute__((ext_vector_type(16)));
struct Frame {
    LAS unsigned char* lds;
    volatile LAS unsigned* MISC;
    int tid, lane, wave;
    int vcu, G;
    unsigned char* ws;
    const void* const* in_unused;
};
__device__ __forceinline__ float wave_sum(float v, int lane) {
#pragma unroll
    for (int o = 1; o < 64; o <<= 1) v += bperm(lane ^ o, v);
    return v;
}
__device__ __forceinline__ float wave_max(float v, int lane) {
#pragma unroll
    for (int o = 1; o < 64; o <<= 1) v = fmaxf(v, bperm(lane ^ o, v));
    return v;
}
__device__ __forceinline__ float wave_incl_sum(float v, int lane) {
#pragma unroll
    for (int o = 1; o < 64; o <<= 1) { const float t = bperm(lane >= o ? lane - o : lane, v); if (lane >= o) v += t; }
    return v;
}
__device__ __forceinline__ float wave_incl_max(float v, int lane) {
#pragma unroll
    for (int o = 1; o < 64; o <<= 1) { const float t = bperm(lane >= o ? lane - o : lane, v); if (lane >= o) v = fmaxf(v, t); }
    return v;
}
__device__ __forceinline__ float lane_bcast(float v, int src) { return __int_as_float(__builtin_amdgcn_readlane(__float_as_int(v), src)); }
__device__ __forceinline__ float logsigmoidf_(float x) { return fminf(x, 0.f) - log1pf(__expf(-fabsf(x))); }
__device__ __forceinline__ int crow32(int r, int hi) { return (r & 3) + 8 * (r >> 2) + 4 * hi; }
__device__ __forceinline__ void unpack8(const v4u w, float (&f)[8]) {
    f[0] = bflo(w.x); f[1] = bfhi(w.x); f[2] = bflo(w.y); f[3] = bfhi(w.y); f[4] = bflo(w.z); f[5] = bfhi(w.z); f[6] = bflo(w.w); f[7] = bfhi(w.w);
}
__device__ __forceinline__ v4u pack8(const float (&f)[8]) { v4u w; w.x = pk2(f[0], f[1]); w.y = pk2(f[2], f[3]); w.z = pk2(f[4], f[5]); w.w = pk2(f[6], f[7]); return w; }

__device__ __forceinline__ f32x16 mma_tile(const LAS bf16* A, int lda, const LAS bf16* Bt, int ldb, int K, int lane) {
    const int r = lane & 31, hh = lane >> 5; f32x16 acc = {};
    const LAS bf16* ap = A + r * lda + 8 * hh; const LAS bf16* bp = Bt + r * ldb + 8 * hh;
    for (int k0 = 0; k0 < K; k0 += 16) {
        const bf16x8 a = *(const LAS bf16x8*)(ap + k0), b = *(const LAS bf16x8*)(bp + k0);
        acc = __builtin_amdgcn_mfma_f32_32x32x16_bf16(a, b, acc, 0, 0, 0);
    }
    return acc;
}

__device__ __forceinline__ int cvt_dst_row(int mode, int row0, int n) {
    if (mode == 0) return row0 + n;
    if (mode == 1) return row0 + 2 * n;
    if (mode == 2) return row0 + (n & ~63) + 2 * (n & 31) + ((n >> 5) & 1);
    const int blk = n / 192, p = n - blk * 192;
    return row0 + blk * 192 + (p < 128 ? p : 128 + 2 * ((p - 128) & 31) + ((p - 128) >> 5));
}
struct CvtJob { const float* W; int ldw, K, src_col0, ncols; bf16* WT; int ldd, row0, mode; const float* gain; };
__device__ __forceinline__ void cvt_item(const CvtJob& J, LAS float* scr, int item, int lane) {
    const int nblk = J.ncols / 32, kb = item / nblk, nb = item - kb * nblk, k0 = 64 * kb, n0 = 32 * nb;
#pragma unroll 8
    for (int i = 0; i < 32; ++i) { const int kk = 2 * i + (lane >> 5); float v = J.W[(size_t)(k0 + kk) * J.ldw + J.src_col0 + n0 + (lane & 31)]; if (J.gain) v *= J.gain[k0 + kk]; scr[kk * 33 + (lane & 31)] = v; }
    LDS_WAIT(); asm volatile("" ::: "memory");
    const int c = lane & 7;
#pragma unroll
    for (int j = 0; j < 4; ++j) { const int n = (lane >> 3) + 8 * j; const LAS float* s = scr + (8 * c) * 33 + n;
        v4u o; o.x = pk2(s[0 * 33], s[1 * 33]); o.y = pk2(s[2 * 33], s[3 * 33]); o.z = pk2(s[4 * 33], s[5 * 33]); o.w = pk2(s[6 * 33], s[7 * 33]);
        *(GAS v4u*)(J.WT + (size_t)cvt_dst_row(J.mode, J.row0, n0 + n) * J.ldd + k0 + 8 * c) = o; }
    LDS_WAIT(); asm volatile("" ::: "memory");
}
__device__ __forceinline__ void cvt_job(Frame& F, const CvtJob& J) {
    LAS float* scr = (LAS float*)(F.lds + F.wave * 16384);
    const int gw = F.vcu * 8 + F.wave, NGW = F.G * 8, nitems = (J.K / 64) * (J.ncols / 32);
    for (int it = gw; it < nitems; it += NGW) cvt_item(J, scr, it, F.lane);
}

namespace att {
using bf16x8 = __attribute__((ext_vector_type(8))) short;
using s16x4  = __attribute__((ext_vector_type(4))) short;
using f32x16 = __attribute__((ext_vector_type(16))) float;
using u32x4  = __attribute__((ext_vector_type(4))) unsigned;
constexpr int NW = 8, QBLK = 32, KVBLK = 64;
constexpr float SCALE = 0.07216878364870322f;
constexpr float THR = 8.f;
constexpr int LDQ = 768, LDKN = 512, LDKR = 64, LDV = 512, LDO = 1280;
constexpr int SHM_V = KVBLK * 128 * 2, SHM_KN = KVBLK * 128 * 2, SHM_KR = KVBLK * 64 * 2;
constexpr int OFF_V = 0, OFF_KN = 2 * SHM_V, OFF_KR = OFF_KN + 2 * SHM_KN, OFF_WS = OFF_KR + 2 * SHM_KR, OFF_QR = OFF_WS + NW * 64 * 4, NQR = ATT_NQR, QR_PITCH = (12 - NQR) * 32 + 16, QR_WAVE = 32 * QR_PITCH, SHM_ATTN = OFF_QR + NW * QR_WAVE;
#define KSWZ(row, colB) ((row) * 256 + ((colB) ^ (((row) & 7) << 4)))
#define KRSWZ(row, colB) ((row) * 128 + ((colB) ^ (((row) & 7) << 4)))
#define SBAR() __builtin_amdgcn_sched_barrier(0)
__device__ __forceinline__ int crow(int r, int hi) { return (r & 3) + 8 * (r >> 2) + 4 * hi; }
__device__ __forceinline__ unsigned cvtpk(float lo, float hi) { unsigned r; asm volatile("v_cvt_pk_bf16_f32 %0, %1, %2" : "=v"(r) : "v"(lo), "v"(hi)); return r; }

__device__ __forceinline__ void partialSM(f32x16& p0, f32x16& p1, float& m_reg, float& mn, float& alpha) {
  constexpr float C = SCALE * 1.4426950408889634f;
  float pmax = p0[0];
#pragma unroll
  for (int r = 1; r < 16; ++r) pmax = fmaxf(pmax, p0[r]);
#pragma unroll
  for (int r = 0; r < 16; ++r) pmax = fmaxf(pmax, p1[r]);
  { auto rr = __builtin_amdgcn_permlane32_swap(__float_as_uint(pmax), __float_as_uint(pmax), false, false);
    pmax = fmaxf(__uint_as_float(rr[0]), __uint_as_float(rr[1])); }
  if (__builtin_expect(__all(pmax - m_reg <= THR / SCALE), 1)) { mn = m_reg; alpha = 1.f; }
  else { mn = fmaxf(m_reg, pmax); alpha = __builtin_amdgcn_exp2f((m_reg - mn) * C); m_reg = mn; }
  float mnC = -mn * C;
#pragma unroll
  for (int r = 0; r < 16; ++r) p0[r] = fmaf(p0[r], C, mnC);
#pragma unroll
  for (int r = 0; r < 16; ++r) p1[r] = fmaf(p1[r], C, mnC);
#pragma unroll
  for (int r = 0; r < 16; ++r) p0[r] = __builtin_amdgcn_exp2f(p0[r]);
}
__device__ __forceinline__ void finishSM(f32x16& p0, f32x16& p1, float alpha, float& l_reg, bf16x8& pa0, bf16x8& pa1, bf16x8& pa2, bf16x8& pa3) {
#pragma unroll
  for (int r = 0; r < 16; ++r) p1[r] = __builtin_amdgcn_exp2f(p1[r]);
  float ps = 0;
#pragma unroll
  for (int r = 0; r < 16; ++r) ps += p0[r];
#pragma unroll
  for (int r = 0; r < 16; ++r) ps += p1[r];
  { auto rr = __builtin_amdgcn_permlane32_swap(__float_as_uint(ps), __float_as_uint(ps), false, false);
    ps = __uint_as_float(rr[0]) + __uint_as_float(rr[1]); }
  l_reg = l_reg * alpha + ps;
#define PK4(P, BASE, OUT) do { unsigned a0 = cvtpk(P[BASE + 0], P[BASE + 1]), a1 = cvtpk(P[BASE + 2], P[BASE + 3]);   \
    unsigned b0 = cvtpk(P[BASE + 4], P[BASE + 5]), b1 = cvtpk(P[BASE + 6], P[BASE + 7]);                              \
    auto r0 = __builtin_amdgcn_permlane32_swap(a0, b0, false, false); auto r1 = __builtin_amdgcn_permlane32_swap(a1, b1, false, false); \
    u32x4 w = {r0[0], r1[0], r0[1], r1[1]}; OUT = *reinterpret_cast<bf16x8*>(&w); } while (0)
  PK4(p0, 0, pa0); PK4(p0, 8, pa1); PK4(p1, 0, pa2); PK4(p1, 8, pa3);
#undef PK4
}
__device__ __forceinline__ void qkt(f32x16& p0, f32x16& p1, const char* KNs, const char* KRs, const bf16x8* qr, const char* qrl, int r32, int hi) {
  p0 = f32x16{}; p1 = f32x16{};
#pragma unroll
  for (int d0 = 0; d0 < 8; ++d0) { int cb = (d0 * 16 + hi * 8) * 2;
    bf16x8 b0 = *reinterpret_cast<const bf16x8*>(KNs + KSWZ(r32, cb));
    bf16x8 b1 = *reinterpret_cast<const bf16x8*>(KNs + KSWZ(32 + r32, cb));
    bf16x8 qv; if (d0 < NQR) qv = qr[d0]; else qv = *reinterpret_cast<const bf16x8*>(qrl + (d0 - NQR) * 32);
    p0 = __builtin_amdgcn_mfma_f32_32x32x16_bf16(b0, qv, p0, 0, 0, 0);
    p1 = __builtin_amdgcn_mfma_f32_32x32x16_bf16(b1, qv, p1, 0, 0, 0); }
#pragma unroll
  for (int d0 = 0; d0 < 4; ++d0) { int cb = (d0 * 16 + hi * 8) * 2;
    bf16x8 b0 = *reinterpret_cast<const bf16x8*>(KRs + KRSWZ(r32, cb));
    bf16x8 b1 = *reinterpret_cast<const bf16x8*>(KRs + KRSWZ(32 + r32, cb));
    const bf16x8 qv = *reinterpret_cast<const bf16x8*>(qrl + (8 - NQR + d0) * 32);
    p0 = __builtin_amdgcn_mfma_f32_32x32x16_bf16(b0, qv, p0, 0, 0, 0);
    p1 = __builtin_amdgcn_mfma_f32_32x32x16_bf16(b1, qv, p1, 0, 0, 0); }
}
__device__ __forceinline__ int v_st(int k, int c) { const int kk = (k & ~0xC) | ((k & 4) << 1) | ((k & 8) >> 1); return ((kk >> 3) * 4 + (c >> 5)) * 512 + ((kk & 7) * 32 + (c & 31)) * 2; }
__device__ __forceinline__ int v_rd_base(int lane) { return ((lane & 3) << 3) | (((lane >> 2) & 3) << 6) | (((lane >> 4) & 1) << 5) | (((lane >> 5) & 1) << 8); }
constexpr int v_rd_off(int d0, int ks, int half) { return d0 * 512 + ks * 4096 + half * 2048; }
template <int OFF> __device__ __forceinline__ s16x4 tr_read(int vb) {
  s16x4 r; asm volatile("ds_read_b64_tr_b16 %0, %1 offset:%2" : "=&v"(r) : "v"(vb), "i"(OFF) : "memory"); return r;
}
template <int D0> __device__ __forceinline__ void pv_one(f32x16& od, int vb, bf16x8 pa0, bf16x8 pa1, bf16x8 pa2, bf16x8 pa3) {
  const s16x4 l0 = tr_read<v_rd_off(D0, 0, 0)>(vb), h0 = tr_read<v_rd_off(D0, 0, 1)>(vb), l1 = tr_read<v_rd_off(D0, 1, 0)>(vb), h1 = tr_read<v_rd_off(D0, 1, 1)>(vb);
  const s16x4 l2 = tr_read<v_rd_off(D0, 2, 0)>(vb), h2 = tr_read<v_rd_off(D0, 2, 1)>(vb), l3 = tr_read<v_rd_off(D0, 3, 0)>(vb), h3 = tr_read<v_rd_off(D0, 3, 1)>(vb);
  asm volatile("s_waitcnt lgkmcnt(0)" ::: "memory"); SBAR();
#define PK(L, H) (bf16x8){L[0], L[1], L[2], L[3], H[0], H[1], H[2], H[3]}
  od = __builtin_amdgcn_mfma_f32_32x32x16_bf16(pa0, PK(l0, h0), od, 0, 0, 0);
  od = __builtin_amdgcn_mfma_f32_32x32x16_bf16(pa1, PK(l1, h1), od, 0, 0, 0);
  od = __builtin_amdgcn_mfma_f32_32x32x16_bf16(pa2, PK(l2, h2), od, 0, 0, 0);
  od = __builtin_amdgcn_mfma_f32_32x32x16_bf16(pa3, PK(l3, h3), od, 0, 0, 0);
#undef PK
}
__device__ __forceinline__ void pv_d0(f32x16* o, int vb, bf16x8 pa0, bf16x8 pa1, bf16x8 pa2, bf16x8 pa3) {
  pv_one<0>(o[0], vb, pa0, pa1, pa2, pa3); pv_one<1>(o[1], vb, pa0, pa1, pa2, pa3); pv_one<2>(o[2], vb, pa0, pa1, pa2, pa3); pv_one<3>(o[3], vb, pa0, pa1, pa2, pa3);
}

template <int SDEPTH>
__device__ __forceinline__ void attn_dense_body(const bf16* __restrict__ Qb, const bf16* __restrict__ KNh, const bf16* __restrict__ KRb, const bf16* __restrict__ Vh,
                                                bf16* __restrict__ Ob, int seq, char* lds) {
  const int tid = opaque_tid(), wid = tid >> 6, lane = tid & 63, r32 = lane & 31, hi = lane >> 5;
  char* V_lds = lds + OFF_V; char* KN_lds = lds + OFF_KN; char* KR_lds = lds + OFF_KR;
  float* ws = (float*)(lds + OFF_WS) + wid * 64; float* li_l = ws; float* al_l = ws + 32;
  float m_reg = -1e30f, l_reg = 0; f32x16 o[4] = {}; bf16x8 qr[NQR];
  const bf16* Qw = Qb + (long)(wid * QBLK + r32) * LDQ + hi * 8;
#pragma unroll
  for (int d0 = 0; d0 < NQR; ++d0) qr[d0] = *reinterpret_cast<const bf16x8*>(Qw + d0 * 16);
  char* qrl = lds + OFF_QR + wid * QR_WAVE + r32 * QR_PITCH + hi * 16;
#pragma unroll
  for (int d0 = NQR; d0 < 12; ++d0) *reinterpret_cast<bf16x8*>(qrl + (d0 - NQR) * 32) = *reinterpret_cast<const bf16x8*>(Qw + d0 * 16);
  const int sr = tid >> 4, sc = (tid & 15) * 8, vst0 = v_st(sr, sc), vst1 = v_st(32 + sr, sc);
  const int rr_ = tid >> 3, rc = (tid & 7) * 8;
  const int vb0 = (int)(uintptr_t)V_lds + v_rd_base(lane);
  struct { bf16x8 vs0, vs1, ks0, ks1, kr; } sr_[SDEPTH];
#define SLOAD(i, k0) do { sr_[i].vs0 = *reinterpret_cast<const bf16x8*>(&Vh[(long)((k0) + sr) * LDV + sc]); sr_[i].vs1 = *reinterpret_cast<const bf16x8*>(&Vh[(long)((k0) + 32 + sr) * LDV + sc]); \
    sr_[i].ks0 = *reinterpret_cast<const bf16x8*>(&KNh[(long)((k0) + sr) * LDKN + sc]); sr_[i].ks1 = *reinterpret_cast<const bf16x8*>(&KNh[(long)((k0) + 32 + sr) * LDKN + sc]); \
    sr_[i].kr = *reinterpret_cast<const bf16x8*>(&KRb[(long)((k0) + rr_) * LDKR + rc]); } while (0)
#define SWRITE(b, i) do { *(bf16x8*)(V_lds + (b) * SHM_V + vst0) = sr_[i].vs0; *(bf16x8*)(V_lds + (b) * SHM_V + vst1) = sr_[i].vs1; int kc = sc * 2; \
    *(bf16x8*)(KN_lds + (b) * SHM_KN + KSWZ(sr, kc)) = sr_[i].ks0; *(bf16x8*)(KN_lds + (b) * SHM_KN + KSWZ(32 + sr, kc)) = sr_[i].ks1; \
    *(bf16x8*)(KR_lds + (b) * SHM_KR + KRSWZ(rr_, rc * 2)) = sr_[i].kr; } while (0)
#define SWAIT() do { if constexpr (SDEPTH == 2) asm volatile("s_waitcnt vmcnt(5)" ::: "memory"); else asm volatile("s_waitcnt vmcnt(0)" ::: "memory"); } while (0)
#define RESC(a) do { if (__any((a) < 1.f)) { if (hi == 0) al_l[r32] = (a); asm volatile("s_waitcnt lgkmcnt(0)" ::: "memory"); \
    _Pragma("unroll") for (int d = 0; d < 4; ++d) _Pragma("unroll") for (int r = 0; r < 16; ++r) o[d][r] *= al_l[crow(r, hi)]; } } while (0)
  f32x16 pA0, pA1, pB0, pB1; float mnA, mnB, alA, alB; bf16x8 pa0, pa1, pa2, pa3; const int NT = seq / KVBLK;
  constexpr int SE = 0, SO = SDEPTH - 1;
  SLOAD(SE, 0); asm volatile("s_waitcnt vmcnt(0)" ::: "memory"); SWRITE(0, SE); __syncthreads();
  qkt(pA0, pA1, KN_lds, KR_lds, qr, qrl, r32, hi); partialSM(pA0, pA1, m_reg, mnA, alA);
  SLOAD(SO, KVBLK); if constexpr (SDEPTH == 2) { if (2 < NT) SLOAD(SE, 2 * KVBLK); }
  SWAIT(); SWRITE(1, SO); __syncthreads();
  for (int j = 1; j + 1 < NT; j += 2) {
    SBAR(); qkt(pB0, pB1, KN_lds + SHM_KN, KR_lds + SHM_KR, qr, qrl, r32, hi);
    finishSM(pA0, pA1, alA, l_reg, pa0, pa1, pa2, pa3); SBAR();
    SLOAD(SO, (j + SDEPTH) * KVBLK); SBAR();
    pv_d0(o, vb0, pa0, pa1, pa2, pa3); partialSM(pB0, pB1, m_reg, mnB, alB);
    __syncthreads(); SWAIT(); SWRITE(0, SE);
    RESC(alB); __syncthreads();
    SBAR(); qkt(pA0, pA1, KN_lds, KR_lds, qr, qrl, r32, hi);
    finishSM(pB0, pB1, alB, l_reg, pa0, pa1, pa2, pa3); SBAR();
    if (SDEPTH == 1 || j + 3 < NT) SLOAD(SE, (j + 1 + SDEPTH) * KVBLK); SBAR();
    pv_d0(o, vb0 + SHM_V, pa0, pa1, pa2, pa3); partialSM(pA0, pA1, m_reg, mnA, alA);
    __syncthreads(); SWAIT(); SWRITE(1, SO);
    RESC(alA); __syncthreads();
  }
  SBAR(); qkt(pB0, pB1, KN_lds + SHM_KN, KR_lds + SHM_KR, qr, qrl, r32, hi);
  finishSM(pA0, pA1, alA, l_reg, pa0, pa1, pa2, pa3); SBAR();
  pv_d0(o, vb0, pa0, pa1, pa2, pa3); partialSM(pB0, pB1, m_reg, mnB, alB);
  __syncthreads(); RESC(alB);
  finishSM(pB0, pB1, alB, l_reg, pa0, pa1, pa2, pa3); SBAR();
  pv_d0(o, vb0 + SHM_V, pa0, pa1, pa2, pa3);
  if (hi == 0) li_l[r32] = l_reg; asm volatile("s_waitcnt lgkmcnt(0)" ::: "memory");
  float rli[16];
#pragma unroll
  for (int r = 0; r < 16; ++r) rli[r] = __builtin_amdgcn_rcpf(li_l[crow(r, hi)]);
  bf16* Ow = Ob + (long)(wid * QBLK) * LDO;
#pragma unroll
  for (int r = 0; r < 16; ++r) { int orow = crow(r, hi);
#pragma unroll
    for (int d0 = 0; d0 < 4; ++d0) Ow[(long)orow * LDO + d0 * 32 + r32] = (bf16)f2bf(o[d0][r] * rli[r]); }
  __syncthreads();
#undef SLOAD
#undef SWRITE
#undef SWAIT
#undef RESC
}
#undef KSWZ
#undef KRSWZ
#undef SBAR
}

constexpr int PTAB_OFF = MISC_OFF + 256;
enum { IN_x = 0, IN_p, IN_pos, IN_ffn1_norm, IN_ffn1_wg, IN_ffn1_wu, IN_ffn1_wd, IN_mix_norm, IN_w_in, IN_q_norm, IN_w_uq, IN_kv_norm, IN_w_ukv, IN_conv_w, IN_conv_b, IN_mw_q, IN_mw_k, IN_i_bias, IN_f_bias,
       IN_head_norm, IN_skip, IN_fnet_w, IN_fnet_b, IN_w_out, IN_ffn2_norm, IN_ffn2_wg, IN_ffn2_wu, IN_ffn2_wd, IN_pg_norm, IN_ple_wg, IN_ple_wp, IN_ple_post, IN_final_norm };
__device__ __forceinline__ const float* inp(const Frame& F, int k) {
    const LAS unsigned* t = (const LAS unsigned*)(F.lds + PTAB_OFF) + 2 * k;
    const unsigned lo = __builtin_amdgcn_readfirstlane(t[0]), hi = __builtin_amdgcn_readfirstlane(t[1]);
    return (const float*)(((unsigned long long)hi << 32) | lo);
}

__device__ __forceinline__ void prologue_a(Frame& F, float* H) {
    unsigned char* ws = F.ws;
    float* ropec = (float*)(ws + WS_ROPEC); float* ropes = (float*)(ws + WS_ROPES);
    const int gt = F.vcu * 512 + F.tid, NGT = F.G * 512;
    const int* pos_ = (const int*)inp(F, IN_pos); const float* x_ = inp(F, IN_x); const float* wout_ = inp(F, IN_w_out); const float* fw_ = inp(F, IN_fnet_w); const float* fb_ = inp(F, IN_fnet_b);
    for (int i = gt; i < MTOK * 32; i += NGT) {
        const int row = i >> 5, j = i & 31;
        const float inv = 1.0f / powf(10000.0f, (float)(2 * j) / 64.0f);
        const float ang = (float)pos_[row] * inv;
        const double rev = (double)ang * 0.15915494309189535;
        const float fr = (float)(rev - floor(rev));
        ropec[i] = __builtin_amdgcn_cosf(fr); ropes[i] = __builtin_amdgcn_sinf(fr);
    }
    bf16* XB1 = (bf16*)(ws + B_XB1); float* SS0 = (float*)(ws + WS_SS);
    const int gw = F.vcu * 8 + F.wave, NGW = F.G * 8;
    for (int m = gw; m < MTOK; m += NGW) {
        const GAS f32x4* xr = (const GAS f32x4*)(x_ + (size_t)m * DM) + F.lane;
        GAS f32x4* hr = (GAS f32x4*)(H + (size_t)m * DM) + F.lane;
        GAS v2u* o8 = (GAS v2u*)(XB1 + (size_t)m * DM) + F.lane;
        float s = 0.f;
#pragma unroll
        for (int j = 0; j < 4; ++j) { const f32x4 v = xr[64 * j]; hr[64 * j] = v; v2u w; w.x = pk2(v[0], v[1]); w.y = pk2(v[2], v[3]); o8[64 * j] = w; s += (v[0] * v[0] + v[1] * v[1]) + (v[2] * v[2] + v[3] * v[3]); }
        s += bperm(F.lane ^ 1, s); s += bperm(F.lane ^ 2, s);
        if ((F.lane & 3) == 0) SS0[(size_t)m * 16 + (F.lane >> 2)] = s;
    }
    for (int l = 0; l < DEPTH; ++l) {
        CvtJob J{wout_ + (size_t)l * DM * DM, DM, 768, 0, DM, (bf16*)(ws + WS_WOUT) + (size_t)l * DM * KOUT, KOUT, 0, 0, nullptr};
        cvt_job(F, J);
    }
    float* F1 = (float*)(ws + B_F1); float* BO = (float*)(ws + WS_BOUT);
    for (int i = gt; i < DEPTH * 4 * 64 * DM; i += NGT) {
        const int n = i & 1023, cp = (i >> 10) & 63, g = (i >> 16) & 3, l = i >> 18;
        const float* fw = fw_ + ((size_t)(l * 4 + g) * 64 + cp) * 64; const float* wo = wout_ + ((size_t)l * DM + 768 + 64 * g) * DM + n;
        float a = 0.f;
#pragma unroll 8
        for (int e = 0; e < 64; ++e) a += fw[e] * wo[(size_t)e * DM];
        F1[i] = a;
    }
    for (int i = gt; i < DEPTH * DM; i += NGT) {
        const int n = i & 1023, l = i >> 10; float a = 0.f;
        for (int e = 0; e < 256; ++e) a += fb_[l * 256 + e] * wout_[((size_t)l * DM + 768 + e) * DM + n];
        BO[i] = a;
    }
}
__device__ __forceinline__ void prologue_b(Frame& F) {
    unsigned char* ws = F.ws; const float* F1 = (const float*)(ws + B_F1); bf16* WO = (bf16*)(ws + WS_WOUT);
    const int gt = F.vcu * 512 + F.tid, NGT = F.G * 512;
    for (int i = gt; i < DEPTH * DM * 256; i += NGT) {
        const int c = i & 63, g = (i >> 6) & 3, n = (i >> 8) & 1023, l = i >> 18;
        const float* f = F1 + ((size_t)(l * 4 + g) * 64) * DM + n; float ar = 0.f, ai = 0.f;
        for (int cp = 0; cp < 64; ++cp) { const float fr = (float)((c * cp) & 63) * (1.0f / 64.0f); const float v = f[(size_t)cp * DM];
            ar += __builtin_amdgcn_cosf(fr) * v; ai += __builtin_amdgcn_sinf(fr) * v; }
        bf16* dst = WO + ((size_t)l * DM + n) * KOUT;
        dst[768 + 64 * g + c] = (bf16)f2bf(ar); dst[1024 + 64 * g + c] = (bf16)f2bf(ai);
    }
}

__device__ __forceinline__ void convert_layer(Frame& F, int l) {
    unsigned char* wl = F.ws + WS_WL;
    const size_t ffo = (size_t)l * DM * DFF;
    for (int jj = 0; jj < 16; ++jj) {
        CvtJob J;
        switch (jj) {
        case 0: J = CvtJob{inp(F, IN_ffn1_wg) + ffo, DFF, DM, 0, DFF, (bf16*)(wl + WL_GU1), DM, 0, 1, inp(F, IN_ffn1_norm) + l * DM}; break;
        case 1: J = CvtJob{inp(F, IN_ffn1_wu) + ffo, DFF, DM, 0, DFF, (bf16*)(wl + WL_GU1), DM, 1, 1, inp(F, IN_ffn1_norm) + l * DM}; break;
        case 2: J = CvtJob{inp(F, IN_ffn1_wd) + ffo, DM, DFF, 0, DM, (bf16*)(wl + WL_D1), DFF, 0, 0, nullptr}; break;
        case 3: J = CvtJob{inp(F, IN_ffn2_wg) + ffo, DFF, DM, 0, DFF, (bf16*)(wl + WL_GU2), DM, 0, 1, inp(F, IN_ffn2_norm) + l * DM}; break;
        case 4: J = CvtJob{inp(F, IN_ffn2_wu) + ffo, DFF, DM, 0, DFF, (bf16*)(wl + WL_GU2), DM, 1, 1, inp(F, IN_ffn2_norm) + l * DM}; break;
        case 5: J = CvtJob{inp(F, IN_ffn2_wd) + ffo, DM, DFF, 0, DM, (bf16*)(wl + WL_D2), DFF, 0, 0, nullptr}; break;
        case 6: J = CvtJob{inp(F, IN_w_in) + (size_t)l * DM * DIN, DIN, DM, 0, 640, (bf16*)(wl + WL_IN), DM, 0, 0, inp(F, IN_mix_norm) + l * DM}; break;
        case 7: J = CvtJob{inp(F, IN_w_in) + (size_t)l * DM * DIN, DIN, DM, 640, 64, (bf16*)(wl + WL_IN), DM, 640, 2, inp(F, IN_mix_norm) + l * DM}; break;
        case 8: J = CvtJob{inp(F, IN_w_in) + (size_t)l * DM * DIN, DIN, DM, 1472, 32, (bf16*)(wl + WL_IN), DM, 704, 0, inp(F, IN_mix_norm) + l * DM}; break;
        case 9: J = CvtJob{inp(F, IN_w_in) + (size_t)l * DM * DIN, DIN, DM, 704, 768, (bf16*)(wl + WL_IN), DM, 768, 0, inp(F, IN_mix_norm) + l * DM}; break;
        case 10: J = CvtJob{inp(F, IN_w_in) + (size_t)l * DM * DIN, DIN, DM, 1488, 256, (bf16*)(wl + WL_IN), DM, 1536, 0, inp(F, IN_mix_norm) + l * DM}; break;
        case 11: J = CvtJob{inp(F, IN_w_uq) + (size_t)l * QL * NQ, NQ, QL, 0, NQ, (bf16*)(wl + WL_UQ), QL, 0, 3, inp(F, IN_q_norm) + l * QL}; break;
        case 12: J = CvtJob{inp(F, IN_w_ukv) + (size_t)l * KVL * NKV, NKV, KVL, 0, NKV, (bf16*)(wl + WL_UKV), KVL, 0, 0, inp(F, IN_kv_norm) + l * KVL}; break;
        case 13: J = CvtJob{inp(F, IN_ple_wg) + (size_t)l * DM * DM, DM, DM, 0, DM, (bf16*)(wl + WL_PG), DM, 0, 0, inp(F, IN_pg_norm) + l * DM}; break;
        case 14: J = CvtJob{inp(F, IN_ple_wp) + (size_t)l * PLE * DM, DM, PLE, 0, DM, (bf16*)(wl + WL_PP), PLE, 0, 0, nullptr}; break;
        default: J = CvtJob{nullptr, 0, 0, 0, 0, nullptr, 0, 0, 0, nullptr}; break;
        }
        if (J.W) cvt_job(F, J);
    }
    { GAS v4u* z = (GAS v4u*)((bf16*)(wl + WL_IN) + (size_t)736 * DM); const int gt = F.vcu * 512 + F.tid;
      for (int i = gt; i < 32 * DM / 8; i += F.G * 512) z[i] = (v4u){0u, 0u, 0u, 0u}; }
}
__device__ __forceinline__ void convert_p(Frame& F, int l) {
    const GAS f32x4* src = (const GAS f32x4*)(inp(F, IN_p) + (size_t)l * MTOK * PLE); GAS v2u* dst = (GAS v2u*)(F.ws + B_PB);
    const int gt = F.vcu * 512 + F.tid, NGT = F.G * 512;
    for (int i = gt; i < MTOK * PLE / 4; i += NGT) { const f32x4 v = src[i]; v2u w; w.x = pk2(v[0], v[1]); w.y = pk2(v[2], v[3]); dst[i] = w; }
}

__device__ __forceinline__ void mlstm_m1(Frame& F, int l) {
    unsigned char* ws = F.ws;
    const bf16* MX = (const bf16*)(ws + B_MX); const bf16* MV = (const bf16*)(ws + B_MV); const float* MIF = (const float*)(ws + B_MIF);
    bf16* QM = (bf16*)(ws + B_QM); bf16* KM = (bf16*)(ws + B_KM); bf16* XC = (bf16*)(ws + B_XC);
    bf16* CST = (bf16*)(ws + B_CST); float* NST = (float*)(ws + B_NST); float* SCL = (float*)(ws + B_SCL);
    LAS bf16* XCs = (LAS bf16*)(F.lds); LAS bf16* WqT = XCs + 64 * 72; LAS bf16* WkT = WqT + 64 * 72; LAS bf16* VT = WkT + 64 * 72;
    LAS bf16* KT0 = VT + 64 * 72; LAS bf16* KT1 = KT0 + 64 * 72; LAS float* wv = (LAS float*)(KT1 + 64 * 72);
    const int tid = F.tid, lane = F.lane, w = F.wave, hi = lane >> 5, r32 = lane & 31;
    const float* convb_ = inp(F, IN_conv_b); const float* convw_ = inp(F, IN_conv_w); const float* mwq_ = inp(F, IN_mw_q); const float* mwk_ = inp(F, IN_mw_k); const float* ib_ = inp(F, IN_i_bias); const float* fbias_ = inp(F, IN_f_bias);
    for (int unit = F.vcu; unit < NB * 4 * NCHUNK; unit += F.G) {
        const int b = unit >> 9, hh = (unit >> 7) & 3, c = unit & 127; const int t0 = b * SEQ + c * 64;
        {
            const int j = tid >> 3, d8 = (tid & 7) * 8, ch = hh * 64 + d8; float a[8];
#pragma unroll
            for (int i = 0; i < 8; ++i) a[i] = convb_[l * 256 + ch + i];
#pragma unroll
            for (int tap = 0; tap < 5; ++tap) { const int ss = c * 64 + j + tap - 2;
                if (ss >= 0 && ss < SEQ) { float xv[8]; unpack8(*(const GAS v4u*)(MX + (size_t)(b * SEQ + ss) * 256 + ch), xv);
                    const float* cw = convw_ + ((size_t)l * 5 + tap) * 256 + ch;
#pragma unroll
                    for (int i = 0; i < 8; ++i) a[i] += xv[i] * cw[i]; } }
#pragma unroll
            for (int i = 0; i < 8; ++i) a[i] = siluf_(a[i]);
            const v4u xw = pack8(a);
            *(LAS v4u*)(XCs + j * 72 + d8) = xw; *(GAS v4u*)(XC + (size_t)(t0 + j) * 256 + ch) = xw;
            { const int e = j; const float* wq = mwq_ + ((size_t)(l * 4 + hh) * 64 + d8) * 64 + e; const float* wk = mwk_ + ((size_t)(l * 4 + hh) * 64 + d8) * 64 + e; float q8[8], k8[8];
#pragma unroll
              for (int i = 0; i < 8; ++i) { q8[i] = wq[i * 64]; k8[i] = wk[i * 64]; }
              *(LAS v4u*)(WqT + e * 72 + d8) = pack8(q8); *(LAS v4u*)(WkT + e * 72 + d8) = pack8(k8); }
            { const v4u vw = *(const GAS v4u*)(MV + (size_t)(t0 + j) * 256 + ch); const unsigned ww[4] = {vw.x, vw.y, vw.z, vw.w};
#pragma unroll
              for (int i = 0; i < 8; ++i) VT[(d8 + i) * 72 + j] = (bf16)((i & 1) ? (ww[i >> 1] >> 16) : (ww[i >> 1] & 0xffffu)); }
        }
        if (w < 2) {
            const int dir = w, tok = t0 + (dir ? 63 - lane : lane);
            const float iv = MIF[(size_t)tok * 16 + dir * 4 + hh] + ib_[l * 8 + dir * 4 + hh];
            const float fv = MIF[(size_t)tok * 16 + 8 + dir * 4 + hh] + fbias_[l * 8 + dir * 4 + hh];
            const float lf = logsigmoidf_(fv);
            const float bc = wave_incl_sum(lf, lane); const float bL = lane_bcast(bc, 63);
            const float lw = bL - bc + iv; const float ml = wave_max(lw, lane);
            wv[dir * 64 + (dir ? 63 - lane : lane)] = __expf(lw - ml);
            if (lane == 0) { const int chain = dir * 16 + b * 4 + hh, chunk = dir ? (NCHUNK - 1 - c) : c; SCL[((size_t)chain * NCHUNK + chunk) * 4 + 0] = bL; SCL[((size_t)chain * NCHUNK + chunk) * 4 + 1] = ml; }
        }
        __syncthreads();
        const int ti = (w >> 1) & 1, tj = w & 1, dir = w >> 2;
        {
            const f32x16 acc = mma_tile(XCs + ti * 32 * 72, 72, (dir ? WkT : WqT) + tj * 32 * 72, 72, 64, lane);
            bf16* dst = (dir ? KM : QM) + (size_t)t0 * 256 + hh * 64 + tj * 32 + r32; const float sc = dir ? 1.0f : 0.125f;
#pragma unroll
            for (int r = 0; r < 16; ++r) dst[(size_t)(ti * 32 + crow32(r, hi)) * 256] = (bf16)f2bf(acc[r] * sc);
        }
        {
            const f32x16 acc = mma_tile(WkT + ti * 32 * 72, 72, XCs + tj * 32 * 72, 72, 64, lane);
            const float wj = wv[dir * 64 + tj * 32 + r32]; LAS bf16* kt = (dir ? KT1 : KT0) + tj * 32 + r32;
#pragma unroll
            for (int r = 0; r < 16; ++r) kt[(ti * 32 + crow32(r, hi)) * 72] = (bf16)f2bf(acc[r] * wj);
        }
        __syncthreads();
        {
            const f32x16 acc = mma_tile(VT + ti * 32 * 72, 72, (dir ? KT1 : KT0) + tj * 32 * 72, 72, 64, lane);
            const int chain = dir * 16 + b * 4 + hh, chunk = dir ? (NCHUNK - 1 - c) : c;
            bf16* dst = CST + ((size_t)chain * NCHUNK + chunk) * 4096 + tj * 32 + r32;
#pragma unroll
            for (int r = 0; r < 16; ++r) dst[(ti * 32 + crow32(r, hi)) * 64] = (bf16)f2bf(acc[r]);
        }
        if (tid < 128) { const int d = tid >> 6, kk = tid & 63; const LAS bf16* kt = (d ? KT1 : KT0) + kk * 72; float s = 0.f;
            for (int j = 0; j < 64; ++j) s += bf2f(kt[j]);
            const int chain = d * 16 + b * 4 + hh, chunk = d ? (NCHUNK - 1 - c) : c; NST[((size_t)chain * NCHUNK + chunk) * 64 + kk] = s; }
        __syncthreads();
    }
}
__device__ __forceinline__ void mlstm_m2(Frame& F) {
    unsigned char* ws = F.ws; bf16* CST = (bf16*)(ws + B_CST); float* NST = (float*)(ws + B_NST); float* SCL = (float*)(ws + B_SCL);
    for (int g = F.vcu * 512 + F.tid; g < NCHAIN * 4096; g += F.G * 512) {
        const int chain = g >> 12, e = g & 4095; float m = 0.f, C = 0.f, n = 0.f;
        bf16* cp = CST + (size_t)chain * NCHUNK * 4096 + e; float* np = NST + (size_t)chain * NCHUNK * 64 + (e & 63); float* sp = SCL + (size_t)chain * NCHUNK * 4;
#pragma unroll 4
        for (int c = 0; c < NCHUNK; ++c) {
            const float bL = sp[c * 4 + 0], ml = sp[c * 4 + 1]; const float cl = bf2f(cp[(size_t)c * 4096]);
            float nl = 0.f; if (e < 64) nl = np[c * 64];
            cp[(size_t)c * 4096] = (bf16)f2bf(C);
            if (e < 64) np[c * 64] = n;
            if (e == 0) sp[c * 4 + 2] = m;
            const float mn = fmaxf(bL + m, ml); const float dec = __expf(bL + m - mn), wl = __expf(ml - mn);
            C = dec * C + wl * cl; n = dec * n + wl * nl; m = mn;
        }
    }
}
__device__ __forceinline__ void mlstm_m3(Frame& F, int l) {
    unsigned char* ws = F.ws;
    const bf16* MV = (const bf16*)(ws + B_MV); const bf16* MO = (const bf16*)(ws + B_MO); const float* MIF = (const float*)(ws + B_MIF);
    const bf16* QM = (const bf16*)(ws + B_QM); const bf16* KM = (const bf16*)(ws + B_KM); const bf16* XC = (const bf16*)(ws + B_XC);
    const bf16* CST = (const bf16*)(ws + B_CST); const float* NST = (const float*)(ws + B_NST); const float* SCL = (const float*)(ws + B_SCL);
    bf16* Y = (bf16*)(ws + B_Y);
    LAS bf16* Qs = (LAS bf16*)(F.lds); LAS bf16* Ks = Qs + 64 * 72; LAS bf16* A0 = Ks + 64 * 72; LAS bf16* A1 = A0 + 64 * 136; LAS bf16* B0 = A1 + 64 * 136; LAS bf16* B1 = B0 + 64 * 136;
    LAS float* Hs = (LAS float*)(B1 + 64 * 136); LAS float* vec = Hs + 2 * 64 * 68;
    LAS float* av = vec; LAS float* Mv = vec + 128; LAS float* mtv = vec + 256; LAS float* wst = vec + 384; LAS float* nvec = vec + 512; LAS float* rden = vec + 640;
    const int tid = F.tid, lane = F.lane, w = F.wave, hi = lane >> 5, r32 = lane & 31;
    const float* ib_ = inp(F, IN_i_bias); const float* fbias_ = inp(F, IN_f_bias); const float* hn_ = inp(F, IN_head_norm); const float* sk_ = inp(F, IN_skip);
    for (int unit = F.vcu; unit < NB * 4 * NCHUNK; unit += F.G) {
        const int b = unit >> 9, hh = (unit >> 7) & 3, c = unit & 127; const int t0 = b * SEQ + c * 64;
        const int chf = b * 4 + hh, chb = 16 + b * 4 + hh, ckf = c, ckb = NCHUNK - 1 - c;
        {
            const int t = tid >> 3, d8 = (tid & 7) * 8; const size_t go = (size_t)(t0 + t) * 256 + hh * 64 + d8;
            *(LAS v4u*)(Qs + t * 72 + d8) = *(const GAS v4u*)(QM + go); *(LAS v4u*)(Ks + t * 72 + d8) = *(const GAS v4u*)(KM + go);
            { const v4u vw = *(const GAS v4u*)(MV + go); const unsigned ww[4] = {vw.x, vw.y, vw.z, vw.w};
#pragma unroll
              for (int i = 0; i < 8; ++i) { const bf16 e = (bf16)((i & 1) ? (ww[i >> 1] >> 16) : (ww[i >> 1] & 0xffffu)); B0[(d8 + i) * 136 + t] = e; B1[(d8 + i) * 136 + t] = e; } }
            *(LAS v4u*)(B0 + t * 136 + 64 + d8) = *(const GAS v4u*)(CST + ((size_t)chf * NCHUNK + ckf) * 4096 + t * 64 + d8);
            *(LAS v4u*)(B1 + t * 136 + 64 + d8) = *(const GAS v4u*)(CST + ((size_t)chb * NCHUNK + ckb) * 4096 + t * 64 + d8);
            if (tid < 128) { const int d = tid >> 6, k = tid & 63; nvec[tid] = NST[((size_t)(d ? chb : chf) * NCHUNK + (d ? ckb : ckf)) * 64 + k]; }
        }
        if (w < 2) {
            const int dir = w, idx = dir ? 63 - lane : lane, tok = t0 + idx;
            const float iv = MIF[(size_t)tok * 16 + dir * 4 + hh] + ib_[l * 8 + dir * 4 + hh];
            const float fv = MIF[(size_t)tok * 16 + 8 + dir * 4 + hh] + fbias_[l * 8 + dir * 4 + hh];
            const float m0 = SCL[((size_t)(dir ? chb : chf) * NCHUNK + (dir ? ckb : ckf)) * 4 + 2];
            const float bc = wave_incl_sum(logsigmoidf_(fv), lane); const float a = iv - bc; const float pm = wave_incl_max(a, lane);
            const float Mx = fmaxf(m0, pm);
            av[dir * 64 + idx] = a; Mv[dir * 64 + idx] = Mx; mtv[dir * 64 + idx] = bc + Mx; wst[dir * 64 + idx] = __expf(m0 - Mx);
        }
        __syncthreads();
        const int ti = (w >> 1) & 1, tj = w & 1, dir = w >> 2;
        {
            const f32x16 acc = mma_tile(Qs + ti * 32 * 72, 72, Ks + tj * 32 * 72, 72, 64, lane);
            const int s = tj * 32 + r32; const float as = av[dir * 64 + s]; LAS bf16* A = (dir ? A1 : A0) + s;
#pragma unroll
            for (int r = 0; r < 16; ++r) { const int t = ti * 32 + crow32(r, hi); const bool ok = dir ? (s >= t) : (s <= t);
                const float p = ok ? acc[r] * __expf(as - Mv[dir * 64 + t]) : 0.f; A[t * 136] = (bf16)f2bf(p); }
        }
        {
            const int t = tid >> 3, d8 = (tid & 7) * 8; float q8[8]; unpack8(*(const LAS v4u*)(Qs + t * 72 + d8), q8);
            float f8[8], g8[8]; const float w0 = wst[t], w1 = wst[64 + t];
#pragma unroll
            for (int i = 0; i < 8; ++i) { f8[i] = q8[i] * w0; g8[i] = q8[i] * w1; }
            *(LAS v4u*)(A0 + t * 136 + 64 + d8) = pack8(f8); *(LAS v4u*)(A1 + t * 136 + 64 + d8) = pack8(g8);
        }
        __syncthreads();
        const f32x16 num = mma_tile((dir ? A1 : A0) + ti * 32 * 136, 136, (dir ? B1 : B0) + tj * 32 * 136, 136, 128, lane);
        if (tid < 128) { const int d = tid >> 6, t = tid & 63; const LAS bf16* Ar = (d ? A1 : A0) + t * 136; float den = 0.f;
            for (int s = 0; s < 64; ++s) den += bf2f(Ar[s]);
            for (int k = 0; k < 64; ++k) den += bf2f(Ar[64 + k]) * nvec[d * 64 + k];
            rden[tid] = fast_rcp(fmaxf(fabsf(den), __expf(-mtv[tid]))); }
        __syncthreads();
        {
            const int v = tj * 32 + r32;
#pragma unroll
            for (int r = 0; r < 16; ++r) { const int t = ti * 32 + crow32(r, hi); Hs[(dir * 64 + t) * 68 + v] = num[r] * rden[dir * 64 + t]; }
        }
        __syncthreads();
        {
            const int t = tid >> 3, v8 = (tid & 7) * 8; float h[8]; float ss = 0.f;
#pragma unroll
            for (int i = 0; i < 8; ++i) { h[i] = Hs[t * 68 + v8 + i] + Hs[(64 + t) * 68 + v8 + i]; ss += h[i] * h[i]; }
            ss += bperm(lane ^ 1, ss); ss += bperm(lane ^ 2, ss); ss += bperm(lane ^ 4, ss);
            const float rs = rsqrtf(ss * (1.0f / 64.0f) + EPS);
            const size_t go = (size_t)(t0 + t) * 256 + hh * 64 + v8; float xc[8], mo[8]; unpack8(*(const GAS v4u*)(XC + go), xc); unpack8(*(const GAS v4u*)(MO + go), mo);
            const float* hn = hn_ + l * 256 + hh * 64 + v8; const float* sk = sk_ + l * 256 + hh * 64 + v8; float o[8];
#pragma unroll
            for (int i = 0; i < 8; ++i) o[i] = (h[i] * rs * hn[i] + sk[i] * xc[i]) * sigmoidf_(mo[i]);
            *(GAS v4u*)(Y + (size_t)(t0 + t) * KOUT + 512 + hh * 64 + v8) = pack8(o);
        }
        __syncthreads();
    }
}

__device__ __forceinline__ void fft_phase(Frame& F) {
    typedef float f32x2 __attribute__((ext_vector_type(2)));
    unsigned char* ws = F.ws; const bf16* FQ = (const bf16*)(ws + B_FQ); bf16* FO = (bf16*)(ws + B_FO);
    LAS f32x2* Z1 = (LAS f32x2*)(F.lds); LAS f32x2* Z2 = Z1 + 8192;
    const int tid = F.tid;
    for (int unit = F.vcu; unit < NB * 64; unit += F.G) {
        const bf16* src = FQ + (size_t)unit * 8192 * 4;
        for (int s = tid; s < 8192; s += 512) { const v2u wv = *(const GAS v2u*)(src + (size_t)s * 4); const int r = (int)(__brev((unsigned)s) >> 19);
            Z1[r] = (f32x2){bflo(wv.x), bfhi(wv.x)}; Z2[r] = (f32x2){bflo(wv.y), bfhi(wv.y)}; }
        for (int h = 1; h < 8192; h <<= 1) {
            __syncthreads();
            const float inv2h = 0.5f / (float)h;
            for (int j = tid; j < 4096; j += 512) { const int pos = j & (h - 1); const int i0 = ((j - pos) << 1) + pos, i1 = i0 + h;
                const float fr = (float)pos * inv2h; const float wr = __builtin_amdgcn_cosf(fr), wi = -__builtin_amdgcn_sinf(fr);
                { const f32x2 u = Z1[i0], v = Z1[i1]; const float tr = wr * v.x - wi * v.y, ti = wr * v.y + wi * v.x; Z1[i0] = (f32x2){u.x + tr, u.y + ti}; Z1[i1] = (f32x2){u.x - tr, u.y - ti}; }
                { const f32x2 u = Z2[i0], v = Z2[i1]; const float tr = wr * v.x - wi * v.y, ti = wr * v.y + wi * v.x; Z2[i0] = (f32x2){u.x + tr, u.y + ti}; Z2[i1] = (f32x2){u.x - tr, u.y - ti}; } }
        }
        __syncthreads();
        constexpr float NRM = 0.0013810679320049757f;
        bf16* dst = FO + (size_t)unit * 8192 * 8;
        for (int k = tid; k < 8192; k += 512) { const int km = (8192 - k) & 8191;
            const f32x2 a = Z1[k], am = Z1[km], c = Z2[k], cm = Z2[km];
            const float x0r = 0.5f * (a.x + am.x), x0i = 0.5f * (a.y - am.y), x1r = 0.5f * (a.y + am.y), x1i = -0.5f * (a.x - am.x);
            const float x2r = 0.5f * (c.x + cm.x), x2i = 0.5f * (c.y - cm.y), x3r = 0.5f * (c.y + cm.y), x3i = -0.5f * (c.x - cm.x);
            v4u o; o.x = pk2(x0r * NRM, x1r * NRM); o.y = pk2(x2r * NRM, x3r * NRM); o.z = pk2(x0i * NRM, x1i * NRM); o.w = pk2(x2i * NRM, x3i * NRM);
            *(GAS v4u*)(dst + (size_t)k * 8) = o; }
        __syncthreads();
    }
}
__device__ __forceinline__ void gather_phase(Frame& F) {
    unsigned char* ws = F.ws; const bf16* FO = (const bf16*)(ws + B_FO); bf16* Y = (bf16*)(ws + B_Y);
    const int gw = F.vcu * 8 + F.wave, NGW = F.G * 8; const int per = MTOK / NGW;
    for (int r = 0; r < per; ++r) { const int row = gw * per + r; const int b = row >> 13, k = row & 8191;
        const v4u v = *(const GAS v4u*)(FO + (((size_t)(b * 64 + F.lane) * 8192 + k) << 3));
        v2u re, im; re.x = v.x; re.y = v.y; im.x = v.z; im.y = v.w;
        bf16* yr = Y + (size_t)row * KOUT; *(GAS v2u*)(yr + 768 + 4 * F.lane) = re; *(GAS v2u*)(yr + 1024 + 4 * F.lane) = im; }
    for (int row = NGW * per + gw; row < MTOK; row += NGW) { const int b = row >> 13, k = row & 8191;
        const v4u v = *(const GAS v4u*)(FO + (((size_t)(b * 64 + F.lane) * 8192 + k) << 3));
        v2u re, im; re.x = v.x; re.y = v.y; im.x = v.z; im.y = v.w;
        bf16* yr = Y + (size_t)row * KOUT; *(GAS v2u*)(yr + 768 + 4 * F.lane) = re; *(GAS v2u*)(yr + 1024 + 4 * F.lane) = im; }
}
__device__ __forceinline__ void final_norm(Frame& F, float* H, const float* SS) {
    const float* fn_ = inp(F, IN_final_norm);
    const int gw = F.vcu * 8 + F.wave, NGW = F.G * 8;
    for (int m = gw; m < MTOK; m += NGW) {
        float s = (F.lane < 16) ? SS[(size_t)m * 16 + F.lane] : 0.f; s = wave_sum(s, F.lane);
        const float rs = rsqrtf(s * (1.0f / 1024.0f) + EPS);
        GAS f32x4* hr = (GAS f32x4*)(H + (size_t)m * DM) + F.lane; const GAS f32x4* g = (const GAS f32x4*)fn_ + F.lane;
#pragma unroll
        for (int j = 0; j < 4; ++j) { f32x4 v = hr[64 * j]; const f32x4 gg = g[64 * j]; v = v * rs * gg; hr[64 * j] = v; }
    }
}

constexpr int PPL = 12;
constexpr int NPH = 2 + DEPTH * PPL + 1;
struct Args { const void* in[33]; float* out; unsigned char* ws; int ph_lo, ph_hi, li, use_bar; };

__global__ void __launch_bounds__(512, 2) fwd(Args args) {
    extern __shared__ __attribute__((aligned(16))) unsigned char lds[];
    Frame F;
    F.lds = (LAS unsigned char*)lds;
    F.MISC = (volatile LAS unsigned*)(F.lds + MISC_OFF);
    F.tid = threadIdx.x; F.lane = F.tid & 63; F.wave = __builtin_amdgcn_readfirstlane(F.tid >> 6);
    F.G = gridDim.x; { const int bx = blockIdx.x; F.vcu = (F.G % 8 == 0) ? (bx % 8) * (F.G / 8) + bx / 8 : bx; }
    F.ws = args.ws;
    unsigned char* ws = args.ws;
    float* H = args.out;

    for (int u = F.tid; u < (LDS_BYTES - MISC_OFF) / 4; u += 512) ((LAS unsigned*)(F.lds + MISC_OFF))[u] = 0u;
    __syncthreads();
    if (F.tid == 0) {
#pragma unroll
        for (int i = 0; i < 33; ++i) { const unsigned long long pv = (unsigned long long)args.in[i]; ((LAS unsigned*)(F.lds + PTAB_OFF))[2 * i] = (unsigned)pv; ((LAS unsigned*)(F.lds + PTAB_OFF))[2 * i + 1] = (unsigned)(pv >> 32); }
    }
    __syncthreads();
    XcdBarrier bar; bar.bar = (unsigned*)(ws + WS_CTL) + 1024 + args.li * XCD_BAR_WORDS; bar.x = 0; bar.st = nullptr;
    if (args.use_bar) bar = xcd_barrier_post((unsigned*)(ws + WS_CTL) + 1024 + args.li * XCD_BAR_WORDS, F.MISC + 8);

    const int lo = args.ph_lo, hi = args.ph_hi;
#define IN(k) (lo <= (k) && (k) < hi)
#define REFRESH() do { F.tid = opaque_tid(); F.lane = F.tid & 63; F.wave = __builtin_amdgcn_readfirstlane(F.tid >> 6); } while (0)
#define SEAM(k) do { if (IN((k) + 1)) xcd_barrier(bar); } while (0)

    bf16* XB0 = (bf16*)(ws + WS_XB0); bf16* XB1 = (bf16*)(ws + B_XB1);
    float* SS0 = (float*)(ws + WS_SS);
    bf16* HID = (bf16*)(ws + B_HID);
    unsigned char* wl = ws + WS_WL;

    if (IN(0)) { REFRESH();
#ifndef DIS_PA
prologue_a(F, H);
#endif
 SEAM(0); }
    if (IN(1)) { REFRESH();
#ifndef DIS_PB
prologue_b(F);
#endif
 SEAM(1); }

    for (int l = 0; l < DEPTH; ++l) {
        const int pb = 2 + l * PPL;
        if (IN(pb + 0)) { REFRESH();
#ifndef DIS_CV
convert_layer(F, l);
#endif
 SEAM(pb + 0); }
        if (IN(pb + 1)) { REFRESH();
            pg8::Gemm g{XB1, (const bf16*)(wl + WL_GU1), MTOK, NGU, DM}; pg8::StaticOrder S; S.init(MTOK, NGU, F.G, (int)blockIdx.x);
            pg8::EpiSwiGLU E{ws, WS_SS};

#ifndef DIS_SW1
pg8::gemm_phase<pg8::EpiSwiGLU, pg8::StaticOrder, true, true>(F.lds, g, S, E);
#endif

            SEAM(pb + 1);
        }
        if (IN(pb + 2)) { REFRESH();
            pg8::Gemm g{HID, (const bf16*)(wl + WL_D1), MTOK, DM, DFF}; pg8::StaticOrder S; S.init(MTOK, DM, F.G, (int)blockIdx.x);
            pg8::EpiResid E{H, ws, WS_SS + (size_t)MTOK * 64, 0, 0.5f};

#ifndef DIS_RE1
pg8::gemm_phase<pg8::EpiResid, pg8::StaticOrder, true, true>(F.lds, g, S, E);
#endif

            SEAM(pb + 2);
        }
        if (IN(pb + 3)) { REFRESH();
            pg8::Gemm g{XB0, (const bf16*)(wl + WL_IN), MTOK, DINP, DM}; pg8::StaticOrder S; S.init(MTOK, DINP, F.G, (int)blockIdx.x);
            pg8::EpiWin E{ws};

#ifndef DIS_WIN1
pg8::gemm_phase<pg8::EpiWin, pg8::StaticOrder, true, true>(F.lds, g, S, E);
#endif

            SEAM(pb + 3);
        }
        if (IN(pb + 4)) { REFRESH();
            { pg8::Gemm g{(const bf16*)(ws + B_CQ), (const bf16*)(wl + WL_UQ), MTOK, NQ, QL}; pg8::StaticOrder S; S.init(MTOK, NQ, F.G, (int)blockIdx.x);
              pg8::EpiQ E{ws};

#ifndef DIS_EQ1
pg8::gemm_phase<pg8::EpiQ, pg8::StaticOrder, true, true>(F.lds, g, S, E);
#endif
 }
            __syncthreads();
            { pg8::Gemm g{(const bf16*)(ws + B_CKV), (const bf16*)(wl + WL_UKV), MTOK, NKV, KVL}; pg8::StaticOrder S; S.init(MTOK, NKV, F.G, (int)blockIdx.x);
              pg8::EpiKV E{ws};

#ifndef DIS_EKV1
pg8::gemm_phase<pg8::EpiKV, pg8::StaticOrder, true, true>(F.lds, g, S, E);
#endif
 }
            __syncthreads();

#ifndef DIS_M1
mlstm_m1(F, l);
#endif

            __syncthreads();

#ifndef DIS_FFT
fft_phase(F);
#endif

            SEAM(pb + 4);
        }
        if (IN(pb + 5)) { REFRESH();

#ifndef DIS_M2
mlstm_m2(F);
#endif

            for (int u = F.vcu; u < NB * 4 * (SEQ / 256); u += F.G) {
                const int bh = u >> 5, qb = u & 31, b = bh >> 2, hh = bh & 3; const size_t r0 = (size_t)b * SEQ;

#ifndef DIS_ATT
att::attn_dense_body<ATT_SDEPTH>((const bf16*)(ws + B_Q) + (r0 + qb * 256) * 768 + hh * 192, (const bf16*)(ws + B_KN) + r0 * 512 + hh * 128, (const bf16*)(ws + B_KR) + r0 * 64,
                                         (const bf16*)(ws + B_V) + r0 * 512 + hh * 128, (bf16*)(ws + B_Y) + (r0 + qb * 256) * KOUT + hh * 128, SEQ, (char*)lds);
#endif

            }
            SEAM(pb + 5);
        }
        if (IN(pb + 6)) { REFRESH();
#ifndef DIS_M3
mlstm_m3(F, l);
#endif

#ifndef DIS_GA
gather_phase(F);
#endif
 SEAM(pb + 6); }
        if (IN(pb + 7)) { REFRESH();
            pg8::Gemm g{(const bf16*)(ws + B_Y), (const bf16*)(ws + WS_WOUT) + (size_t)l * DM * KOUT, MTOK, DM, KOUT}; pg8::StaticOrder S; S.init(MTOK, DM, F.G, (int)blockIdx.x);
            pg8::EpiResid E{H, ws, WS_SS, WS_BOUT + (size_t)l * DM * 4, 1.0f};

#ifndef DIS_RE2
pg8::gemm_phase<pg8::EpiResid, pg8::StaticOrder, true, true>(F.lds, g, S, E);
#endif

            SEAM(pb + 7);
        }
        if (IN(pb + 8)) { REFRESH();

#ifndef DIS_CP
convert_p(F, l);
#endif

            pg8::Gemm g{XB0, (const bf16*)(wl + WL_GU2), MTOK, NGU, DM}; pg8::StaticOrder S; S.init(MTOK, NGU, F.G, (int)blockIdx.x);
            pg8::EpiSwiGLU E{ws, WS_SS};

#ifndef DIS_SW2
pg8::gemm_phase<pg8::EpiSwiGLU, pg8::StaticOrder, true, true>(F.lds, g, S, E);
#endif

            SEAM(pb + 8);
        }
        if (IN(pb + 9)) { REFRESH();
            pg8::Gemm g{HID, (const bf16*)(wl + WL_D2), MTOK, DM, DFF}; pg8::StaticOrder S; S.init(MTOK, DM, F.G, (int)blockIdx.x);
            pg8::EpiResid E{H, ws, WS_SS + (size_t)MTOK * 64, 0, 0.5f};

#ifndef DIS_RE3
pg8::gemm_phase<pg8::EpiResid, pg8::StaticOrder, true, true>(F.lds, g, S, E);
#endif

            SEAM(pb + 9);
        }
        if (IN(pb + 10)) { REFRESH();
            pg8::Gemm g{(const bf16*)(ws + B_PB), (const bf16*)(wl + WL_PP), MTOK, DM, PLE}; pg8::StaticOrder S; S.init(MTOK, DM, F.G, (int)blockIdx.x);
            pg8::EpiE E{ws};

#ifndef DIS_EE1
pg8::gemm_phase<pg8::EpiE, pg8::StaticOrder, true, true>(F.lds, g, S, E);
#endif

            SEAM(pb + 10);
        }
        if (IN(pb + 11)) { REFRESH();
            pg8::Gemm g{XB0, (const bf16*)(wl + WL_PG), MTOK, DM, DM}; pg8::StaticOrder S; S.init(MTOK, DM, F.G, (int)blockIdx.x);
            pg8::EpiPle E{H, ws, inp(F, IN_ple_post) + l * DM};

#ifndef DIS_EP1
pg8::gemm_phase<pg8::EpiPle, pg8::StaticOrder, true, true>(F.lds, g, S, E);
#endif

            SEAM(pb + 11);
        }
    }
    if (IN(NPH - 1)) { REFRESH();
#ifndef DIS_FN
final_norm(F, H, SS0);
#endif
}

#undef IN
#undef SEAM
}

extern "C" void kernel_launch(void* const* d_in, const int* in_sizes, int n_in, void* d_out, int out_size, void* d_ws, size_t ws_size, hipStream_t stream) {
    static int grid = 0;
    if (grid == 0) {
        if (n_in != 33 || out_size != MTOK * DM || ws_size < WS_END) { fprintf(stderr, "kernel_launch: unexpected shapes (n_in %d out %d ws %zu need %zu)\n", n_in, out_size, ws_size, (size_t)WS_END); grid = -1; return; }
        int dev = 0, cus = 0, per_cu = 0;
        if (hipGetDevice(&dev) != hipSuccess || hipDeviceGetAttribute(&cus, hipDeviceAttributeMultiprocessorCount, dev) != hipSuccess) { grid = -1; return; }
        if (hipFuncSetAttribute((const void*)fwd, hipFuncAttributeMaxDynamicSharedMemorySize, LDS_BYTES) != hipSuccess) { grid = -1; return; }
        if (hipOccupancyMaxActiveBlocksPerMultiprocessor(&per_cu, (const void*)fwd, 512, LDS_BYTES) != hipSuccess || per_cu < 1) { fprintf(stderr, "kernel_launch: occupancy query says %d\n", per_cu); }
        (void)hipGetLastError();
        grid = cus;
    }
    if (grid < 0) return;
    (void)hipMemsetAsync((char*)d_ws + WS_CTL, 0, CTL_BYTES, stream);
    Args a{};
    for (int i = 0; i < 33; ++i) a.in[i] = d_in[i];
    a.out = (float*)d_out; a.ws = (unsigned char*)d_ws;
    int li = 0;
    for (int p = 0; p < NPH; p += PH_STEP, ++li) {
        a.ph_lo = p; a.ph_hi = (p + PH_STEP < NPH) ? p + PH_STEP : NPH; a.li = li; a.use_bar = (a.ph_hi - a.ph_lo > 1) ? 1 : 0;
        hipLaunchKernelGGL(fwd, dim3(grid), dim3(512), LDS_BYTES, stream, a);
    }
}
static_assert(att::SHM_ATTN <= MISC_OFF && PTAB_OFF + 33 * 8 <= LDS_BYTES && MISC_OFF + 64 <= PTAB_OFF, "LDS map");
```

```cpp
#include <hip/hip_runtime.h>
#include <cstdio>
#include <cstdint>

#ifndef PH_STEP
#define PH_STEP 1000
#endif

#define GAS __attribute__((address_space(1)))
#define LAS __attribute__((address_space(3)))

constexpr int NB = 4, SEQ = 8192, DM = 1024, MTOK = NB * SEQ, DEPTH = 4;
constexpr int DFF = 2816, NGU = 2 * DFF;
constexpr int DIN = 1744, DINP = 1792;
constexpr int QL = 384, KVL = 256, NQ = 768, NKV = 1024;
constexpr int KOUT = 1280;
constexpr int PLE = 256;
constexpr float EPS = 1e-6f;
constexpr int NCHUNK = 128, NCHAIN = 32;

constexpr size_t MiB = 1u << 20;
constexpr size_t WS_CTL = 0, CTL_BYTES = 1 * MiB;
constexpr size_t WS_WOUT = 1 * MiB;
constexpr size_t WS_BOUT = 11 * MiB;
constexpr size_t WS_ROPEC = 12 * MiB, WS_ROPES = 16 * MiB;
constexpr size_t WS_SS = 20 * MiB;
constexpr size_t WS_XB0 = 24 * MiB;
constexpr size_t WS_WL = 88 * MiB;
constexpr size_t WS_BIG = 132 * MiB;
constexpr size_t WL_GU1 = 0;
constexpr size_t WL_D1  = WL_GU1 + (size_t)NGU * DM * 2;
constexpr size_t WL_GU2 = WL_D1 + (size_t)DM * DFF * 2;
constexpr size_t WL_D2  = WL_GU2 + (size_t)NGU * DM * 2;
constexpr size_t WL_IN  = WL_D2 + (size_t)DM * DFF * 2;
constexpr size_t WL_UQ  = WL_IN + (size_t)DINP * DM * 2;
constexpr size_t WL_UKV = WL_UQ + (size_t)NQ * QL * 2;
constexpr size_t WL_PG  = WL_UKV + (size_t)NKV * KVL * 2;
constexpr size_t WL_PP  = WL_PG + (size_t)DM * DM * 2;
constexpr size_t WL_END = WL_PP + (size_t)DM * PLE * 2;
static_assert(WL_END <= 44 * MiB, "per-layer weights fit");
constexpr size_t B_HID = WS_BIG;
constexpr size_t B_XB1 = WS_BIG + 176 * MiB;
constexpr size_t B_PB  = WS_BIG + 240 * MiB;
constexpr size_t B_E   = WS_BIG + 256 * MiB;
constexpr size_t B_SSE = WS_BIG + 320 * MiB;
constexpr size_t B_CQ  = WS_BIG + 0 * MiB;
constexpr size_t B_CKV = WS_BIG + 24 * MiB;
constexpr size_t B_KR  = WS_BIG + 40 * MiB;
constexpr size_t B_MX  = WS_BIG + 44 * MiB;
constexpr size_t B_MV  = WS_BIG + 60 * MiB;
constexpr size_t B_MO  = WS_BIG + 76 * MiB;
constexpr size_t B_MIF = WS_BIG + 92 * MiB;
constexpr size_t B_FQ  = WS_BIG + 94 * MiB;
constexpr size_t B_SSQ = WS_BIG + 110 * MiB;
constexpr size_t B_Q   = WS_BIG + 114 * MiB;
constexpr size_t B_KN  = WS_BIG + 162 * MiB;
constexpr size_t B_V   = WS_BIG + 194 * MiB;
constexpr size_t B_Y   = WS_BIG + 226 * MiB;
constexpr size_t B_QM  = WS_BIG + 306 * MiB;
constexpr size_t B_KM  = WS_BIG + 322 * MiB;
constexpr size_t B_XC  = WS_BIG + 338 * MiB;
constexpr size_t B_CST = WS_BIG + 354 * MiB;
constexpr size_t B_NST = WS_BIG + 386 * MiB;
constexpr size_t B_SCL = WS_BIG + 387 * MiB;
constexpr size_t B_FO  = WS_BIG + 388 * MiB;
constexpr size_t B_F1  = WS_BIG + 0 * MiB;
constexpr size_t WS_END = WS_BIG + 420 * MiB;

constexpr int RING_BYTES = 131072;
constexpr int LDS_BYTES = 147456;
constexpr int MISC_OFF = LDS_BYTES - 1024;

typedef unsigned short bf16;
typedef unsigned v4u __attribute__((ext_vector_type(4)));
typedef unsigned v2u __attribute__((ext_vector_type(2)));
typedef GAS unsigned gu32;
#define RLX_AGENT __ATOMIC_RELAXED, __HIP_MEMORY_SCOPE_AGENT
#define LDS_WAIT() asm volatile("s_waitcnt lgkmcnt(0)" ::: "memory")
#define VM_WAIT() asm volatile("s_waitcnt vmcnt(0)" ::: "memory")

__device__ __forceinline__ unsigned f2bf(float f) { unsigned u = __builtin_bit_cast(unsigned, f); return (u + 0x7fffu + ((u >> 16) & 1u)) >> 16; }
__device__ __forceinline__ unsigned pk2(float lo, float hi) { return f2bf(lo) | (f2bf(hi) << 16); }
__device__ __forceinline__ float bf2f(unsigned short b) { return __builtin_bit_cast(float, (unsigned)b << 16); }
__device__ __forceinline__ float bflo(unsigned w) { return __builtin_bit_cast(float, w << 16); }
__device__ __forceinline__ float bfhi(unsigned w) { return __builtin_bit_cast(float, w & 0xffff0000u); }
__device__ __forceinline__ float fast_rcp(float x) { return __builtin_amdgcn_rcpf(x); }
__device__ __forceinline__ float sigmoidf_(float x) { return fast_rcp(1.0f + __expf(-x)); }
__device__ __forceinline__ float siluf_(float x) { return x * fast_rcp(1.0f + __expf(-x)); }

__device__ __forceinline__ int opaque_tid() { int t = threadIdx.x; asm volatile("" : "+v"(t)); return t; }

__device__ __forceinline__ float sum_xor16(float s) { auto r = __builtin_amdgcn_permlane16_swap(__float_as_uint(s), __float_as_uint(s), false, false); return __uint_as_float(r[0]) + __uint_as_float(r[1]); }
__device__ __forceinline__ float sum_xor32(float s) { auto r = __builtin_amdgcn_permlane32_swap(__float_as_uint(s), __float_as_uint(s), false, false); return __uint_as_float(r[0]) + __uint_as_float(r[1]); }
__device__ __forceinline__ float sum_fq(float s) { return sum_xor32(sum_xor16(s)); }
__device__ __forceinline__ float bperm(int src_lane, float v) { return __int_as_float(__builtin_amdgcn_ds_bpermute(src_lane << 2, __float_as_int(v))); }

#ifndef ATT_SDEPTH
#define ATT_SDEPTH 1
#endif
#ifndef ATT_NQR
#define ATT_NQR 6
#endif
namespace pg8 {
#define PG8_LAS __attribute__((address_space(3)))
typedef unsigned short bf16_t;
typedef short bf16x8 __attribute__((ext_vector_type(8)));
typedef float f32x4 __attribute__((ext_vector_type(4)));
typedef unsigned u32x4 __attribute__((ext_vector_type(4)));
constexpr int BM = 256, BK = 64, HALF = 128, HTB = HALF * BK * 2  , STAGE_BYTES = 8 * HTB, NXCD = 8, WGM = 8;

__host__ __device__ __forceinline__ int lds_byte(int r, int c) { const int st = (r >> 4) * 2 + (c >> 5), rr = r & 15, cc = c & 31, ob = rr * 64 + cc * 2; return st * 1024 + (ob ^ (((ob >> 9) & 1) << 5)); }
__host__ __device__ __forceinline__ void stage_rc(int b, int& R, int& C) { const int st = b / 1024, sb = b % 1024, swz = sb ^ (((sb >> 9) & 1) << 5); R = (st >> 1) * 16 + swz / 64; C = (st & 1) * 32 + (swz % 64) / 2; }
__host__ __device__ __forceinline__ int perm32(int rho) { const int n = rho >> 4, i = rho & 15; return 8 * (i >> 2) + 4 * n + (i & 3); }

struct Unit { int pm, pn; };
struct Gemm { const bf16_t* A; const bf16_t* Bt; int M, N, K; };

struct StaticOrder {
    int nM, nN, nwg, G, c;
    __host__ __device__ void init(int M, int N, int G_, int c_) { nM = M / BM; nN = N / BM; nwg = nM * nN; G = G_; c = c_; }
    __host__ __device__ bool next(int i, Unit& u) const {
        const long L = (long)i * G + c; if (L >= nwg) return false;
        int wgid = (int)L; { const int q = nwg / NXCD, r = nwg % NXCD, xcd = wgid % NXCD, off = wgid / NXCD; wgid = (xcd < r ? xcd * (q + 1) : r * (q + 1) + (xcd - r) * q) + off; }
        const int nig = WGM * nN, gid = wgid / nig, fm = gid * WGM, gsz = (nM - fm) < WGM ? (nM - fm) : WGM;
        u.pm = fm + ((wgid % nig) % gsz); u.pn = (wgid % nig) / gsz; return true;
    }
    __device__ __forceinline__ void a_ready(const Unit&) const {}
    __device__ __forceinline__ void done(const Unit&) const {}
};

__device__ __forceinline__ unsigned cvt_pk_bf16(float lo, float hi) { unsigned r; asm volatile("v_cvt_pk_bf16_f32 %0, %1, %2" : "=v"(r) : "v"(lo), "v"(hi)); return r; }
typedef float f32x2 __attribute__((ext_vector_type(2)));
typedef unsigned u32x2 __attribute__((ext_vector_type(2)));
__device__ __forceinline__ float row_partial_sum(const float* p, int ns4, int fq) {
    float s = 0.f;
    if (fq < ns4) { const f32x4 v = *(const f32x4*)(p + 4 * fq); s = (v[0] + v[1]) + (v[2] + v[3]); }
    s = sum_fq(s);
    return s;
}
__device__ __forceinline__ float rowscale(const float* p, int ns4, int fq, float inv_n) { return rsqrtf(row_partial_sum(p, ns4, fq) * inv_n + 1e-6f); }

struct EpiSwiGLU {
    static constexpr bool PERM = true, AFTER_DRAIN = false;
    unsigned char* ws; size_t ss_off;
    __device__ __forceinline__ void operator()(const f32x4 (&acc)[2][2][4][2], const Unit& u, int wr, int wc, int fr, int fq) const {
        bf16_t* HID = (bf16_t*)(ws + B_HID); const float* SS = (const float*)(ws + ss_off);
        const int row0 = u.pm * BM + wr * 64 + fr, hc0 = u.pn * 128 + wc * 16 + 4 * fq;
#pragma unroll
        for (int ai = 0; ai < 2; ++ai)
#pragma unroll
            for (int m = 0; m < 4; ++m) { asm volatile("" ::: "memory");
                const int row = row0 + ai * HALF + m * 16; const float rs = rowscale(SS + (size_t)row * 16, 4, fq, 1.0f / 1024.0f);
#pragma unroll
                for (int bj = 0; bj < 2; ++bj) {
                    const f32x4 v0 = acc[ai][bj][m][0] * rs, v1 = acc[ai][bj][m][1] * rs;
                    const float h0 = siluf_(v0[0]) * v0[1], h1 = siluf_(v0[2]) * v0[3], h2 = siluf_(v1[0]) * v1[1], h3 = siluf_(v1[2]) * v1[3];
                    u32x2 w; w.x = cvt_pk_bf16(h0, h1); w.y = cvt_pk_bf16(h2, h3);
                    *(u32x2*)(HID + (size_t)row * 2816 + hc0 + bj * 64) = w;
                }
            }
    }
};

struct EpiResid {
    static constexpr bool PERM = false, AFTER_DRAIN = false;
    float* H; unsigned char* ws; size_t sso_off, bias_off; float alpha;
    __device__ __forceinline__ void operator()(const f32x4 (&acc)[2][2][4][2], const Unit& u, int wr, int wc, int fr, int fq) const {
        bf16_t* XB = (bf16_t*)(ws + WS_XB0); float* SSo = (float*)(ws + sso_off); const float* bias = bias_off ? (const float*)(ws + bias_off) : nullptr;
        const int row0 = u.pm * BM + wr * 64 + fr, col0 = u.pn * BM + wc * 32 + 4 * fq;
#pragma unroll
        for (int ai = 0; ai < 2; ++ai)
#pragma unroll
            for (int m = 0; m < 4; ++m) { asm volatile("" ::: "memory");
                const int row = row0 + ai * HALF + m * 16; float ssq = 0.f;
#pragma unroll
                for (int bj = 0; bj < 2; ++bj)
#pragma unroll
                    for (int n = 0; n < 2; ++n) {
                        const int col = col0 + bj * HALF + n * 16; const size_t off = (size_t)row * 1024 + col;
                        f32x4 hv = *(const f32x4*)(H + off);
                        f32x4 a = acc[ai][bj][m][n] * alpha; if (bias) a = a + *(const f32x4*)(bias + col);
                        hv = hv + a; *(f32x4*)(H + off) = hv;
                        u32x2 w; w.x = cvt_pk_bf16(hv[0], hv[1]); w.y = cvt_pk_bf16(hv[2], hv[3]); *(u32x2*)(XB + off) = w;
                        ssq += (hv[0] * hv[0] + hv[1] * hv[1]) + (hv[2] * hv[2] + hv[3] * hv[3]);
                    }
                ssq = sum_fq(ssq);
                if (fq == 0) SSo[(size_t)row * 16 + u.pn * 4 + wc] = ssq;
            }
    }
};

struct EpiWin {
    static constexpr bool PERM = true, AFTER_DRAIN = false;
    unsigned char* ws;
    __device__ __forceinline__ void operator()(const f32x4 (&acc)[2][2][4][2], const Unit& u, int wr, int wc, int fr, int fq) const {
        const float* SS = (const float*)(ws + WS_SS) + (size_t)MTOK * 16;
        bf16_t* CQ = (bf16_t*)(ws + B_CQ); bf16_t* CKV = (bf16_t*)(ws + B_CKV); bf16_t* KR = (bf16_t*)(ws + B_KR); bf16_t* MX = (bf16_t*)(ws + B_MX); bf16_t* MV = (bf16_t*)(ws + B_MV);
        bf16_t* MO = (bf16_t*)(ws + B_MO); bf16_t* FQ = (bf16_t*)(ws + B_FQ); float* MIF = (float*)(ws + B_MIF); float* SSQ = (float*)(ws + B_SSQ);
        const float* ropec = (const float*)(ws + WS_ROPEC); const float* ropes = (const float*)(ws + WS_ROPES);
        const int row0 = u.pm * BM + wr * 64 + fr; const int pn = u.pn;
#pragma unroll
        for (int ai = 0; ai < 2; ++ai)
#pragma unroll
            for (int m = 0; m < 4; ++m) { asm volatile("" ::: "memory");
                const int row = row0 + ai * HALF + m * 16; const float rs = rowscale(SS + (size_t)row * 16, 4, fq, 1.0f / 1024.0f);
#pragma unroll
                for (int bj = 0; bj < 2; ++bj) {
                    const f32x4 v0 = acc[ai][bj][m][0] * rs, v1 = acc[ai][bj][m][1] * rs;
                    const int cl = bj * HALF + wc * 32 + 8 * fq;
                    u32x4 w; w.x = cvt_pk_bf16(v0[0], v0[1]); w.y = cvt_pk_bf16(v0[2], v0[3]); w.z = cvt_pk_bf16(v1[0], v1[1]); w.w = cvt_pk_bf16(v1[2], v1[3]);
                    float ssq = (v0[0] * v0[0] + v0[1] * v0[1]) + (v0[2] * v0[2] + v0[3] * v0[3]) + (v1[0] * v1[0] + v1[1] * v1[1]) + (v1[2] * v1[2] + v1[3] * v1[3]);
                    const int gcol = pn * BM + cl;
                    if (pn <= 2 && gcol < 640) {
                        ssq = sum_fq(ssq);
                        const int grp = pn * 2 + bj;
                        if (fq == 0) SSQ[(size_t)row * 32 + grp * 4 + wc] = ssq;
                        if (gcol < 384) *(u32x4*)(CQ + (size_t)row * 384 + gcol) = w;
                        else *(u32x4*)(CKV + (size_t)row * 256 + (gcol - 384)) = w;
                    } else if (pn == 2) {
                        if (gcol < 704) {
                            const int j0 = (gcol - 640) >> 1;
                            const f32x4 c = *(const f32x4*)(ropec + (size_t)row * 32 + j0), s = *(const f32x4*)(ropes + (size_t)row * 32 + j0);
                            u32x4 o; o.x = cvt_pk_bf16(v0[0] * c[0] - v0[1] * s[0], v0[1] * c[0] + v0[0] * s[0]);
                            o.y = cvt_pk_bf16(v0[2] * c[1] - v0[3] * s[1], v0[3] * c[1] + v0[2] * s[1]);
                            o.z = cvt_pk_bf16(v1[0] * c[2] - v1[1] * s[2], v1[1] * c[2] + v1[0] * s[2]);
                            o.w = cvt_pk_bf16(v1[2] * c[3] - v1[3] * s[3], v1[3] * c[3] + v1[2] * s[3]);
                            *(u32x4*)(KR + (size_t)row * 64 + (gcol - 640)) = o;
                        } else if (gcol < 720) {
                            *(f32x4*)(MIF + (size_t)row * 16 + (gcol - 704)) = v0; *(f32x4*)(MIF + (size_t)row * 16 + (gcol - 704) + 4) = v1;
                        }
                    } else if (pn == 3) { *(u32x4*)(MX + (size_t)row * 256 + cl) = w;
                    } else if (pn == 4) { *(u32x4*)(MV + (size_t)row * 256 + cl) = w;
                    } else if (pn == 5) { *(u32x4*)(MO + (size_t)row * 256 + cl) = w;
                    } else {
                        const int b = row >> 13, s_ = row & 8191, quad = cl >> 2;
                        bf16_t* p = FQ + (((size_t)(b * 64 + quad) * 8192 + s_) << 2);
                        u32x2 lo, hi; lo.x = w.x; lo.y = w.y; hi.x = w.z; hi.y = w.w;
                        *(u32x2*)p = lo; *(u32x2*)(p + (size_t)8192 * 4) = hi;
                    }
                }
            }
    }
};

struct EpiQ {
    static constexpr bool PERM = true, AFTER_DRAIN = false;
    unsigned char* ws;
    __device__ __forceinline__ void operator()(const f32x4 (&acc)[2][2][4][2], const Unit& u, int wr, int wc, int fr, int fq) const {
        const float* SSQ = (const float*)(ws + B_SSQ); bf16_t* Q = (bf16_t*)(ws + B_Q); const float* ropec = (const float*)(ws + WS_ROPEC); const float* ropes = (const float*)(ws + WS_ROPES);
        const int row0 = u.pm * BM + wr * 64 + fr;
#pragma unroll
        for (int ai = 0; ai < 2; ++ai)
#pragma unroll
            for (int m = 0; m < 4; ++m) { asm volatile("" ::: "memory");
                const int row = row0 + ai * HALF + m * 16; const float rs = rowscale(SSQ + (size_t)row * 32, 3, fq, 1.0f / 384.0f);
#pragma unroll
                for (int bj = 0; bj < 2; ++bj) {
                    const f32x4 v0 = acc[ai][bj][m][0] * rs, v1 = acc[ai][bj][m][1] * rs;
                    const int gcol = u.pn * BM + bj * HALF + wc * 32 + 8 * fq; const int hc = gcol % 192;
                    u32x4 o;
                    if (hc >= 128) {
                        const int j0 = (hc - 128) >> 1;
                        const f32x4 c = *(const f32x4*)(ropec + (size_t)row * 32 + j0), s = *(const f32x4*)(ropes + (size_t)row * 32 + j0);
                        o.x = cvt_pk_bf16(v0[0] * c[0] - v0[1] * s[0], v0[1] * c[0] + v0[0] * s[0]);
                        o.y = cvt_pk_bf16(v0[2] * c[1] - v0[3] * s[1], v0[3] * c[1] + v0[2] * s[1]);
                        o.z = cvt_pk_bf16(v1[0] * c[2] - v1[1] * s[2], v1[1] * c[2] + v1[0] * s[2]);
                        o.w = cvt_pk_bf16(v1[2] * c[3] - v1[3] * s[3], v1[3] * c[3] + v1[2] * s[3]);
                    } else { o.x = cvt_pk_bf16(v0[0], v0[1]); o.y = cvt_pk_bf16(v0[2], v0[3]); o.z = cvt_pk_bf16(v1[0], v1[1]); o.w = cvt_pk_bf16(v1[2], v1[3]); }
                    *(u32x4*)(Q + (size_t)row * 768 + gcol) = o;
                }
            }
    }
};

struct EpiKV {
    static constexpr bool PERM = true, AFTER_DRAIN = false;
    unsigned char* ws;
    __device__ __forceinline__ void operator()(const f32x4 (&acc)[2][2][4][2], const Unit& u, int wr, int wc, int fr, int fq) const {
        const float* SSQ = (const float*)(ws + B_SSQ); bf16_t* KN = (bf16_t*)(ws + B_KN); bf16_t* V = (bf16_t*)(ws + B_V);
        const int row0 = u.pm * BM + wr * 64 + fr;
#pragma unroll
        for (int ai = 0; ai < 2; ++ai)
#pragma unroll
            for (int m = 0; m < 4; ++m) { asm volatile("" ::: "memory");
                const int row = row0 + ai * HALF + m * 16; const float rs = rowscale(SSQ + (size_t)row * 32 + 12, 2, fq, 1.0f / 256.0f);
#pragma unroll
                for (int bj = 0; bj < 2; ++bj) {
                    const f32x4 v0 = acc[ai][bj][m][0] * rs, v1 = acc[ai][bj][m][1] * rs;
                    u32x4 o; o.x = cvt_pk_bf16(v0[0], v0[1]); o.y = cvt_pk_bf16(v0[2], v0[3]); o.z = cvt_pk_bf16(v1[0], v1[1]); o.w = cvt_pk_bf16(v1[2], v1[3]);
                    bf16_t* dst = (bj == 0 ? KN : V) + (size_t)row * 512 + u.pn * 128 + wc * 32 + 8 * fq;
                    *(u32x4*)dst = o;
                }
            }
    }
};

struct EpiE {
    static constexpr bool PERM = true, AFTER_DRAIN = false;
    unsigned char* ws;
    __device__ __forceinline__ void operator()(const f32x4 (&acc)[2][2][4][2], const Unit& u, int wr, int wc, int fr, int fq) const {
        bf16_t* E = (bf16_t*)(ws + B_E); float* SSE = (float*)(ws + B_SSE);
        const int row0 = u.pm * BM + wr * 64 + fr;
#pragma unroll
        for (int ai = 0; ai < 2; ++ai)
#pragma unroll
            for (int m = 0; m < 4; ++m) { asm volatile("" ::: "memory");
                const int row = row0 + ai * HALF + m * 16; float ssq = 0.f;
#pragma unroll
                for (int bj = 0; bj < 2; ++bj) {
                    const f32x4 v0 = acc[ai][bj][m][0], v1 = acc[ai][bj][m][1];
                    u32x4 o; o.x = cvt_pk_bf16(v0[0], v0[1]); o.y = cvt_pk_bf16(v0[2], v0[3]); o.z = cvt_pk_bf16(v1[0], v1[1]); o.w = cvt_pk_bf16(v1[2], v1[3]);
                    ssq += (v0[0] * v0[0] + v0[1] * v0[1]) + (v0[2] * v0[2] + v0[3] * v0[3]) + (v1[0] * v1[0] + v1[1] * v1[1]) + (v1[2] * v1[2] + v1[3] * v1[3]);
                    *(u32x4*)(E + (size_t)row * 1024 + u.pn * BM + bj * HALF + wc * 32 + 8 * fq) = o;
                }
                ssq = sum_fq(ssq);
                if (fq == 0) SSE[(size_t)row * 16 + u.pn * 4 + wc] = ssq;
            }
    }
};

struct EpiPle {
    static constexpr bool PERM = false, AFTER_DRAIN = false;
    float* H; unsigned char* ws; const float* gpost;
    __device__ __forceinline__ void operator()(const f32x4 (&acc)[2][2][4][2], const Unit& u, int wr, int wc, int fr, int fq) const {
        bf16_t* XB = (bf16_t*)(ws + B_XB1); float* SSo = (float*)(ws + WS_SS); const float* SSi = SSo + (size_t)MTOK * 16; const bf16_t* E = (const bf16_t*)(ws + B_E); const float* SSE = (const float*)(ws + B_SSE);
        const int row0 = u.pm * BM + wr * 64 + fr, col0 = u.pn * BM + wc * 32 + 4 * fq;
#pragma unroll
        for (int ai = 0; ai < 2; ++ai)
#pragma unroll
            for (int m = 0; m < 4; ++m) { asm volatile("" ::: "memory");
                const int row = row0 + ai * HALF + m * 16; float ssq = 0.f;
                const float rs = rowscale(SSi + (size_t)row * 16, 4, fq, 1.0f / 1024.0f), re = rowscale(SSE + (size_t)row * 16, 4, fq, 1.0f / 1024.0f);
#pragma unroll
                for (int bj = 0; bj < 2; ++bj)
#pragma unroll
                    for (int n = 0; n < 2; ++n) {
                        const int col = col0 + bj * HALF + n * 16; const size_t off = (size_t)row * 1024 + col;
                        f32x4 hv = *(const f32x4*)(H + off); const u32x2 ew = *(const u32x2*)(E + off); const f32x4 gp = *(const f32x4*)(gpost + col);
                        const f32x4 a = acc[ai][bj][m][n] * rs;
                        hv[0] += sigmoidf_(a[0]) * (__builtin_bit_cast(float, ew.x << 16) * re * gp[0]);
                        hv[1] += sigmoidf_(a[1]) * (__builtin_bit_cast(float, ew.x & 0xffff0000u) * re * gp[1]);
                        hv[2] += sigmoidf_(a[2]) * (__builtin_bit_cast(float, ew.y << 16) * re * gp[2]);
                        hv[3] += sigmoidf_(a[3]) * (__builtin_bit_cast(float, ew.y & 0xffff0000u) * re * gp[3]);
                        *(f32x4*)(H + off) = hv;
                        u32x2 w; w.x = cvt_pk_bf16(hv[0], hv[1]); w.y = cvt_pk_bf16(hv[2], hv[3]); *(u32x2*)(XB + off) = w;
                        ssq += (hv[0] * hv[0] + hv[1] * hv[1]) + (hv[2] * hv[2] + hv[3] * hv[3]);
                    }
                ssq = sum_fq(ssq);
                if (fq == 0) SSo[(size_t)row * 16 + u.pn * 4 + wc] = ssq;
            }
    }
};

template <class Epi, class Sched, bool ALIGN_EPI = false, bool SP2 = false>
__device__ __forceinline__ void gemm_phase(PG8_LAS unsigned char* lds, const Gemm g, const Sched& S, const Epi& E) {
    const int tid = opaque_tid(), wid = __builtin_amdgcn_readfirstlane(tid >> 6), lane = tid & 63, wr = wid >> 2, wc = wid & 3, fr = lane & 15, fq = lane >> 4;
    int K_ = g.K; asm volatile("" : "+s"(K_)); const int K = K_, nt = K / BK;
    unsigned voffA[2], voffB[2];
#pragma unroll
    for (int i = 0; i < 2; ++i) { int R, C; stage_rc(tid * 16 + i * 8192, R, C); const int Rb = Epi::PERM ? ((R & ~31) + perm32(R & 31)) : R;
        voffA[i] = (unsigned)(R * K + C) * 2u; voffB[i] = (unsigned)(Rb * K + C) * 2u; }
    const size_t kstep = (size_t)(BK * 2);
    const size_t hstep = (size_t)HALF * K * 2;
    const size_t tstep = 2 * hstep;
    const unsigned ldsw = (unsigned)wid * 1024u;
    const int aoff = lds_byte(wr * 64 + fr, fq * 8), boff = lds_byte(wc * 32 + fr, fq * 8);
#define PG8_SA(b, h) (((b) * 2 + (h)) * HTB)
#define PG8_SB(b, h) ((4 + (b) * 2 + (h)) * HTB)
#define PG8_STAGE(bufoff, gbase, voff) do { _Pragma("unroll") for (int _i = 0; _i < 2; ++_i) \
        __builtin_amdgcn_global_load_lds((const unsigned*)((const char*)(gbase) + (voff)[_i]), (PG8_LAS unsigned*)(lds + (bufoff) + ldsw + _i * 8192), 16, 0, 0); } while (0)
#define PG8_LDA(dst, b, h) do { _Pragma("unroll") for (int m = 0; m < 4; ++m) _Pragma("unroll") for (int k = 0; k < 2; ++k) dst[m][k] = *(const PG8_LAS bf16x8*)(lds + PG8_SA(b, h) + aoff + m * 2048 + k * 1024); } while (0)
#define PG8_LDB(dst, b, h) do { _Pragma("unroll") for (int n = 0; n < 2; ++n) _Pragma("unroll") for (int k = 0; k < 2; ++k) dst[n][k] = *(const PG8_LAS bf16x8*)(lds + PG8_SB(b, h) + boff + n * 2048 + k * 1024); } while (0)
#define PG8_MMA(ai, bj, At, Bt) do { __builtin_amdgcn_s_setprio(1); _Pragma("unroll") for (int m = 0; m < 4; ++m) _Pragma("unroll") for (int n = 0; n < 2; ++n) _Pragma("unroll") for (int k = 0; k < 2; ++k) \
        acc[ai][bj][m][n] = __builtin_amdgcn_mfma_f32_16x16x32_bf16(Bt[n][k], At[m][k], acc[ai][bj][m][n], 0, 0, 0); __builtin_amdgcn_s_setprio(0); } while (0)
#define PG8_WAIT_V(n) asm volatile("s_waitcnt vmcnt(" #n ")" ::: "memory")
#define PG8_WAIT_L(n) asm volatile("s_waitcnt lgkmcnt(" #n ")" ::: "memory")
#define PG8_BAR __builtin_amdgcn_s_barrier()
#define PG8_SCHED __builtin_amdgcn_sched_barrier(0)
    Unit cur, nxt; int ui = 0;
    if (!S.next(0, cur)) return;
    f32x4 acc[2][2][4][2];
#pragma unroll
    for (int a = 0; a < 2; ++a)
#pragma unroll
        for (int b = 0; b < 2; ++b)
#pragma unroll
            for (int m = 0; m < 4; ++m)
#pragma unroll
                for (int n = 0; n < 2; ++n) acc[a][b][m][n] = (f32x4){0.f, 0.f, 0.f, 0.f};
    bf16x8 At[4][2], B0[2][2], B1[2][2];
    const char* cA = (const char*)g.A + (size_t)cur.pm * tstep; const char* cB = (const char*)g.Bt + (size_t)cur.pn * tstep;
    S.a_ready(cur);
    if constexpr (SP2) {
        PG8_STAGE(PG8_SB(0, 0), cB, voffB); PG8_STAGE(PG8_SB(0, 1), cB + hstep, voffB); PG8_STAGE(PG8_SA(0, 0), cA, voffA); PG8_STAGE(PG8_SA(0, 1), cA + hstep, voffA);
        if (wr == 1) PG8_BAR;
        PG8_WAIT_V(2); PG8_BAR;
        PG8_STAGE(PG8_SB(1, 0), cB + kstep, voffB); PG8_STAGE(PG8_SA(1, 0), cA + kstep, voffA); PG8_STAGE(PG8_SB(1, 1), cB + hstep + kstep, voffB);
        PG8_WAIT_V(6); PG8_BAR;
    } else {
        PG8_STAGE(PG8_SB(0, 0), cB, voffB); PG8_STAGE(PG8_SA(0, 0), cA, voffA); PG8_STAGE(PG8_SB(0, 1), cB + hstep, voffB); PG8_STAGE(PG8_SA(0, 1), cA + hstep, voffA);
        if (wr == 1) PG8_BAR;
        PG8_WAIT_V(4); PG8_BAR;
        PG8_STAGE(PG8_SB(1, 0), cB + kstep, voffB); PG8_STAGE(PG8_SA(1, 0), cA + kstep, voffA); PG8_STAGE(PG8_SB(1, 1), cB + hstep + kstep, voffB);
        PG8_WAIT_V(6); PG8_BAR;
    }
    for (;;) {
        const bool has_next = S.next(ui + 1, nxt);
        const char* nA = has_next ? (const char*)g.A + (size_t)nxt.pm * tstep : cA; const char* nB = has_next ? (const char*)g.Bt + (size_t)nxt.pn * tstep : cB;
        for (int t = 0; t < nt; t += 2) {
            const bool last = (t == nt - 2);
            const char* a1 = cA + (size_t)(t + 1) * kstep;
            const char* a2 = last ? nA : cA + (size_t)(t + 2) * kstep; const char* b2 = last ? nB : cB + (size_t)(t + 2) * kstep;
            const char* a3 = a2 + kstep; const char* b3 = b2 + kstep;
            if (last && has_next) S.a_ready(nxt);
            if constexpr (SP2) {
            PG8_LDB(B0, 0, 0); PG8_LDB(B1, 0, 1); PG8_SCHED; PG8_LDA(At, 0, 0); PG8_STAGE(PG8_SA(1, 1), a1 + hstep, voffA);
            PG8_WAIT_V(8); PG8_WAIT_L(0); PG8_BAR; PG8_MMA(0, 0, At, B0); PG8_MMA(0, 1, At, B1); PG8_BAR; PG8_SCHED;
            PG8_LDA(At, 0, 1); PG8_STAGE(PG8_SB(0, 0), b2, voffB); PG8_STAGE(PG8_SB(0, 1), b2 + hstep, voffB); PG8_STAGE(PG8_SA(0, 0), a2, voffA);
            PG8_WAIT_V(8); PG8_WAIT_L(0); PG8_BAR; PG8_MMA(1, 0, At, B0); PG8_MMA(1, 1, At, B1); PG8_BAR; PG8_SCHED;
            PG8_LDB(B0, 1, 0); PG8_LDB(B1, 1, 1); PG8_SCHED; PG8_LDA(At, 1, 0); PG8_STAGE(PG8_SA(0, 1), a2 + hstep, voffA);
            PG8_WAIT_V(8); PG8_WAIT_L(0); PG8_BAR; PG8_MMA(0, 0, At, B0); PG8_MMA(0, 1, At, B1); PG8_BAR; PG8_SCHED;
            PG8_LDA(At, 1, 1); PG8_STAGE(PG8_SB(1, 0), b3, voffB); PG8_STAGE(PG8_SB(1, 1), b3 + hstep, voffB); PG8_STAGE(PG8_SA(1, 0), a3, voffA);
            PG8_WAIT_V(8); PG8_WAIT_L(0); PG8_BAR; PG8_MMA(1, 0, At, B0); PG8_MMA(1, 1, At, B1); PG8_BAR; PG8_SCHED;
            } else {
            PG8_LDB(B0, 0, 0); PG8_SCHED; PG8_LDA(At, 0, 0); PG8_STAGE(PG8_SA(1, 1), a1 + hstep, voffA);
            PG8_WAIT_L(8); PG8_BAR; PG8_WAIT_L(0); PG8_MMA(0, 0, At, B0); PG8_BAR; PG8_SCHED;
            PG8_LDB(B1, 0, 1); PG8_STAGE(PG8_SB(0, 0), b2, voffB);
            PG8_BAR; PG8_WAIT_L(0); PG8_MMA(0, 1, At, B1); PG8_BAR;
            PG8_LDA(At, 0, 1); PG8_STAGE(PG8_SA(0, 0), a2, voffA);
            PG8_BAR; PG8_WAIT_L(0); PG8_MMA(1, 0, At, B0); PG8_BAR; PG8_SCHED;
            PG8_STAGE(PG8_SB(0, 1), b2 + hstep, voffB);
            PG8_WAIT_V(6); PG8_BAR; PG8_MMA(1, 1, At, B1); PG8_BAR;
            PG8_LDB(B0, 1, 0); PG8_SCHED; PG8_LDA(At, 1, 0); PG8_STAGE(PG8_SA(0, 1), a2 + hstep, voffA);
            PG8_WAIT_L(8); PG8_BAR; PG8_WAIT_L(0); PG8_MMA(0, 0, At, B0); PG8_BAR; PG8_SCHED;
            PG8_LDB(B1, 1, 1); PG8_STAGE(PG8_SB(1, 0), b3, voffB);
            PG8_BAR; PG8_WAIT_L(0); PG8_MMA(0, 1, At, B1); PG8_BAR;
            PG8_LDA(At, 1, 1); PG8_STAGE(PG8_SA(1, 0), a3, voffA);
            PG8_BAR; PG8_WAIT_L(0); PG8_MMA(1, 0, At, B0); PG8_BAR; PG8_SCHED;
            PG8_STAGE(PG8_SB(1, 1), b3 + hstep, voffB);
            PG8_WAIT_V(6); PG8_BAR; PG8_MMA(1, 1, At, B1); PG8_BAR;
            }
        }
        if constexpr (ALIGN_EPI) { if (wr == 0) PG8_BAR; }
        if constexpr (!Epi::AFTER_DRAIN) { E(acc, cur, wr, wc, fr, fq); S.done(cur); }
        if (!has_next) break;
#pragma unroll
        for (int a = 0; a < 2; ++a)
#pragma unroll
            for (int b = 0; b < 2; ++b)
#pragma unroll
                for (int m = 0; m < 4; ++m)
#pragma unroll
                    for (int n = 0; n < 2; ++n) acc[a][b][m][n] = (f32x4){0.f, 0.f, 0.f, 0.f};
        cur = nxt; cA = nA; cB = nB; ++ui;
        if constexpr (ALIGN_EPI) { if (wr == 1) PG8_BAR; }
    }
    PG8_WAIT_V(0);
    if constexpr (!ALIGN_EPI) { if (wr == 0) PG8_BAR; }
    PG8_BAR;
    if constexpr (Epi::AFTER_DRAIN) { E.fused(acc, cur, wr, wc, fr, fq, lds, wid, lane); S.done(cur); }
#undef PG8_SA
#undef PG8_SB
#undef PG8_STAGE
#undef PG8_LDA
#undef PG8_LDB
#undef PG8_MMA
#undef PG8_WAIT_V
#undef PG8_WAIT_L
#undef PG8_BAR
#undef PG8_SCHED
}
}
#define XB_TMO      128
#define XB_XCNT(j)  (256  + 64 * (j))
#define XB_XSUB(j)  (1280 + 64 * (j))
#define XB_XGEN(j)  (2304 + 64 * (j))
#define XB_TOP      3328
#define XB_TOPGEN   3392
#define XCD_BAR_WORDS 3456
#define XB_SPIN_CAP (1u << 18)

__device__ __forceinline__ unsigned xb_ld(unsigned* p)              { return __hip_atomic_load(p, __ATOMIC_RELAXED, __HIP_MEMORY_SCOPE_AGENT); }
__device__ __forceinline__ unsigned xb_add(unsigned* p, unsigned v) { return __hip_atomic_fetch_add(p, v, __ATOMIC_RELAXED, __HIP_MEMORY_SCOPE_AGENT); }
__device__ __forceinline__ unsigned xb_xcc_id() { return (unsigned)__builtin_amdgcn_s_getreg((3 << 11) | 20) & 0xFu; }
#define XB_SPIN(cond, bar) do { unsigned _sp = 0; while (cond) { __builtin_amdgcn_s_sleep(1); \
    if ((++_sp & 255u) == 0u) { if (xb_ld(&(bar)[XB_TMO])) break; if (_sp > XB_SPIN_CAP) { atomicAdd(&(bar)[XB_TMO], 1u); break; } } } } while (0)

struct XcdBarrier {
    unsigned* bar; unsigned x;
    volatile LAS unsigned* st;
};

__device__ __forceinline__ XcdBarrier xcd_barrier_post(unsigned* bar, volatile LAS unsigned* st) {
    XcdBarrier b; b.bar = bar; b.x = xb_xcc_id(); b.st = st;
    if (threadIdx.x == 0) (void)xb_add(&bar[XB_XCNT(b.x)], 1u);
    return b;
}
__device__ __forceinline__ void xcd_barrier_complete(unsigned* bar, unsigned x, unsigned& nloc, unsigned& nx) {
    const unsigned G = gridDim.x * gridDim.y * gridDim.z;
    unsigned sum, cnt, mine, sp = 0u;
    for (;;) {
        sum = 0u; cnt = 0u; mine = 0u;
#pragma unroll
        for (unsigned j = 0; j < 16; ++j) { const unsigned c = xb_ld(&bar[XB_XCNT(j)]); sum += c; cnt += (c > 0u) ? 1u : 0u; mine = (j == x) ? c : mine; }
        if (sum == G) break;
        __builtin_amdgcn_s_sleep(1);
        if ((++sp & 255u) == 0u) { if (xb_ld(&bar[XB_TMO])) break; if (sp > XB_SPIN_CAP) { atomicAdd(&bar[XB_TMO], 1u); break; } }
    }
    nloc = mine > 0u ? mine : 1u; nx = cnt > 0u ? cnt : 1u;
}

__device__ __forceinline__ void xcd_barrier(const XcdBarrier& b) {
    asm volatile("s_waitcnt vmcnt(0)" ::: "memory");
    __syncthreads();
    if (threadIdx.x == 0) {
        unsigned* bar = b.bar;
        __builtin_amdgcn_s_waitcnt(0);
        unsigned nloc = b.st[0], nx = b.st[1];
        if (nloc == 0u) { xcd_barrier_complete(bar, b.x, nloc, nx); b.st[0] = nloc; b.st[1] = nx; }
        const unsigned old = xb_add(&bar[XB_XSUB(b.x)], 1u);
        const unsigned gen = old / nloc;
        if (old + 1u == (gen + 1u) * nloc) {
            __builtin_amdgcn_fence(__ATOMIC_RELEASE, "agent");
            asm volatile("s_waitcnt vmcnt(0)" ::: "memory");
            const unsigned og = xb_add(&bar[XB_TOP], 1u);
            const unsigned tg = og / nx;
            if (og + 1u == (tg + 1u) * nx) xb_add(&bar[XB_TOPGEN], 1u);
            else XB_SPIN(xb_ld(&bar[XB_TOPGEN]) == tg, bar);
            __builtin_amdgcn_fence(__ATOMIC_ACQUIRE, "agent");
            xb_add(&bar[XB_XGEN(b.x)], 1u);
            asm volatile("s_waitcnt vmcnt(0)" ::: "memory");
        } else {
            XB_SPIN(xb_ld(&bar[XB_XGEN(b.x)]) == gen, bar);
            __builtin_amdgcn_fence(__ATOMIC_ACQUIRE, "agent");
            asm volatile("s_waitcnt vmcnt(0)" ::: "memory");
        }
    }
    __syncthreads();
}
typedef short bf16x8 __attribute__((ext_vector_type(8)));
typedef float f32x4 __attribute__((ext_vector_type(4)));
typedef float f32x16 __attribute__((ext_vector_type(16)));
struct Frame {
    LAS unsigned char* lds;
    volatile LAS unsigned* MISC;
    int tid, lane, wave;
    int vcu, G;
    unsigned char* ws;
    const void* const* in_unused;
};
__device__ __forceinline__ float wave_sum(float v, int lane) {
#pragma unroll
    for (int o = 1; o < 64; o <<= 1) v += bperm(lane ^ o, v);
    return v;
}
__device__ __forceinline__ float wave_max(float v, int lane) {
#pragma unroll
    for (int o = 1; o < 64; o <<= 1) v = fmaxf(v, bperm(lane ^ o, v));
    return v;
}
__device__ __forceinline__ float wave_incl_sum(float v, int lane) {
#pragma unroll
    for (int o = 1; o < 64; o <<= 1) { const float t = bperm(lane >= o ? lane - o : lane, v); if (lane >= o) v += t; }
    return v;
}
__device__ __forceinline__ float wave_incl_max(float v, int lane) {
#pragma unroll
    for (int o = 1; o < 64; o <<= 1) { const float t = bperm(lane >= o ? lane - o : lane, v); if (lane >= o) v = fmaxf(v, t); }
    return v;
}
__device__ __forceinline__ float lane_bcast(float v, int src) { return __int_as_float(__builtin_amdgcn_readlane(__float_as_int(v), src)); }
__device__ __forceinline__ float logsigmoidf_(float x) { return fminf(x, 0.f) - log1pf(__expf(-fabsf(x))); }
__device__ __forceinline__ int crow32(int r, int hi) { return (r & 3) + 8 * (r >> 2) + 4 * hi; }
__device__ __forceinline__ void unpack8(const v4u w, float (&f)[8]) {
    f[0] = bflo(w.x); f[1] = bfhi(w.x); f[2] = bflo(w.y); f[3] = bfhi(w.y); f[4] = bflo(w.z); f[5] = bfhi(w.z); f[6] = bflo(w.w); f[7] = bfhi(w.w);
}
__device__ __forceinline__ v4u pack8(const float (&f)[8]) { v4u w; w.x = pk2(f[0], f[1]); w.y = pk2(f[2], f[3]); w.z = pk2(f[4], f[5]); w.w = pk2(f[6], f[7]); return w; }

__device__ __forceinline__ f32x16 mma_tile(const LAS bf16* A, int lda, const LAS bf16* Bt, int ldb, int K, int lane) {
    const int r = lane & 31, hh = lane >> 5; f32x16 acc = {};
    const LAS bf16* ap = A + r * lda + 8 * hh; const LAS bf16* bp = Bt + r * ldb + 8 * hh;
    for (int k0 = 0; k0 < K; k0 += 16) {
        const bf16x8 a = *(const LAS bf16x8*)(ap + k0), b = *(const LAS bf16x8*)(bp + k0);
        acc = __builtin_amdgcn_mfma_f32_32x32x16_bf16(a, b, acc, 0, 0, 0);
    }
    return acc;
}

__device__ __forceinline__ int cvt_dst_row(int mode, int row0, int n) {
    if (mode == 0) return row0 + n;
    if (mode == 1) return row0 + 2 * n;
    if (mode == 2) return row0 + (n & ~63) + 2 * (n & 31) + ((n >> 5) & 1);
    const int blk = n / 192, p = n - blk * 192;
    return row0 + blk * 192 + (p < 128 ? p : 128 + 2 * ((p - 128) & 31) + ((p - 128) >> 5));
}
struct CvtJob { const float* W; int ldw, K, src_col0, ncols; bf16* WT; int ldd, row0, mode; const float* gain; };
__device__ __forceinline__ void cvt_item(const CvtJob& J, LAS float* scr, int item, int lane) {
    const int nblk = J.ncols / 32, kb = item / nblk, nb = item - kb * nblk, k0 = 64 * kb, n0 = 32 * nb;
#pragma unroll 8
    for (int i = 0; i < 32; ++i) { const int kk = 2 * i + (lane >> 5); float v = J.W[(size_t)(k0 + kk) * J.ldw + J.src_col0 + n0 + (lane & 31)]; if (J.gain) v *= J.gain[k0 + kk]; scr[kk * 33 + (lane & 31)] = v; }
    LDS_WAIT(); asm volatile("" ::: "memory");
    const int c = lane & 7;
#pragma unroll
    for (int j = 0; j < 4; ++j) { const int n = (lane >> 3) + 8 * j; const LAS float* s = scr + (8 * c) * 33 + n;
        v4u o; o.x = pk2(s[0 * 33], s[1 * 33]); o.y = pk2(s[2 * 33], s[3 * 33]); o.z = pk2(s[4 * 33], s[5 * 33]); o.w = pk2(s[6 * 33], s[7 * 33]);
        *(GAS v4u*)(J.WT + (size_t)cvt_dst_row(J.mode, J.row0, n0 + n) * J.ldd + k0 + 8 * c) = o; }
    LDS_WAIT(); asm volatile("" ::: "memory");
}
__device__ __forceinline__ void cvt_job(Frame& F, const CvtJob& J) {
    LAS float* scr = (LAS float*)(F.lds + F.wave * 16384);
    const int gw = F.vcu * 8 + F.wave, NGW = F.G * 8, nitems = (J.K / 64) * (J.ncols / 32);
    for (int it = gw; it < nitems; it += NGW) cvt_item(J, scr, it, F.lane);
}

namespace att {
using bf16x8 = __attribute__((ext_vector_type(8))) short;
using s16x4  = __attribute__((ext_vector_type(4))) short;
using f32x16 = __attribute__((ext_vector_type(16))) float;
using u32x4  = __attribute__((ext_vector_type(4))) unsigned;
constexpr int NW = 8, QBLK = 32, KVBLK = 64;
constexpr float SCALE = 0.07216878364870322f;
constexpr float THR = 8.f;
constexpr int LDQ = 768, LDKN = 512, LDKR = 64, LDV = 512, LDO = 1280;
constexpr int SHM_V = KVBLK * 128 * 2, SHM_KN = KVBLK * 128 * 2, SHM_KR = KVBLK * 64 * 2;
constexpr int OFF_V = 0, OFF_KN = 2 * SHM_V, OFF_KR = OFF_KN + 2 * SHM_KN, OFF_WS = OFF_KR + 2 * SHM_KR, OFF_QR = OFF_WS + NW * 64 * 4, NQR = ATT_NQR, QR_PITCH = (12 - NQR) * 32 + 16, QR_WAVE = 32 * QR_PITCH, SHM_ATTN = OFF_QR + NW * QR_WAVE;
#define KSWZ(row, colB) ((row) * 256 + ((colB) ^ (((row) & 7) << 4)))
#define KRSWZ(row, colB) ((row) * 128 + ((colB) ^ (((row) & 7) << 4)))
#define SBAR() __builtin_amdgcn_sched_barrier(0)
__device__ __forceinline__ int crow(int r, int hi) { return (r & 3) + 8 * (r >> 2) + 4 * hi; }
__device__ __forceinline__ unsigned cvtpk(float lo, float hi) { unsigned r; asm volatile("v_cvt_pk_bf16_f32 %0, %1, %2" : "=v"(r) : "v"(lo), "v"(hi)); return r; }

__device__ __forceinline__ void partialSM(f32x16& p0, f32x16& p1, float& m_reg, float& mn, float& alpha) {
  constexpr float C = SCALE * 1.4426950408889634f;
  float pmax = p0[0];
#pragma unroll
  for (int r = 1; r < 16; ++r) pmax = fmaxf(pmax, p0[r]);
#pragma unroll
  for (int r = 0; r < 16; ++r) pmax = fmaxf(pmax, p1[r]);
  { auto rr = __builtin_amdgcn_permlane32_swap(__float_as_uint(pmax), __float_as_uint(pmax), false, false);
    pmax = fmaxf(__uint_as_float(rr[0]), __uint_as_float(rr[1])); }
  if (__builtin_expect(__all(pmax - m_reg <= THR / SCALE), 1)) { mn = m_reg; alpha = 1.f; }
  else { mn = fmaxf(m_reg, pmax); alpha = __builtin_amdgcn_exp2f((m_reg - mn) * C); m_reg = mn; }
  float mnC = -mn * C;
#pragma unroll
  for (int r = 0; r < 16; ++r) p0[r] = fmaf(p0[r], C, mnC);
#pragma unroll
  for (int r = 0; r < 16; ++r) p1[r] = fmaf(p1[r], C, mnC);
#pragma unroll
  for (int r = 0; r < 16; ++r) p0[r] = __builtin_amdgcn_exp2f(p0[r]);
}
__device__ __forceinline__ void finishSM(f32x16& p0, f32x16& p1, float alpha, float& l_reg, bf16x8& pa0, bf16x8& pa1, bf16x8& pa2, bf16x8& pa3) {
#pragma unroll
  for (int r = 0; r < 16; ++r) p1[r] = __builtin_amdgcn_exp2f(p1[r]);
  float ps = 0;
#pragma unroll
  for (int r = 0; r < 16; ++r) ps += p0[r];
#pragma unroll
  for (int r = 0; r < 16; ++r) ps += p1[r];
  { auto rr = __builtin_amdgcn_permlane32_swap(__float_as_uint(ps), __float_as_uint(ps), false, false);
    ps = __uint_as_float(rr[0]) + __uint_as_float(rr[1]); }
  l_reg = l_reg * alpha + ps;
#define PK4(P, BASE, OUT) do { unsigned a0 = cvtpk(P[BASE + 0], P[BASE + 1]), a1 = cvtpk(P[BASE + 2], P[BASE + 3]);   \
    unsigned b0 = cvtpk(P[BASE + 4], P[BASE + 5]), b1 = cvtpk(P[BASE + 6], P[BASE + 7]);                              \
    auto r0 = __builtin_amdgcn_permlane32_swap(a0, b0, false, false); auto r1 = __builtin_amdgcn_permlane32_swap(a1, b1, false, false); \
    u32x4 w = {r0[0], r1[0], r0[1], r1[1]}; OUT = *reinterpret_cast<bf16x8*>(&w); } while (0)
  PK4(p0, 0, pa0); PK4(p0, 8, pa1); PK4(p1, 0, pa2); PK4(p1, 8, pa3);
#undef PK4
}
__device__ __forceinline__ void qkt(f32x16& p0, f32x16& p1, const char* KNs, const char* KRs, const bf16x8* qr, const char* qrl, int r32, int hi) {
  p0 = f32x16{}; p1 = f32x16{};
#pragma unroll
  for (int d0 = 0; d0 < 8; ++d0) { int cb = (d0 * 16 + hi * 8) * 2;
    bf16x8 b0 = *reinterpret_cast<const bf16x8*>(KNs + KSWZ(r32, cb));
    bf16x8 b1 = *reinterpret_cast<const bf16x8*>(KNs + KSWZ(32 + r32, cb));
    bf16x8 qv; if (d0 < NQR) qv = qr[d0]; else qv = *reinterpret_cast<const bf16x8*>(qrl + (d0 - NQR) * 32);
    p0 = __builtin_amdgcn_mfma_f32_32x32x16_bf16(b0, qv, p0, 0, 0, 0);
    p1 = __builtin_amdgcn_mfma_f32_32x32x16_bf16(b1, qv, p1, 0, 0, 0); }
#pragma unroll
  for (int d0 = 0; d0 < 4; ++d0) { int cb = (d0 * 16 + hi * 8) * 2;
    bf16x8 b0 = *reinterpret_cast<const bf16x8*>(KRs + KRSWZ(r32, cb));
    bf16x8 b1 = *reinterpret_cast<const bf16x8*>(KRs + KRSWZ(32 + r32, cb));
    const bf16x8 qv = *reinterpret_cast<const bf16x8*>(qrl + (8 - NQR + d0) * 32);
    p0 = __builtin_amdgcn_mfma_f32_32x32x16_bf16(b0, qv, p0, 0, 0, 0);
    p1 = __builtin_amdgcn_mfma_f32_32x32x16_bf16(b1, qv, p1, 0, 0, 0); }
}
__device__ __forceinline__ int v_st(int k, int c) { const int kk = (k & ~0xC) | ((k & 4) << 1) | ((k & 8) >> 1); return ((kk >> 3) * 4 + (c >> 5)) * 512 + ((kk & 7) * 32 + (c & 31)) * 2; }
__device__ __forceinline__ int v_rd_base(int lane) { return ((lane & 3) << 3) | (((lane >> 2) & 3) << 6) | (((lane >> 4) & 1) << 5) | (((lane >> 5) & 1) << 8); }
constexpr int v_rd_off(int d0, int ks, int half) { return d0 * 512 + ks * 4096 + half * 2048; }
template <int OFF> __device__ __forceinline__ s16x4 tr_read(int vb) {
  s16x4 r; asm volatile("ds_read_b64_tr_b16 %0, %1 offset:%2" : "=&v"(r) : "v"(vb), "i"(OFF) : "memory"); return r;
}
template <int D0> __device__ __forceinline__ void pv_one(f32x16& od, int vb, bf16x8 pa0, bf16x8 pa1, bf16x8 pa2, bf16x8 pa3) {
  const s16x4 l0 = tr_read<v_rd_off(D0, 0, 0)>(vb), h0 = tr_read<v_rd_off(D0, 0, 1)>(vb), l1 = tr_read<v_rd_off(D0, 1, 0)>(vb), h1 = tr_read<v_rd_off(D0, 1, 1)>(vb);
  const s16x4 l2 = tr_read<v_rd_off(D0, 2, 0)>(vb), h2 = tr_read<v_rd_off(D0, 2, 1)>(vb), l3 = tr_read<v_rd_off(D0, 3, 0)>(vb), h3 = tr_read<v_rd_off(D0, 3, 1)>(vb);
  asm volatile("s_waitcnt lgkmcnt(0)" ::: "memory"); SBAR();
#define PK(L, H) (bf16x8){L[0], L[1], L[2], L[3], H[0], H[1], H[2], H[3]}
  od = __builtin_amdgcn_mfma_f32_32x32x16_bf16(pa0, PK(l0, h0), od, 0, 0, 0);
  od = __builtin_amdgcn_mfma_f32_32x32x16_bf16(pa1, PK(l1, h1), od, 0, 0, 0);
  od = __builtin_amdgcn_mfma_f32_32x32x16_bf16(pa2, PK(l2, h2), od, 0, 0, 0);
  od = __builtin_amdgcn_mfma_f32_32x32x16_bf16(pa3, PK(l3, h3), od, 0, 0, 0);
#undef PK
}
__device__ __forceinline__ void pv_d0(f32x16* o, int vb, bf16x8 pa0, bf16x8 pa1, bf16x8 pa2, bf16x8 pa3) {
  pv_one<0>(o[0], vb, pa0, pa1, pa2, pa3); pv_one<1>(o[1], vb, pa0, pa1, pa2, pa3); pv_one<2>(o[2], vb, pa0, pa1, pa2, pa3); pv_one<3>(o[3], vb, pa0, pa1, pa2, pa3);
}

template <int SDEPTH>
__device__ __forceinline__ void attn_dense_body(const bf16* __restrict__ Qb, const bf16* __restrict__ KNh, const bf16* __restrict__ KRb, const bf16* __restrict__ Vh,
                                                bf16* __restrict__ Ob, int seq, char* lds) {
  const int tid = opaque_tid(), wid = tid >> 6, lane = tid & 63, r32 = lane & 31, hi = lane >> 5;
  char* V_lds = lds + OFF_V; char* KN_lds = lds + OFF_KN; char* KR_lds = lds + OFF_KR;
  float* ws = (float*)(lds + OFF_WS) + wid * 64; float* li_l = ws; float* al_l = ws + 32;
  float m_reg = -1e30f, l_reg = 0; f32x16 o[4] = {}; bf16x8 qr[NQR];
  const bf16* Qw = Qb + (long)(wid * QBLK + r32) * LDQ + hi * 8;
#pragma unroll
  for (int d0 = 0; d0 < NQR; ++d0) qr[d0] = *reinterpret_cast<const bf16x8*>(Qw + d0 * 16);
  char* qrl = lds + OFF_QR + wid * QR_WAVE + r32 * QR_PITCH + hi * 16;
#pragma unroll
  for (int d0 = NQR; d0 < 12; ++d0) *reinterpret_cast<bf16x8*>(qrl + (d0 - NQR) * 32) = *reinterpret_cast<const bf16x8*>(Qw + d0 * 16);
  const int sr = tid >> 4, sc = (tid & 15) * 8, vst0 = v_st(sr, sc), vst1 = v_st(32 + sr, sc);
  const int rr_ = tid >> 3, rc = (tid & 7) * 8;
  const int vb0 = (int)(uintptr_t)V_lds + v_rd_base(lane);
  struct { bf16x8 vs0, vs1, ks0, ks1, kr; } sr_[SDEPTH];
#define SLOAD(i, k0) do { sr_[i].vs0 = *reinterpret_cast<const bf16x8*>(&Vh[(long)((k0) + sr) * LDV + sc]); sr_[i].vs1 = *reinterpret_cast<const bf16x8*>(&Vh[(long)((k0) + 32 + sr) * LDV + sc]); \
    sr_[i].ks0 = *reinterpret_cast<const bf16x8*>(&KNh[(long)((k0) + sr) * LDKN + sc]); sr_[i].ks1 = *reinterpret_cast<const bf16x8*>(&KNh[(long)((k0) + 32 + sr) * LDKN + sc]); \
    sr_[i].kr = *reinterpret_cast<const bf16x8*>(&KRb[(long)((k0) + rr_) * LDKR + rc]); } while (0)
#define SWRITE(b, i) do { *(bf16x8*)(V_lds + (b) * SHM_V + vst0) = sr_[i].vs0; *(bf16x8*)(V_lds + (b) * SHM_V + vst1) = sr_[i].vs1; int kc = sc * 2; \
    *(bf16x8*)(KN_lds + (b) * SHM_KN + KSWZ(sr, kc)) = sr_[i].ks0; *(bf16x8*)(KN_lds + (b) * SHM_KN + KSWZ(32 + sr, kc)) = sr_[i].ks1; \
    *(bf16x8*)(KR_lds + (b) * SHM_KR + KRSWZ(rr_, rc * 2)) = sr_[i].kr; } while (0)
#define SWAIT() do { if constexpr (SDEPTH == 2) asm volatile("s_waitcnt vmcnt(5)" ::: "memory"); else asm volatile("s_waitcnt vmcnt(0)" ::: "memory"); } while (0)
#define RESC(a) do { if (__any((a) < 1.f)) { if (hi == 0) al_l[r32] = (a); asm volatile("s_waitcnt lgkmcnt(0)" ::: "memory"); \
    _Pragma("unroll") for (int d = 0; d < 4; ++d) _Pragma("unroll") for (int r = 0; r < 16; ++r) o[d][r] *= al_l[crow(r, hi)]; } } while (0)
  f32x16 pA0, pA1, pB0, pB1; float mnA, mnB, alA, alB; bf16x8 pa0, pa1, pa2, pa3; const int NT = seq / KVBLK;
  constexpr int SE = 0, SO = SDEPTH - 1;
  SLOAD(SE, 0); asm volatile("s_waitcnt vmcnt(0)" ::: "memory"); SWRITE(0, SE); __syncthreads();
  qkt(pA0, pA1, KN_lds, KR_lds, qr, qrl, r32, hi); partialSM(pA0, pA1, m_reg, mnA, alA);
  SLOAD(SO, KVBLK); if constexpr (SDEPTH == 2) { if (2 < NT) SLOAD(SE, 2 * KVBLK); }
  SWAIT(); SWRITE(1, SO); __syncthreads();
  for (int j = 1; j + 1 < NT; j += 2) {
    SBAR(); qkt(pB0, pB1, KN_lds + SHM_KN, KR_lds + SHM_KR, qr, qrl, r32, hi);
    finishSM(pA0, pA1, alA, l_reg, pa0, pa1, pa2, pa3); SBAR();
    SLOAD(SO, (j + SDEPTH) * KVBLK); SBAR();
    pv_d0(o, vb0, pa0, pa1, pa2, pa3); partialSM(pB0, pB1, m_reg, mnB, alB);
    __syncthreads(); SWAIT(); SWRITE(0, SE);
    RESC(alB); __syncthreads();
    SBAR(); qkt(pA0, pA1, KN_lds, KR_lds, qr, qrl, r32, hi);
    finishSM(pB0, pB1, alB, l_reg, pa0, pa1, pa2, pa3); SBAR();
    if (SDEPTH == 1 || j + 3 < NT) SLOAD(SE, (j + 1 + SDEPTH) * KVBLK); SBAR();
    pv_d0(o, vb0 + SHM_V, pa0, pa1, pa2, pa3); partialSM(pA0, pA1, m_reg, mnA, alA);
    __syncthreads(); SWAIT(); SWRITE(1, SO);
    RESC(alA); __syncthreads();
  }
  SBAR(); qkt(pB0, pB1, KN_lds + SHM_KN, KR_lds + SHM_KR, qr, qrl, r32, hi);
  finishSM(pA0, pA1, alA, l_reg, pa0, pa1, pa2, pa3); SBAR();
  pv_d0(o, vb0, pa0, pa1, pa2, pa3); partialSM(pB0, pB1, m_reg, mnB, alB);
  __syncthreads(); RESC(alB);
  finishSM(pB0, pB1, alB, l_reg, pa0, pa1, pa2, pa3); SBAR();
  pv_d0(o, vb0 + SHM_V, pa0, pa1, pa2, pa3);
  if (hi == 0) li_l[r32] = l_reg; asm volatile("s_waitcnt lgkmcnt(0)" ::: "memory");
  float rli[16];
#pragma unroll
  for (int r = 0; r < 16; ++r) rli[r] = __builtin_amdgcn_rcpf(li_l[crow(r, hi)]);
  bf16* Ow = Ob + (long)(wid * QBLK) * LDO;
#pragma unroll
  for (int r = 0; r < 16; ++r) { int orow = crow(r, hi);
#pragma unroll
    for (int d0 = 0; d0 < 4; ++d0) Ow[(long)orow * LDO + d0 * 32 + r32] = (bf16)f2bf(o[d0][r] * rli[r]); }
  __syncthreads();
#undef SLOAD
#undef SWRITE
#undef SWAIT
#undef RESC
}
#undef KSWZ
#undef KRSWZ
#undef SBAR
}

constexpr int PTAB_OFF = MISC_OFF + 256;
enum { IN_x = 0, IN_p, IN_pos, IN_ffn1_norm, IN_ffn1_wg, IN_ffn1_wu, IN_ffn1_wd, IN_mix_norm, IN_w_in, IN_q_norm, IN_w_uq, IN_kv_norm, IN_w_ukv, IN_conv_w, IN_conv_b, IN_mw_q, IN_mw_k, IN_i_bias, IN_f_bias,
       IN_head_norm, IN_skip, IN_fnet_w, IN_fnet_b, IN_w_out, IN_ffn2_norm, IN_ffn2_wg, IN_ffn2_wu, IN_ffn2_wd, IN_pg_norm, IN_ple_wg, IN_ple_wp, IN_ple_post, IN_final_norm };
__device__ __forceinline__ const float* inp(const Frame& F, int k) {
    const LAS unsigned* t = (const LAS unsigned*)(F.lds + PTAB_OFF) + 2 * k;
    const unsigned lo = __builtin_amdgcn_readfirstlane(t[0]), hi = __builtin_amdgcn_readfirstlane(t[1]);
    return (const float*)(((unsigned long long)hi << 32) | lo);
}

__device__ __forceinline__ void prologue_a(Frame& F, float* H) {
    unsigned char* ws = F.ws;
    float* ropec = (float*)(ws + WS_ROPEC); float* ropes = (float*)(ws + WS_ROPES);
    const int gt = F.vcu * 512 + F.tid, NGT = F.G * 512;
    const int* pos_ = (const int*)inp(F, IN_pos); const float* x_ = inp(F, IN_x); const float* wout_ = inp(F, IN_w_out); const float* fw_ = inp(F, IN_fnet_w); const float* fb_ = inp(F, IN_fnet_b);
    for (int i = gt; i < MTOK * 32; i += NGT) {
        const int row = i >> 5, j = i & 31;
        const float inv = 1.0f / powf(10000.0f, (float)(2 * j) / 64.0f);
        const float ang = (float)pos_[row] * inv;
        const double rev = (double)ang * 0.15915494309189535;
        const float fr = (float)(rev - floor(rev));
        ropec[i] = __builtin_amdgcn_cosf(fr); ropes[i] = __builtin_amdgcn_sinf(fr);
    }
    bf16* XB1 = (bf16*)(ws + B_XB1); float* SS0 = (float*)(ws + WS_SS);
    const int gw = F.vcu * 8 + F.wave, NGW = F.G * 8;
    for (int m = gw; m < MTOK; m += NGW) {
        const GAS f32x4* xr = (const GAS f32x4*)(x_ + (size_t)m * DM) + F.lane;
        GAS f32x4* hr = (GAS f32x4*)(H + (size_t)m * DM) + F.lane;
        GAS v2u* o8 = (GAS v2u*)(XB1 + (size_t)m * DM) + F.lane;
        float s = 0.f;
#pragma unroll
        for (int j = 0; j < 4; ++j) { const f32x4 v = xr[64 * j]; hr[64 * j] = v; v2u w; w.x = pk2(v[0], v[1]); w.y = pk2(v[2], v[3]); o8[64 * j] = w; s += (v[0] * v[0] + v[1] * v[1]) + (v[2] * v[2] + v[3] * v[3]); }
        s += bperm(F.lane ^ 1, s); s += bperm(F.lane ^ 2, s);
        if ((F.lane & 3) == 0) SS0[(size_t)m * 16 + (F.lane >> 2)] = s;
    }
    for (int l = 0; l < DEPTH; ++l) {
        CvtJob J{wout_ + (size_t)l * DM * DM, DM, 768, 0, DM, (bf16*)(ws + WS_WOUT) + (size_t)l * DM * KOUT, KOUT, 0, 0, nullptr};
        cvt_job(F, J);
    }
    float* F1 = (float*)(ws + B_F1); float* BO = (float*)(ws + WS_BOUT);
    for (int i = gt; i < DEPTH * 4 * 64 * DM; i += NGT) {
        const int n = i & 1023, cp = (i >> 10) & 63, g = (i >> 16) & 3, l = i >> 18;
        const float* fw = fw_ + ((size_t)(l * 4 + g) * 64 + cp) * 64; const float* wo = wout_ + ((size_t)l * DM + 768 + 64 * g) * DM + n;
        float a = 0.f;
#pragma unroll 8
        for (int e = 0; e < 64; ++e) a += fw[e] * wo[(size_t)e * DM];
        F1[i] = a;
    }
    for (int i = gt; i < DEPTH * DM; i += NGT) {
        const int n = i & 1023, l = i >> 10; float a = 0.f;
        for (int e = 0; e < 256; ++e) a += fb_[l * 256 + e] * wout_[((size_t)l * DM + 768 + e) * DM + n];
        BO[i] = a;
    }
}
__device__ __forceinline__ void prologue_b(Frame& F) {
    unsigned char* ws = F.ws; const float* F1 = (const float*)(ws + B_F1); bf16* WO = (bf16*)(ws + WS_WOUT);
    const int gt = F.vcu * 512 + F.tid, NGT = F.G * 512;
    for (int i = gt; i < DEPTH * DM * 256; i += NGT) {
        const int c = i & 63, g = (i >> 6) & 3, n = (i >> 8) & 1023, l = i >> 18;
        const float* f = F1 + ((size_t)(l * 4 + g) * 64) * DM + n; float ar = 0.f, ai = 0.f;
        for (int cp = 0; cp < 64; ++cp) { const float fr = (float)((c * cp) & 63) * (1.0f / 64.0f); const float v = f[(size_t)cp * DM];
            ar += __builtin_amdgcn_cosf(fr) * v; ai += __builtin_amdgcn_sinf(fr) * v; }
        bf16* dst = WO + ((size_t)l * DM + n) * KOUT;
        dst[768 + 64 * g + c] = (bf16)f2bf(ar); dst[1024 + 64 * g + c] = (bf16)f2bf(ai);
    }
}

__device__ __forceinline__ void convert_layer(Frame& F, int l) {
    unsigned char* wl = F.ws + WS_WL;
    const size_t ffo = (size_t)l * DM * DFF;
    for (int jj = 0; jj < 16; ++jj) {
        CvtJob J;
        switch (jj) {
        case 0: J = CvtJob{inp(F, IN_ffn1_wg) + ffo, DFF, DM, 0, DFF, (bf16*)(wl + WL_GU1), DM, 0, 1, inp(F, IN_ffn1_norm) + l * DM}; break;
        case 1: J = CvtJob{inp(F, IN_ffn1_wu) + ffo, DFF, DM, 0, DFF, (bf16*)(wl + WL_GU1), DM, 1, 1, inp(F, IN_ffn1_norm) + l * DM}; break;
        case 2: J = CvtJob{inp(F, IN_ffn1_wd) + ffo, DM, DFF, 0, DM, (bf16*)(wl + WL_D1), DFF, 0, 0, nullptr}; break;
        case 3: J = CvtJob{inp(F, IN_ffn2_wg) + ffo, DFF, DM, 0, DFF, (bf16*)(wl + WL_GU2), DM, 0, 1, inp(F, IN_ffn2_norm) + l * DM}; break;
        case 4: J = CvtJob{inp(F, IN_ffn2_wu) + ffo, DFF, DM, 0, DFF, (bf16*)(wl + WL_GU2), DM, 1, 1, inp(F, IN_ffn2_norm) + l * DM}; break;
        case 5: J = CvtJob{inp(F, IN_ffn2_wd) + ffo, DM, DFF, 0, DM, (bf16*)(wl + WL_D2), DFF, 0, 0, nullptr}; break;
        case 6: J = CvtJob{inp(F, IN_w_in) + (size_t)l * DM * DIN, DIN, DM, 0, 640, (bf16*)(wl + WL_IN), DM, 0, 0, inp(F, IN_mix_norm) + l * DM}; break;
        case 7: J = CvtJob{inp(F, IN_w_in) + (size_t)l * DM * DIN, DIN, DM, 640, 64, (bf16*)(wl + WL_IN), DM, 640, 2, inp(F, IN_mix_norm) + l * DM}; break;
        case 8: J = CvtJob{inp(F, IN_w_in) + (size_t)l * DM * DIN, DIN, DM, 1472, 32, (bf16*)(wl + WL_IN), DM, 704, 0, inp(F, IN_mix_norm) + l * DM}; break;
        case 9: J = CvtJob{inp(F, IN_w_in) + (size_t)l * DM * DIN, DIN, DM, 704, 768, (bf16*)(wl + WL_IN), DM, 768, 0, inp(F, IN_mix_norm) + l * DM}; break;
        case 10: J = CvtJob{inp(F, IN_w_in) + (size_t)l * DM * DIN, DIN, DM, 1488, 256, (bf16*)(wl + WL_IN), DM, 1536, 0, inp(F, IN_mix_norm) + l * DM}; break;
        case 11: J = CvtJob{inp(F, IN_w_uq) + (size_t)l * QL * NQ, NQ, QL, 0, NQ, (bf16*)(wl + WL_UQ), QL, 0, 3, inp(F, IN_q_norm) + l * QL}; break;
        case 12: J = CvtJob{inp(F, IN_w_ukv) + (size_t)l * KVL * NKV, NKV, KVL, 0, NKV, (bf16*)(wl + WL_UKV), KVL, 0, 0, inp(F, IN_kv_norm) + l * KVL}; break;
        case 13: J = CvtJob{inp(F, IN_ple_wg) + (size_t)l * DM * DM, DM, DM, 0, DM, (bf16*)(wl + WL_PG), DM, 0, 0, inp(F, IN_pg_norm) + l * DM}; break;
        case 14: J = CvtJob{inp(F, IN_ple_wp) + (size_t)l * PLE * DM, DM, PLE, 0, DM, (bf16*)(wl + WL_PP), PLE, 0, 0, nullptr}; break;
        default: J = CvtJob{nullptr, 0, 0, 0, 0, nullptr, 0, 0, 0, nullptr}; break;
        }
        if (J.W) cvt_job(F, J);
    }
    { GAS v4u* z = (GAS v4u*)((bf16*)(wl + WL_IN) + (size_t)736 * DM); const int gt = F.vcu * 512 + F.tid;
      for (int i = gt; i < 32 * DM / 8; i += F.G * 512) z[i] = (v4u){0u, 0u, 0u, 0u}; }
}
__device__ __forceinline__ void convert_p(Frame& F, int l) {
    const GAS f32x4* src = (const GAS f32x4*)(inp(F, IN_p) + (size_t)l * MTOK * PLE); GAS v2u* dst = (GAS v2u*)(F.ws + B_PB);
    const int gt = F.vcu * 512 + F.tid, NGT = F.G * 512;
    for (int i = gt; i < MTOK * PLE / 4; i += NGT) { const f32x4 v = src[i]; v2u w; w.x = pk2(v[0], v[1]); w.y = pk2(v[2], v[3]); dst[i] = w; }
}

__device__ __forceinline__ void mlstm_m1(Frame& F, int l) {
    unsigned char* ws = F.ws;
    const bf16* MX = (const bf16*)(ws + B_MX); const bf16* MV = (const bf16*)(ws + B_MV); const float* MIF = (const float*)(ws + B_MIF);
    bf16* QM = (bf16*)(ws + B_QM); bf16* KM = (bf16*)(ws + B_KM); bf16* XC = (bf16*)(ws + B_XC);
    bf16* CST = (bf16*)(ws + B_CST); float* NST = (float*)(ws + B_NST); float* SCL = (float*)(ws + B_SCL);
    LAS bf16* XCs = (LAS bf16*)(F.lds); LAS bf16* WqT = XCs + 64 * 72; LAS bf16* WkT = WqT + 64 * 72; LAS bf16* VT = WkT + 64 * 72;
    LAS bf16* KT0 = VT + 64 * 72; LAS bf16* KT1 = KT0 + 64 * 72; LAS float* wv = (LAS float*)(KT1 + 64 * 72);
    const int tid = F.tid, lane = F.lane, w = F.wave, hi = lane >> 5, r32 = lane & 31;
    const float* convb_ = inp(F, IN_conv_b); const float* convw_ = inp(F, IN_conv_w); const float* mwq_ = inp(F, IN_mw_q); const float* mwk_ = inp(F, IN_mw_k); const float* ib_ = inp(F, IN_i_bias); const float* fbias_ = inp(F, IN_f_bias);
    for (int unit = F.vcu; unit < NB * 4 * NCHUNK; unit += F.G) {
        const int b = unit >> 9, hh = (unit >> 7) & 3, c = unit & 127; const int t0 = b * SEQ + c * 64;
        {
            const int j = tid >> 3, d8 = (tid & 7) * 8, ch = hh * 64 + d8; float a[8];
#pragma unroll
            for (int i = 0; i < 8; ++i) a[i] = convb_[l * 256 + ch + i];
#pragma unroll
            for (int tap = 0; tap < 5; ++tap) { const int ss = c * 64 + j + tap - 2;
                if (ss >= 0 && ss < SEQ) { float xv[8]; unpack8(*(const GAS v4u*)(MX + (size_t)(b * SEQ + ss) * 256 + ch), xv);
                    const float* cw = convw_ + ((size_t)l * 5 + tap) * 256 + ch;
#pragma unroll
                    for (int i = 0; i < 8; ++i) a[i] += xv[i] * cw[i]; } }
#pragma unroll
            for (int i = 0; i < 8; ++i) a[i] = siluf_(a[i]);
            const v4u xw = pack8(a);
            *(LAS v4u*)(XCs + j * 72 + d8) = xw; *(GAS v4u*)(XC + (size_t)(t0 + j) * 256 + ch) = xw;
            { const int e = j; const float* wq = mwq_ + ((size_t)(l * 4 + hh) * 64 + d8) * 64 + e; const float* wk = mwk_ + ((size_t)(l * 4 + hh) * 64 + d8) * 64 + e; float q8[8], k8[8];
#pragma unroll
              for (int i = 0; i < 8; ++i) { q8[i] = wq[i * 64]; k8[i] = wk[i * 64]; }
              *(LAS v4u*)(WqT + e * 72 + d8) = pack8(q8); *(LAS v4u*)(WkT + e * 72 + d8) = pack8(k8); }
            { const v4u vw = *(const GAS v4u*)(MV + (size_t)(t0 + j) * 256 + ch); const unsigned ww[4] = {vw.x, vw.y, vw.z, vw.w};
#pragma unroll
              for (int i = 0; i < 8; ++i) VT[(d8 + i) * 72 + j] = (bf16)((i & 1) ? (ww[i >> 1] >> 16) : (ww[i >> 1] & 0xffffu)); }
        }
        if (w < 2) {
            const int dir = w, tok = t0 + (dir ? 63 - lane : lane);
            const float iv = MIF[(size_t)tok * 16 + dir * 4 + hh] + ib_[l * 8 + dir * 4 + hh];
            const float fv = MIF[(size_t)tok * 16 + 8 + dir * 4 + hh] + fbias_[l * 8 + dir * 4 + hh];
            const float lf = logsigmoidf_(fv);
            const float bc = wave_incl_sum(lf, lane); const float bL = lane_bcast(bc, 63);
            const float lw = bL - bc + iv; const float ml = wave_max(lw, lane);
            wv[dir * 64 + (dir ? 63 - lane : lane)] = __expf(lw - ml);
            if (lane == 0) { const int chain = dir * 16 + b * 4 + hh, chunk = dir ? (NCHUNK - 1 - c) : c; SCL[((size_t)chain * NCHUNK + chunk) * 4 + 0] = bL; SCL[((size_t)chain * NCHUNK + chunk) * 4 + 1] = ml; }
        }
        __syncthreads();
        const int ti = (w >> 1) & 1, tj = w & 1, dir = w >> 2;
        {
            const f32x16 acc = mma_tile(XCs + ti * 32 * 72, 72, (dir ? WkT : WqT) + tj * 32 * 72, 72, 64, lane);
            bf16* dst = (dir ? KM : QM) + (size_t)t0 * 256 + hh * 64 + tj * 32 + r32; const float sc = dir ? 1.0f : 0.125f;
#pragma unroll
            for (int r = 0; r < 16; ++r) dst[(size_t)(ti * 32 + crow32(r, hi)) * 256] = (bf16)f2bf(acc[r] * sc);
        }
        {
            const f32x16 acc = mma_tile(WkT + ti * 32 * 72, 72, XCs + tj * 32 * 72, 72, 64, lane);
            const float wj = wv[dir * 64 + tj * 32 + r32]; LAS bf16* kt = (dir ? KT1 : KT0) + tj * 32 + r32;
#pragma unroll
            for (int r = 0; r < 16; ++r) kt[(ti * 32 + crow32(r, hi)) * 72] = (bf16)f2bf(acc[r] * wj);
        }
        __syncthreads();
        {
            const f32x16 acc = mma_tile(VT + ti * 32 * 72, 72, (dir ? KT1 : KT0) + tj * 32 * 72, 72, 64, lane);
            const int chain = dir * 16 + b * 4 + hh, chunk = dir ? (NCHUNK - 1 - c) : c;
            bf16* dst = CST + ((size_t)chain * NCHUNK + chunk) * 4096 + tj * 32 + r32;
#pragma unroll
            for (int r = 0; r < 16; ++r) dst[(ti * 32 + crow32(r, hi)) * 64] = (bf16)f2bf(acc[r]);
        }
        if (tid < 128) { const int d = tid >> 6, kk = tid & 63; const LAS bf16* kt = (d ? KT1 : KT0) + kk * 72; float s = 0.f;
            for (int j = 0; j < 64; ++j) s += bf2f(kt[j]);
            const int chain = d * 16 + b * 4 + hh, chunk = d ? (NCHUNK - 1 - c) : c; NST[((size_t)chain * NCHUNK + chunk) * 64 + kk] = s; }
        __syncthreads();
    }
}
__device__ __forceinline__ void mlstm_m2(Frame& F) {
    unsigned char* ws = F.ws; bf16* CST = (bf16*)(ws + B_CST); float* NST = (float*)(ws + B_NST); float* SCL = (float*)(ws + B_SCL);
    for (int g = F.vcu * 512 + F.tid; g < NCHAIN * 4096; g += F.G * 512) {
        const int chain = g >> 12, e = g & 4095; float m = 0.f, C = 0.f, n = 0.f;
        bf16* cp = CST + (size_t)chain * NCHUNK * 4096 + e; float* np = NST + (size_t)chain * NCHUNK * 64 + (e & 63); float* sp = SCL + (size_t)chain * NCHUNK * 4;
#pragma unroll 4
        for (int c = 0; c < NCHUNK; ++c) {
            const float bL = sp[c * 4 + 0], ml = sp[c * 4 + 1]; const float cl = bf2f(cp[(size_t)c * 4096]);
            float nl = 0.f; if (e < 64) nl = np[c * 64];
            cp[(size_t)c * 4096] = (bf16)f2bf(C);
            if (e < 64) np[c * 64] = n;
            if (e == 0) sp[c * 4 + 2] = m;
            const float mn = fmaxf(bL + m, ml); const float dec = __expf(bL + m - mn), wl = __expf(ml - mn);
            C = dec * C + wl * cl; n = dec * n + wl * nl; m = mn;
        }
    }
}
__device__ __forceinline__ void mlstm_m3(Frame& F, int l) {
    unsigned char* ws = F.ws;
    const bf16* MV = (const bf16*)(ws + B_MV); const bf16* MO = (const bf16*)(ws + B_MO); const float* MIF = (const float*)(ws + B_MIF);
    const bf16* QM = (const bf16*)(ws + B_QM); const bf16* KM = (const bf16*)(ws + B_KM); const bf16* XC = (const bf16*)(ws + B_XC);
    const bf16* CST = (const bf16*)(ws + B_CST); const float* NST = (const float*)(ws + B_NST); const float* SCL = (const float*)(ws + B_SCL);
    bf16* Y = (bf16*)(ws + B_Y);
    LAS bf16* Qs = (LAS bf16*)(F.lds); LAS bf16* Ks = Qs + 64 * 72; LAS bf16* A0 = Ks + 64 * 72; LAS bf16* A1 = A0 + 64 * 136; LAS bf16* B0 = A1 + 64 * 136; LAS bf16* B1 = B0 + 64 * 136;
    LAS float* Hs = (LAS float*)(B1 + 64 * 136); LAS float* vec = Hs + 2 * 64 * 68;
    LAS float* av = vec; LAS float* Mv = vec + 128; LAS float* mtv = vec + 256; LAS float* wst = vec + 384; LAS float* nvec = vec + 512; LAS float* rden = vec + 640;
    const int tid = F.tid, lane = F.lane, w = F.wave, hi = lane >> 5, r32 = lane & 31;
    const float* ib_ = inp(F, IN_i_bias); const float* fbias_ = inp(F, IN_f_bias); const float* hn_ = inp(F, IN_head_norm); const float* sk_ = inp(F, IN_skip);
    for (int unit = F.vcu; unit < NB * 4 * NCHUNK; unit += F.G) {
        const int b = unit >> 9, hh = (unit >> 7) & 3, c = unit & 127; const int t0 = b * SEQ + c * 64;
        const int chf = b * 4 + hh, chb = 16 + b * 4 + hh, ckf = c, ckb = NCHUNK - 1 - c;
        {
            const int t = tid >> 3, d8 = (tid & 7) * 8; const size_t go = (size_t)(t0 + t) * 256 + hh * 64 + d8;
            *(LAS v4u*)(Qs + t * 72 + d8) = *(const GAS v4u*)(QM + go); *(LAS v4u*)(Ks + t * 72 + d8) = *(const GAS v4u*)(KM + go);
            { const v4u vw = *(const GAS v4u*)(MV + go); const unsigned ww[4] = {vw.x, vw.y, vw.z, vw.w};
#pragma unroll
              for (int i = 0; i < 8; ++i) { const bf16 e = (bf16)((i & 1) ? (ww[i >> 1] >> 16) : (ww[i >> 1] & 0xffffu)); B0[(d8 + i) * 136 + t] = e; B1[(d8 + i) * 136 + t] = e; } }
            *(LAS v4u*)(B0 + t * 136 + 64 + d8) = *(const GAS v4u*)(CST + ((size_t)chf * NCHUNK + ckf) * 4096 + t * 64 + d8);
            *(LAS v4u*)(B1 + t * 136 + 64 + d8) = *(const GAS v4u*)(CST + ((size_t)chb * NCHUNK + ckb) * 4096 + t * 64 + d8);
            if (tid < 128) { const int d = tid >> 6, k = tid & 63; nvec[tid] = NST[((size_t)(d ? chb : chf) * NCHUNK + (d ? ckb : ckf)) * 64 + k]; }
        }
        if (w < 2) {
            const int dir = w, idx = dir ? 63 - lane : lane, tok = t0 + idx;
            const float iv = MIF[(size_t)tok * 16 + dir * 4 + hh] + ib_[l * 8 + dir * 4 + hh];
            const float fv = MIF[(size_t)tok * 16 + 8 + dir * 4 + hh] + fbias_[l * 8 + dir * 4 + hh];
            const float m0 = SCL[((size_t)(dir ? chb : chf) * NCHUNK + (dir ? ckb : ckf)) * 4 + 2];
            const float bc = wave_incl_sum(logsigmoidf_(fv), lane); const float a = iv - bc; const float pm = wave_incl_max(a, lane);
            const float Mx = fmaxf(m0, pm);
            av[dir * 64 + idx] = a; Mv[dir * 64 + idx] = Mx; mtv[dir * 64 + idx] = bc + Mx; wst[dir * 64 + idx] = __expf(m0 - Mx);
        }
        __syncthreads();
        const int ti = (w >> 1) & 1, tj = w & 1, dir = w >> 2;
        {
            const f32x16 acc = mma_tile(Qs + ti * 32 * 72, 72, Ks + tj * 32 * 72, 72, 64, lane);
            const int s = tj * 32 + r32; const float as = av[dir * 64 + s]; LAS bf16* A = (dir ? A1 : A0) + s;
#pragma unroll
            for (int r = 0; r < 16; ++r) { const int t = ti * 32 + crow32(r, hi); const bool ok = dir ? (s >= t) : (s <= t);
                const float p = ok ? acc[r] * __expf(as - Mv[dir * 64 + t]) : 0.f; A[t * 136] = (bf16)f2bf(p); }
        }
        {
            const int t = tid >> 3, d8 = (tid & 7) * 8; float q8[8]; unpack8(*(const LAS v4u*)(Qs + t * 72 + d8), q8);
            float f8[8], g8[8]; const float w0 = wst[t], w1 = wst[64 + t];
#pragma unroll
            for (int i = 0; i < 8; ++i) { f8[i] = q8[i] * w0; g8[i] = q8[i] * w1; }
            *(LAS v4u*)(A0 + t * 136 + 64 + d8) = pack8(f8); *(LAS v4u*)(A1 + t * 136 + 64 + d8) = pack8(g8);
        }
        __syncthreads();
        const f32x16 num = mma_tile((dir ? A1 : A0) + ti * 32 * 136, 136, (dir ? B1 : B0) + tj * 32 * 136, 136, 128, lane);
        if (tid < 128) { const int d = tid >> 6, t = tid & 63; const LAS bf16* Ar = (d ? A1 : A0) + t * 136; float den = 0.f;
            for (int s = 0; s < 64; ++s) den += bf2f(Ar[s]);
            for (int k = 0; k < 64; ++k) den += bf2f(Ar[64 + k]) * nvec[d * 64 + k];
            rden[tid] = fast_rcp(fmaxf(fabsf(den), __expf(-mtv[tid]))); }
        __syncthreads();
        {
            const int v = tj * 32 + r32;
#pragma unroll
            for (int r = 0; r < 16; ++r) { const int t = ti * 32 + crow32(r, hi); Hs[(dir * 64 + t) * 68 + v] = num[r] * rden[dir * 64 + t]; }
        }
        __syncthreads();
        {
            const int t = tid >> 3, v8 = (tid & 7) * 8; float h[8]; float ss = 0.f;
#pragma unroll
            for (int i = 0; i < 8; ++i) { h[i] = Hs[t * 68 + v8 + i] + Hs[(64 + t) * 68 + v8 + i]; ss += h[i] * h[i]; }
            ss += bperm(lane ^ 1, ss); ss += bperm(lane ^ 2, ss); ss += bperm(lane ^ 4, ss);
            const float rs = rsqrtf(ss * (1.0f / 64.0f) + EPS);
            const size_t go = (size_t)(t0 + t) * 256 + hh * 64 + v8; float xc[8], mo[8]; unpack8(*(const GAS v4u*)(XC + go), xc); unpack8(*(const GAS v4u*)(MO + go), mo);
            const float* hn = hn_ + l * 256 + hh * 64 + v8; const float* sk = sk_ + l * 256 + hh * 64 + v8; float o[8];
#pragma unroll
            for (int i = 0; i < 8; ++i) o[i] = (h[i] * rs * hn[i] + sk[i] * xc[i]) * sigmoidf_(mo[i]);
            *(GAS v4u*)(Y + (size_t)(t0 + t) * KOUT + 512 + hh * 64 + v8) = pack8(o);
        }
        __syncthreads();
    }
}

__device__ __forceinline__ void fft_phase(Frame& F) {
    typedef float f32x2 __attribute__((ext_vector_type(2)));
    unsigned char* ws = F.ws; const bf16* FQ = (const bf16*)(ws + B_FQ); bf16* FO = (bf16*)(ws + B_FO);
    LAS f32x2* Z1 = (LAS f32x2*)(F.lds); LAS f32x2* Z2 = Z1 + 8192;
    const int tid = F.tid;
    for (int unit = F.vcu; unit < NB * 64; unit += F.G) {
        const bf16* src = FQ + (size_t)unit * 8192 * 4;
        for (int s = tid; s < 8192; s += 512) { const v2u wv = *(const GAS v2u*)(src + (size_t)s * 4); const int r = (int)(__brev((unsigned)s) >> 19);
            Z1[r] = (f32x2){bflo(wv.x), bfhi(wv.x)}; Z2[r] = (f32x2){bflo(wv.y), bfhi(wv.y)}; }
        for (int h = 1; h < 8192; h <<= 1) {
            __syncthreads();
            const float inv2h = 0.5f / (float)h;
            for (int j = tid; j < 4096; j += 512) { const int pos = j & (h - 1); const int i0 = ((j - pos) << 1) + pos, i1 = i0 + h;
                const float fr = (float)pos * inv2h; const float wr = __builtin_amdgcn_cosf(fr), wi = -__builtin_amdgcn_sinf(fr);
                { const f32x2 u = Z1[i0], v = Z1[i1]; const float tr = wr * v.x - wi * v.y, ti = wr * v.y + wi * v.x; Z1[i0] = (f32x2){u.x + tr, u.y + ti}; Z1[i1] = (f32x2){u.x - tr, u.y - ti}; }
                { const f32x2 u = Z2[i0], v = Z2[i1]; const float tr = wr * v.x - wi * v.y, ti = wr * v.y + wi * v.x; Z2[i0] = (f32x2){u.x + tr, u.y + ti}; Z2[i1] = (f32x2){u.x - tr, u.y - ti}; } }
        }
        __syncthreads();
        constexpr float NRM = 0.0013810679320049757f;
        bf16* dst = FO + (size_t)unit * 8192 * 8;
        for (int k = tid; k < 8192; k += 512) { const int km = (8192 - k) & 8191;
            const f32x2 a = Z1[k], am = Z1[km], c = Z2[k], cm = Z2[km];
            const float x0r = 0.5f * (a.x + am.x), x0i = 0.5f * (a.y - am.y), x1r = 0.5f * (a.y + am.y), x1i = -0.5f * (a.x - am.x);
            const float x2r = 0.5f * (c.x + cm.x), x2i = 0.5f * (c.y - cm.y), x3r = 0.5f * (c.y + cm.y), x3i = -0.5f * (c.x - cm.x);
            v4u o; o.x = pk2(x0r * NRM, x1r * NRM); o.y = pk2(x2r * NRM, x3r * NRM); o.z = pk2(x0i * NRM, x1i * NRM); o.w = pk2(x2i * NRM, x3i * NRM);
            *(GAS v4u*)(dst + (size_t)k * 8) = o; }
        __syncthreads();
    }
}
__device__ __forceinline__ void gather_phase(Frame& F) {
    unsigned char* ws = F.ws; const bf16* FO = (const bf16*)(ws + B_FO); bf16* Y = (bf16*)(ws + B_Y);
    const int gw = F.vcu * 8 + F.wave, NGW = F.G * 8; const int per = MTOK / NGW;
    for (int r = 0; r < per; ++r) { const int row = gw * per + r; const int b = row >> 13, k = row & 8191;
        const v4u v = *(const GAS v4u*)(FO + (((size_t)(b * 64 + F.lane) * 8192 + k) << 3));
        v2u re, im; re.x = v.x; re.y = v.y; im.x = v.z; im.y = v.w;
        bf16* yr = Y + (size_t)row * KOUT; *(GAS v2u*)(yr + 768 + 4 * F.lane) = re; *(GAS v2u*)(yr + 1024 + 4 * F.lane) = im; }
    for (int row = NGW * per + gw; row < MTOK; row += NGW) { const int b = row >> 13, k = row & 8191;
        const v4u v = *(const GAS v4u*)(FO + (((size_t)(b * 64 + F.lane) * 8192 + k) << 3));
        v2u re, im; re.x = v.x; re.y = v.y; im.x = v.z; im.y = v.w;
        bf16* yr = Y + (size_t)row * KOUT; *(GAS v2u*)(yr + 768 + 4 * F.lane) = re; *(GAS v2u*)(yr + 1024 + 4 * F.lane) = im; }
}
__device__ __forceinline__ void final_norm(Frame& F, float* H, const float* SS) {
    const float* fn_ = inp(F, IN_final_norm);
    const int gw = F.vcu * 8 + F.wave, NGW = F.G * 8;
    for (int m = gw; m < MTOK; m += NGW) {
        float s = (F.lane < 16) ? SS[(size_t)m * 16 + F.lane] : 0.f; s = wave_sum(s, F.lane);
        const float rs = rsqrtf(s * (1.0f / 1024.0f) + EPS);
        GAS f32x4* hr = (GAS f32x4*)(H + (size_t)m * DM) + F.lane; const GAS f32x4* g = (const GAS f32x4*)fn_ + F.lane;
#pragma unroll
        for (int j = 0; j < 4; ++j) { f32x4 v = hr[64 * j]; const f32x4 gg = g[64 * j]; v = v * rs * gg; hr[64 * j] = v; }
    }
}

constexpr int PPL = 12;
constexpr int NPH = 2 + DEPTH * PPL + 1;
struct Args { const void* in[33]; float* out; unsigned char* ws; int ph_lo, ph_hi, li, use_bar; };

__global__ void __launch_bounds__(512, 2) fwd(Args args) {
    extern __shared__ __attribute__((aligned(16))) unsigned char lds[];
    Frame F;
    F.lds = (LAS unsigned char*)lds;
    F.MISC = (volatile LAS unsigned*)(F.lds + MISC_OFF);
    F.tid = threadIdx.x; F.lane = F.tid & 63; F.wave = __builtin_amdgcn_readfirstlane(F.tid >> 6);
    F.G = gridDim.x; { const int bx = blockIdx.x; F.vcu = (F.G % 8 == 0) ? (bx % 8) * (F.G / 8) + bx / 8 : bx; }
    F.ws = args.ws;
    unsigned char* ws = args.ws;
    float* H = args.out;

    for (int u = F.tid; u < (LDS_BYTES - MISC_OFF) / 4; u += 512) ((LAS unsigned*)(F.lds + MISC_OFF))[u] = 0u;
    __syncthreads();
    if (F.tid == 0) {
#pragma unroll
        for (int i = 0; i < 33; ++i) { const unsigned long long pv = (unsigned long long)args.in[i]; ((LAS unsigned*)(F.lds + PTAB_OFF))[2 * i] = (unsigned)pv; ((LAS unsigned*)(F.lds + PTAB_OFF))[2 * i + 1] = (unsigned)(pv >> 32); }
    }
    __syncthreads();
    XcdBarrier bar; bar.bar = (unsigned*)(ws + WS_CTL) + 1024 + args.li * XCD_BAR_WORDS; bar.x = 0; bar.st = nullptr;
    if (args.use_bar) bar = xcd_barrier_post((unsigned*)(ws + WS_CTL) + 1024 + args.li * XCD_BAR_WORDS, F.MISC + 8);

    const int lo = args.ph_lo, hi = args.ph_hi;
#define IN(k) (lo <= (k) && (k) < hi)
#define REFRESH() do { F.tid = opaque_tid(); F.lane = F.tid & 63; F.wave = __builtin_amdgcn_readfirstlane(F.tid >> 6); } while (0)
#define SEAM(k) do { if (IN((k) + 1)) xcd_barrier(bar); } while (0)

    bf16* XB0 = (bf16*)(ws + WS_XB0); bf16* XB1 = (bf16*)(ws + B_XB1);
    float* SS0 = (float*)(ws + WS_SS);
    bf16* HID = (bf16*)(ws + B_HID);
    unsigned char* wl = ws + WS_WL;

    if (IN(0)) { REFRESH();
#ifndef DIS_PA
prologue_a(F, H);
#endif
 SEAM(0); }
    if (IN(1)) { REFRESH();
#ifndef DIS_PB
prologue_b(F);
#endif
 SEAM(1); }

    for (int l = 0; l < DEPTH; ++l) {
        const int pb = 2 + l * PPL;
        if (IN(pb + 0)) { REFRESH();
#ifndef DIS_CV
convert_layer(F, l);
#endif
 SEAM(pb + 0); }
        if (IN(pb + 1)) { REFRESH();
            pg8::Gemm g{XB1, (const bf16*)(wl + WL_GU1), MTOK, NGU, DM}; pg8::StaticOrder S; S.init(MTOK, NGU, F.G, (int)blockIdx.x);
            pg8::EpiSwiGLU E{ws, WS_SS};

#ifndef DIS_SW1
pg8::gemm_phase<pg8::EpiSwiGLU, pg8::StaticOrder, true, true>(F.lds, g, S, E);
#endif

            SEAM(pb + 1);
        }
        if (IN(pb + 2)) { REFRESH();
            pg8::Gemm g{HID, (const bf16*)(wl + WL_D1), MTOK, DM, DFF}; pg8::StaticOrder S; S.init(MTOK, DM, F.G, (int)blockIdx.x);
            pg8::EpiResid E{H, ws, WS_SS + (size_t)MTOK * 64, 0, 0.5f};

#ifndef DIS_RE1
pg8::gemm_phase<pg8::EpiResid, pg8::StaticOrder, true, true>(F.lds, g, S, E);
#endif

            SEAM(pb + 2);
        }
        if (IN(pb + 3)) { REFRESH();
            pg8::Gemm g{XB0, (const bf16*)(wl + WL_IN), MTOK, DINP, DM}; pg8::StaticOrder S; S.init(MTOK, DINP, F.G, (int)blockIdx.x);
            pg8::EpiWin E{ws};

#ifndef DIS_WIN1
pg8::gemm_phase<pg8::EpiWin, pg8::StaticOrder, true, true>(F.lds, g, S, E);
#endif

            SEAM(pb + 3);
        }
        if (IN(pb + 4)) { REFRESH();
            { pg8::Gemm g{(const bf16*)(ws + B_CQ), (const bf16*)(wl + WL_UQ), MTOK, NQ, QL}; pg8::StaticOrder S; S.init(MTOK, NQ, F.G, (int)blockIdx.x);
              pg8::EpiQ E{ws};

#ifndef DIS_EQ1
pg8::gemm_phase<pg8::EpiQ, pg8::StaticOrder, true, true>(F.lds, g, S, E);
#endif
 }
            __syncthreads();
            { pg8::Gemm g{(const bf16*)(ws + B_CKV), (const bf16*)(wl + WL_UKV), MTOK, NKV, KVL}; pg8::StaticOrder S; S.init(MTOK, NKV, F.G, (int)blockIdx.x);
              pg8::EpiKV E{ws};

#ifndef DIS_EKV1
pg8::gemm_phase<pg8::EpiKV, pg8::StaticOrder, true, true>(F.lds, g, S, E);
#endif
 }
            __syncthreads();

#ifndef DIS_M1
mlstm_m1(F, l);
#endif

            __syncthreads();

#ifndef DIS_FFT
fft_phase(F);
#endif

            SEAM(pb + 4);
        }
        if (IN(pb + 5)) { REFRESH();

#ifndef DIS_M2
mlstm_m2(F);
#endif

            for (int u = F.vcu; u < NB * 4 * (SEQ / 256); u += F.G) {
                const int bh = u >> 5, qb = u & 31, b = bh >> 2, hh = bh & 3; const size_t r0 = (size_t)b * SEQ;

#ifndef DIS_ATT
att::attn_dense_body<ATT_SDEPTH>((const bf16*)(ws + B_Q) + (r0 + qb * 256) * 768 + hh * 192, (const bf16*)(ws + B_KN) + r0 * 512 + hh * 128, (const bf16*)(ws + B_KR) + r0 * 64,
                                         (const bf16*)(ws + B_V) + r0 * 512 + hh * 128, (bf16*)(ws + B_Y) + (r0 + qb * 256) * KOUT + hh * 128, SEQ, (char*)lds);
#endif

            }
            SEAM(pb + 5);
        }
        if (IN(pb + 6)) { REFRESH();
#ifndef DIS_M3
mlstm_m3(F, l);
#endif

#ifndef DIS_GA
gather_phase(F);
#endif
 SEAM(pb + 6); }
        if (IN(pb + 7)) { REFRESH();
            pg8::Gemm g{(const bf16*)(ws + B_Y), (const bf16*)(ws + WS_WOUT) + (size_t)l * DM * KOUT, MTOK, DM, KOUT}; pg8::StaticOrder S; S.init(MTOK, DM, F.G, (int)blockIdx.x);
            pg8::EpiResid E{H, ws, WS_SS, WS_BOUT + (size_t)l * DM * 4, 1.0f};

#ifndef DIS_RE2
pg8::gemm_phase<pg8::EpiResid, pg8::StaticOrder, true, true>(F.lds, g, S, E);
#endif

            SEAM(pb + 7);
        }
        if (IN(pb + 8)) { REFRESH();

#ifndef DIS_CP
convert_p(F, l);
#endif

            pg8::Gemm g{XB0, (const bf16*)(wl + WL_GU2), MTOK, NGU, DM}; pg8::StaticOrder S; S.init(MTOK, NGU, F.G, (int)blockIdx.x);
            pg8::EpiSwiGLU E{ws, WS_SS};

#ifndef DIS_SW2
pg8::gemm_phase<pg8::EpiSwiGLU, pg8::StaticOrder, true, true>(F.lds, g, S, E);
#endif

            SEAM(pb + 8);
        }
        if (IN(pb + 9)) { REFRESH();
            pg8::Gemm g{HID, (const bf16*)(wl + WL_D2), MTOK, DM, DFF}; pg8::StaticOrder S; S.init(MTOK, DM, F.G, (int)blockIdx.x);
            pg8::EpiResid E{H, ws, WS_SS + (size_t)MTOK * 64, 0, 0.5f};

#ifndef DIS_RE3
pg8::gemm_phase<pg8::EpiResid, pg8::StaticOrder, true, true>(F.lds, g, S, E);
#endif

            SEAM(pb + 9);
        }
        if (IN(pb + 10)) { REFRESH();
            pg8::Gemm g{(const bf16*)(ws + B_PB), (const bf16*)(wl + WL_PP), MTOK, DM, PLE}; pg8::StaticOrder S; S.init(MTOK, DM, F.G, (int)blockIdx.x);
            pg8::EpiE E{ws};

#ifndef DIS_EE1
pg8::gemm_phase<pg8::EpiE, pg8::StaticOrder, true, true>(F.lds, g, S, E);
#endif

            SEAM(pb + 10);
        }
        if (IN(pb + 11)) { REFRESH();
            pg8::Gemm g{XB0, (const bf16*)(wl + WL_PG), MTOK, DM, DM}; pg8::StaticOrder S; S.init(MTOK, DM, F.G, (int)blockIdx.x);
            pg8::EpiPle E{H, ws, inp(F, IN_ple_post) + l * DM};

#ifndef DIS_EP1
pg8::gemm_phase<pg8::EpiPle, pg8::StaticOrder, true, true>(F.lds, g, S, E);
#endif

            SEAM(pb + 11);
        }
    }
    if (IN(NPH - 1)) { REFRESH();
#ifndef DIS_FN
final_norm(F, H, SS0);
#endif
}

#undef IN
#undef SEAM
}

extern "C" void kernel_launch(void* const* d_in, const int* in_sizes, int n_in, void* d_out, int out_size, void* d_ws, size_t ws_size, hipStream_t stream) {
    static int grid = 0;
    if (grid == 0) {
        if (n_in != 33 || out_size != MTOK * DM || ws_size < WS_END) { fprintf(stderr, "kernel_launch: unexpected shapes (n_in %d out %d ws %zu need %zu)\n", n_in, out_size, ws_size, (size_t)WS_END); grid = -1; return; }
        int dev = 0, cus = 0, per_cu = 0;
        if (hipGetDevice(&dev) != hipSuccess || hipDeviceGetAttribute(&cus, hipDeviceAttributeMultiprocessorCount, dev) != hipSuccess) { grid = -1; return; }
        if (hipFuncSetAttribute((const void*)fwd, hipFuncAttributeMaxDynamicSharedMemorySize, LDS_BYTES) != hipSuccess) { grid = -1; return; }
        if (hipOccupancyMaxActiveBlocksPerMultiprocessor(&per_cu, (const void*)fwd, 512, LDS_BYTES) != hipSuccess || per_cu < 1) { fprintf(stderr, "kernel_launch: occupancy query says %d\n", per_cu); }
        (void)hipGetLastError();
        grid = cus;
    }
    if (grid < 0) return;
    (void)hipMemsetAsync((char*)d_ws + WS_CTL, 0, CTL_BYTES, stream);
    Args a{};
    for (int i = 0; i < 33; ++i) a.in[i] = d_in[i];
    a.out = (float*)d_out; a.ws = (unsigned char*)d_ws;
    int li = 0;
    for (int p = 0; p < NPH; p += PH_STEP, ++li) {
        a.ph_lo = p; a.ph_hi = (p + PH_STEP < NPH) ? p + PH_STEP : NPH; a.li = li; a.use_bar = (a.ph_hi - a.ph_lo > 1) ? 1 : 0;
        hipLaunchKernelGGL(fwd, dim3(grid), dim3(512), LDS_BYTES, stream, a);
    }
}
static_assert(att::SHM_ATTN <= MISC_OFF && PTAB_OFF + 33 * 8 <= LDS_BYTES && MISC_OFF + 64 <= PTAB_OFF, "LDS map");
```

```cpp
#include <hip/hip_runtime.h>
#include <cstdio>
#include <cstdint>

#ifndef PH_STEP
#define PH_STEP 1000
#endif

#define GAS __attribute__((address_space(1)))
#define LAS __attribute__((address_space(3)))

constexpr int NB = 4, SEQ = 8192, DM = 1024, MTOK = NB * SEQ, DEPTH = 4;
constexpr int DFF = 2816, NGU = 2 * DFF;
constexpr int DIN = 1744, DINP = 1792;
constexpr int QL = 384, KVL = 256, NQ = 768, NKV = 1024;
constexpr int KOUT = 1280;
constexpr int PLE = 256;
constexpr float EPS = 1e-6f;
constexpr int NCHUNK = 128, NCHAIN = 32;

constexpr size_t MiB = 1u << 20;
constexpr size_t WS_CTL = 0, CTL_BYTES = 1 * MiB;
constexpr size_t WS_WOUT = 1 * MiB;
constexpr size_t WS_BOUT = 11 * MiB;
constexpr size_t WS_ROPEC = 12 * MiB, WS_ROPES = 16 * MiB;
constexpr size_t WS_SS = 20 * MiB;
constexpr size_t WS_XB0 = 24 * MiB;
constexpr size_t WS_WL = 88 * MiB;
constexpr size_t WS_BIG = 132 * MiB;
constexpr size_t WL_GU1 = 0;
constexpr size_t WL_D1  = WL_GU1 + (size_t)NGU * DM * 2;
constexpr size_t WL_GU2 = WL_D1 + (size_t)DM * DFF * 2;
constexpr size_t WL_D2  = WL_GU2 + (size_t)NGU * DM * 2;
constexpr size_t WL_IN  = WL_D2 + (size_t)DM * DFF * 2;
constexpr size_t WL_UQ  = WL_IN + (size_t)DINP * DM * 2;
constexpr size_t WL_UKV = WL_UQ + (size_t)NQ * QL * 2;
constexpr size_t WL_PG  = WL_UKV + (size_t)NKV * KVL * 2;
constexpr size_t WL_PP  = WL_PG + (size_t)DM * DM * 2;
constexpr size_t WL_END = WL_PP + (size_t)DM * PLE * 2;
static_assert(WL_END <= 44 * MiB, "per-layer weights fit");
constexpr size_t B_HID = WS_BIG;
constexpr size_t B_XB1 = WS_BIG + 176 * MiB;
constexpr size_t B_PB  = WS_BIG + 420 * MiB;
constexpr size_t B_E   = WS_BIG + 322 * MiB;
constexpr size_t B_SSE = WS_BIG + 386 * MiB;
constexpr size_t B_CQ  = WS_BIG + 0 * MiB;
constexpr size_t B_CKV = WS_BIG + 24 * MiB;
constexpr size_t B_KR  = WS_BIG + 40 * MiB;
constexpr size_t B_MX  = WS_BIG + 44 * MiB;
constexpr size_t B_MV  = WS_BIG + 60 * MiB;
constexpr size_t B_MO  = WS_BIG + 76 * MiB;
constexpr size_t B_MIF = WS_BIG + 92 * MiB;
constexpr size_t B_FQ  = WS_BIG + 94 * MiB;
constexpr size_t B_SSQ = WS_BIG + 110 * MiB;
constexpr size_t B_Q   = WS_BIG + 114 * MiB;
constexpr size_t B_KN  = WS_BIG + 162 * MiB;
constexpr size_t B_V   = WS_BIG + 194 * MiB;
constexpr size_t B_Y   = WS_BIG + 226 * MiB;
constexpr size_t B_QM  = WS_BIG + 306 * MiB;
constexpr size_t B_KM  = WS_BIG + 322 * MiB;
constexpr size_t B_XC  = WS_BIG + 338 * MiB;
constexpr size_t B_CST = WS_BIG + 354 * MiB;
constexpr size_t B_NST = WS_BIG + 386 * MiB;
constexpr size_t B_SCL = WS_BIG + 387 * MiB;
constexpr size_t B_FO  = WS_BIG + 388 * MiB;
constexpr size_t B_F1  = WS_BIG + 0 * MiB;
constexpr size_t WS_END = WS_BIG + 436 * MiB;

constexpr int RING_BYTES = 131072;
constexpr int LDS_BYTES = 147456;
constexpr int MISC_OFF = LDS_BYTES - 1024;

typedef unsigned short bf16;
typedef unsigned v4u __attribute__((ext_vector_type(4)));
typedef unsigned v2u __attribute__((ext_vector_type(2)));
typedef GAS unsigned gu32;
#define RLX_AGENT __ATOMIC_RELAXED, __HIP_MEMORY_SCOPE_AGENT
#define LDS_WAIT() asm volatile("s_waitcnt lgkmcnt(0)" ::: "memory")
#define VM_WAIT() asm volatile("s_waitcnt vmcnt(0)" ::: "memory")

typedef __bf16 bf16x2n __attribute__((ext_vector_type(2)));
typedef float f32x2n __attribute__((ext_vector_type(2)));
__device__ __forceinline__ unsigned f2bf(float f) { const __bf16 b = (__bf16)f; return (unsigned)__builtin_bit_cast(unsigned short, b); }
__device__ __forceinline__ unsigned pk2(float lo, float hi) { const f32x2n v = {lo, hi}; const bf16x2n b = __builtin_convertvector(v, bf16x2n); return __builtin_bit_cast(unsigned, b); }
__device__ __forceinline__ float bf2f(unsigned short b) { return __builtin_bit_cast(float, (unsigned)b << 16); }
__device__ __forceinline__ float bflo(unsigned w) { return __builtin_bit_cast(float, w << 16); }
__device__ __forceinline__ float bfhi(unsigned w) { return __builtin_bit_cast(float, w & 0xffff0000u); }
__device__ __forceinline__ float fast_rcp(float x) { return __builtin_amdgcn_rcpf(x); }
__device__ __forceinline__ float sigmoidf_(float x) { return fast_rcp(1.0f + __expf(-x)); }
__device__ __forceinline__ float siluf_(float x) { return x * fast_rcp(1.0f + __expf(-x)); }

__device__ __forceinline__ int opaque_tid(int wv) { int t = (int)__builtin_amdgcn_mbcnt_hi(~0u, __builtin_amdgcn_mbcnt_lo(~0u, 0u)); asm volatile("" : "+v"(t)); return wv * 64 + t; }

__device__ __forceinline__ float sum_xor16(float s) { auto r = __builtin_amdgcn_permlane16_swap(__float_as_uint(s), __float_as_uint(s), false, false); return __uint_as_float(r[0]) + __uint_as_float(r[1]); }
__device__ __forceinline__ float sum_xor32(float s) { auto r = __builtin_amdgcn_permlane32_swap(__float_as_uint(s), __float_as_uint(s), false, false); return __uint_as_float(r[0]) + __uint_as_float(r[1]); }
__device__ __forceinline__ float sum_fq(float s) { return sum_xor32(sum_xor16(s)); }
__device__ __forceinline__ float bperm(int src_lane, float v) { return __int_as_float(__builtin_amdgcn_ds_bpermute(src_lane << 2, __float_as_int(v))); }

#ifndef ATT_SDEPTH
#define ATT_SDEPTH 1
#endif
#ifndef ATT_T
#define ATT_T 0
#endif
#ifndef ATT_V4
#define ATT_V4 0
#endif
#ifndef ATT_PRIO
#define ATT_PRIO 0
#endif
#ifndef ATT_V3
#define ATT_V3 0
#endif
#ifndef ATT_QKPIPE
#define ATT_QKPIPE 1
#endif
#ifndef ATT_DMA
#define ATT_DMA 0
#endif
#ifndef ATT_V2
#define ATT_V2 1
#endif
#ifndef ATT_NQR
#define ATT_NQR 6
#endif
namespace pg8 {
#define PG8_LAS __attribute__((address_space(3)))
typedef unsigned short bf16_t;
typedef short bf16x8 __attribute__((ext_vector_type(8)));
typedef float f32x4 __attribute__((ext_vector_type(4)));
typedef unsigned u32x4 __attribute__((ext_vector_type(4)));
constexpr int BM = 256, BK = 64, HALF = 128, HTB = HALF * BK * 2  , STAGE_BYTES = 8 * HTB, NXCD = 8, WGM = 8;

__host__ __device__ __forceinline__ int lds_byte(int r, int c) { const int st = (r >> 4) * 2 + (c >> 5), rr = r & 15, cc = c & 31, ob = rr * 64 + cc * 2; return st * 1024 + (ob ^ (((ob >> 9) & 1) << 5)); }
__host__ __device__ __forceinline__ void stage_rc(int b, int& R, int& C) { const int st = b / 1024, sb = b % 1024, swz = sb ^ (((sb >> 9) & 1) << 5); R = (st >> 1) * 16 + swz / 64; C = (st & 1) * 32 + (swz % 64) / 2; }
__host__ __device__ __forceinline__ int perm32(int rho) { const int n = rho >> 4, i = rho & 15; return 8 * (i >> 2) + 4 * n + (i & 3); }

struct Unit { int pm, pn; };
struct Gemm { const bf16_t* A; const bf16_t* Bt; int M, N, K; };

struct StaticOrder {
    int nM, nN, nwg, G, c;
    __host__ __device__ void init(int M, int N, int G_, int c_) { nM = M / BM; nN = N / BM; nwg = nM * nN; G = G_; c = c_; }
    __host__ __device__ bool next(int i, Unit& u) const {
        const long L = (long)i * G + c; if (L >= nwg) return false;
        int wgid = (int)L; { const int q = nwg / NXCD, r = nwg % NXCD, xcd = wgid % NXCD, off = wgid / NXCD; wgid = (xcd < r ? xcd * (q + 1) : r * (q + 1) + (xcd - r) * q) + off; }
        const int nig = WGM * nN, gid = wgid / nig, fm = gid * WGM, gsz = (nM - fm) < WGM ? (nM - fm) : WGM;
        u.pm = fm + ((wgid % nig) % gsz); u.pn = (wgid % nig) / gsz; return true;
    }
    __device__ __forceinline__ void a_ready(const Unit&) const {}
    __device__ __forceinline__ void done(const Unit&) const {}
};

__device__ __forceinline__ unsigned cvt_pk_bf16(float lo, float hi) { unsigned r; asm volatile("v_cvt_pk_bf16_f32 %0, %1, %2" : "=v"(r) : "v"(lo), "v"(hi)); return r; }
typedef float f32x2 __attribute__((ext_vector_type(2)));
typedef unsigned u32x2 __attribute__((ext_vector_type(2)));
__device__ __forceinline__ float row_partial_sum(const float* p, int ns4, int fq) {
    float s = 0.f;
    if (fq < ns4) { const f32x4 v = *(const f32x4*)(p + 4 * fq); s = (v[0] + v[1]) + (v[2] + v[3]); }
    s = sum_fq(s);
    return s;
}
__device__ __forceinline__ float rowscale(const float* p, int ns4, int fq, float inv_n) { return rsqrtf(row_partial_sum(p, ns4, fq) * inv_n + 1e-6f); }

__device__ __forceinline__ void rowscales8(float (&rs)[2][4], const float* base, int row0, int pitch, int ns4, int fq, float inv_n) {
    f32x4 v[2][4]; const int fqc = fq < ns4 ? fq : ns4 - 1;
#pragma unroll
    for (int ai = 0; ai < 2; ++ai)
#pragma unroll
        for (int m = 0; m < 4; ++m) v[ai][m] = *(const f32x4*)(base + (unsigned)(row0 + ai * HALF + m * 16) * (unsigned)pitch + 4 * fqc);
#pragma unroll
    for (int ai = 0; ai < 2; ++ai)
#pragma unroll
        for (int m = 0; m < 4; ++m) { const float p = (v[ai][m][0] + v[ai][m][1]) + (v[ai][m][2] + v[ai][m][3]); const float s = sum_fq(fq < ns4 ? p : 0.f); rs[ai][m] = rsqrtf(s * inv_n + 1e-6f); }
}

__device__ __forceinline__ void rowscales4(float (&rs)[4], const float* base, int row0, int pitch, int ns4, int fq, float inv_n) {
    f32x4 v[4]; const int fqc = fq < ns4 ? fq : ns4 - 1;
#pragma unroll
    for (int m = 0; m < 4; ++m) v[m] = *(const f32x4*)(base + (unsigned)(row0 + m * 16) * (unsigned)pitch + 4 * fqc);
#pragma unroll
    for (int m = 0; m < 4; ++m) { const float p = (v[m][0] + v[m][1]) + (v[m][2] + v[m][3]); const float s = sum_fq(fq < ns4 ? p : 0.f); rs[m] = rsqrtf(s * inv_n + 1e-6f); }
}

__device__ __forceinline__ unsigned swiglu2(const f32x2 g, const f32x2 u, const float k, const float r2) {
    const f32x2 t = g * k;
    f32x2 e; e.x = __builtin_amdgcn_exp2f(t.x); e.y = __builtin_amdgcn_exp2f(t.y);
    const f32x2 d = e + 1.0f;
    f32x2 rc; rc.x = __builtin_amdgcn_rcpf(d.x); rc.y = __builtin_amdgcn_rcpf(d.y);
    const f32x2 o = (g * u) * (rc * r2);
    return cvt_pk_bf16(o.x, o.y);
}
struct EpiSwiGLU {
    static constexpr bool PERM = true, AFTER_DRAIN = false;
    unsigned char* ws; size_t ss_off;
    __device__ __forceinline__ void operator()(const f32x4 (&acc)[2][2][4][2], const Unit& u, int wr, int wc, int fr, int fq) const {
        bf16_t* HID = (bf16_t*)(ws + B_HID); const float* SS = (const float*)(ws + ss_off);
        const int row0 = u.pm * BM + wr * 64 + fr, hc0 = u.pn * 128 + wc * 32 + 8 * fq;
        float rs[2][4]; rowscales8(rs, SS, row0, 16, 4, fq, 1.0f / 1024.0f);
#pragma unroll
        for (int ai = 0; ai < 2; ++ai)
#pragma unroll
            for (int m = 0; m < 4; ++m) {
                const int row = row0 + ai * HALF + m * 16; const float r = rs[ai][m], k = r * -1.4426950408889634f, r2 = r * r;
                const f32x4 g0 = acc[ai][0][m][0], g1 = acc[ai][0][m][1], u0 = acc[ai][1][m][0], u1 = acc[ai][1][m][1];
                u32x4 w; w.x = swiglu2(g0.xy, u0.xy, k, r2); w.y = swiglu2(g0.zw, u0.zw, k, r2); w.z = swiglu2(g1.xy, u1.xy, k, r2); w.w = swiglu2(g1.zw, u1.zw, k, r2);
                *(u32x4*)(HID + ((unsigned)row * 2816u + (unsigned)hc0)) = w;
            }
    }
};

__device__ __forceinline__ void unpack8f(const u32x4 w, float (&f)[8]) {
    f[0] = __builtin_bit_cast(float, w.x << 16); f[1] = __builtin_bit_cast(float, w.x & 0xffff0000u); f[2] = __builtin_bit_cast(float, w.y << 16); f[3] = __builtin_bit_cast(float, w.y & 0xffff0000u);
    f[4] = __builtin_bit_cast(float, w.z << 16); f[5] = __builtin_bit_cast(float, w.z & 0xffff0000u); f[6] = __builtin_bit_cast(float, w.w << 16); f[7] = __builtin_bit_cast(float, w.w & 0xffff0000u);
}
struct EpiResid {
    static constexpr bool PERM = true, AFTER_DRAIN = false;
    unsigned char* ws; size_t src_off, dst_off, sso_off, bias_off; float alpha;
    __device__ __forceinline__ void operator()(const f32x4 (&acc)[2][2][4][2], const Unit& u, int wr, int wc, int fr, int fq) const {
        const bf16_t* SRC = (const bf16_t*)(ws + src_off); bf16_t* DST = (bf16_t*)(ws + dst_off); float* SSo = (float*)(ws + sso_off);
        const int row0 = u.pm * BM + wr * 64 + fr, col0 = u.pn * BM + wc * 32 + 8 * fq;
        u32x4 hx[2][4][2];
#pragma unroll
        for (int ai = 0; ai < 2; ++ai)
#pragma unroll
            for (int m = 0; m < 4; ++m)
#pragma unroll
                for (int bj = 0; bj < 2; ++bj) hx[ai][m][bj] = *(const u32x4*)(SRC + (unsigned)(row0 + ai * HALF + m * 16) * 1024u + col0 + bj * HALF);
        f32x4 bv[2][2];
#pragma unroll
        for (int bj = 0; bj < 2; ++bj)
#pragma unroll
            for (int n = 0; n < 2; ++n) bv[bj][n] = bias_off ? *(const f32x4*)((const float*)(ws + bias_off) + col0 + bj * HALF + 4 * n) : (f32x4){0.f, 0.f, 0.f, 0.f};
#pragma unroll
        for (int ai = 0; ai < 2; ++ai)
#pragma unroll
            for (int m = 0; m < 4; ++m) {
                const int row = row0 + ai * HALF + m * 16; float ssq = 0.f;
#pragma unroll
                for (int bj = 0; bj < 2; ++bj) {
                    float h[8]; unpack8f(hx[ai][m][bj], h);
                    const f32x4 a0 = acc[ai][bj][m][0] * alpha + bv[bj][0], a1 = acc[ai][bj][m][1] * alpha + bv[bj][1];
                    h[0] += a0[0]; h[1] += a0[1]; h[2] += a0[2]; h[3] += a0[3]; h[4] += a1[0]; h[5] += a1[1]; h[6] += a1[2]; h[7] += a1[3];
                    u32x4 w; w.x = cvt_pk_bf16(h[0], h[1]); w.y = cvt_pk_bf16(h[2], h[3]); w.z = cvt_pk_bf16(h[4], h[5]); w.w = cvt_pk_bf16(h[6], h[7]);
                    *(u32x4*)(DST + (unsigned)row * 1024u + col0 + bj * HALF) = w;
                    ssq += (h[0] * h[0] + h[1] * h[1]) + (h[2] * h[2] + h[3] * h[3]) + (h[4] * h[4] + h[5] * h[5]) + (h[6] * h[6] + h[7] * h[7]);
                }
                ssq = sum_fq(ssq);
                if (fq == 0) SSo[(unsigned)row * 16u + u.pn * 4 + wc] = ssq;
            }
    }
};

struct EpiWin {
    static constexpr bool PERM = true, AFTER_DRAIN = false;
    unsigned char* ws;
    __device__ __forceinline__ void operator()(const f32x4 (&acc)[2][2][4][2], const Unit& u, int wr, int wc, int fr, int fq) const {
        const float* SS = (const float*)(ws + WS_SS) + (size_t)MTOK * 16;
        bf16_t* CQ = (bf16_t*)(ws + B_CQ); bf16_t* CKV = (bf16_t*)(ws + B_CKV); bf16_t* KR = (bf16_t*)(ws + B_KR); bf16_t* MX = (bf16_t*)(ws + B_MX); bf16_t* MV = (bf16_t*)(ws + B_MV);
        bf16_t* MO = (bf16_t*)(ws + B_MO); bf16_t* FQ = (bf16_t*)(ws + B_FQ); float* MIF = (float*)(ws + B_MIF); float* SSQ = (float*)(ws + B_SSQ);
        const float* ropec = (const float*)(ws + WS_ROPEC); const float* ropes = (const float*)(ws + WS_ROPES);
        const int row0 = u.pm * BM + wr * 64 + fr; const int pn = u.pn;
        float rsv[2][4]; rowscales8(rsv, SS, row0, 16, 4, fq, 1.0f / 1024.0f);
        const bool kr = (pn == 2) && (wc < 2);
        const unsigned kj0 = (unsigned)(wc * 32 + 8 * fq) >> 1;
#pragma unroll
        for (int ai = 0; ai < 2; ++ai) {
            f32x4 cv[4], sv[4];
#pragma unroll
            for (int m = 0; m < 4; ++m) { cv[m] = (f32x4){1.f, 1.f, 1.f, 1.f}; sv[m] = (f32x4){0.f, 0.f, 0.f, 0.f}; }
            if (kr) {
#pragma unroll
                for (int m = 0; m < 4; ++m) { const unsigned ro = (unsigned)(row0 + ai * HALF + m * 16) * 32u + kj0; cv[m] = *(const f32x4*)(ropec + ro); sv[m] = *(const f32x4*)(ropes + ro); }
#pragma unroll
                for (int m = 0; m < 4; ++m) asm volatile("" : "+v"(cv[m]), "+v"(sv[m]));
            }
#pragma unroll
            for (int m = 0; m < 4; ++m) {
                const int row = row0 + ai * HALF + m * 16; const float rs = rsv[ai][m];
#pragma unroll
                for (int bj = 0; bj < 2; ++bj) {
                    const f32x4 v0 = acc[ai][bj][m][0] * rs, v1 = acc[ai][bj][m][1] * rs;
                    const int cl = bj * HALF + wc * 32 + 8 * fq;
                    u32x4 w; w.x = cvt_pk_bf16(v0[0], v0[1]); w.y = cvt_pk_bf16(v0[2], v0[3]); w.z = cvt_pk_bf16(v1[0], v1[1]); w.w = cvt_pk_bf16(v1[2], v1[3]);
                    float ssq = (v0[0] * v0[0] + v0[1] * v0[1]) + (v0[2] * v0[2] + v0[3] * v0[3]) + (v1[0] * v1[0] + v1[1] * v1[1]) + (v1[2] * v1[2] + v1[3] * v1[3]);
                    const int gcol = pn * BM + cl;
                    if (pn <= 2 && gcol < 640) {
                        ssq = sum_fq(ssq);
                        const int grp = pn * 2 + bj;
                        if (fq == 0) SSQ[(unsigned)row * 32u + (unsigned)(grp * 4 + wc)] = ssq;
                        if (gcol < 384) *(u32x4*)(CQ + ((unsigned)row * 384u + (unsigned)gcol)) = w;
                        else *(u32x4*)(CKV + ((unsigned)row * 256u + (unsigned)(gcol - 384))) = w;
                    } else if (pn == 2) {
                        if (gcol < 704) {
                            const f32x4 c = cv[m], s = sv[m];
                            u32x4 o; o.x = cvt_pk_bf16(v0[0] * c[0] - v0[1] * s[0], v0[1] * c[0] + v0[0] * s[0]);
                            o.y = cvt_pk_bf16(v0[2] * c[1] - v0[3] * s[1], v0[3] * c[1] + v0[2] * s[1]);
                            o.z = cvt_pk_bf16(v1[0] * c[2] - v1[1] * s[2], v1[1] * c[2] + v1[0] * s[2]);
                            o.w = cvt_pk_bf16(v1[2] * c[3] - v1[3] * s[3], v1[3] * c[3] + v1[2] * s[3]);
                            *(u32x4*)(KR + ((unsigned)row * 64u + (unsigned)(gcol - 640))) = o;
                        } else if (gcol < 720) {
                            *(f32x4*)(MIF + ((unsigned)row * 16u + (unsigned)(gcol - 704))) = v0; *(f32x4*)(MIF + ((unsigned)row * 16u + (unsigned)(gcol - 704) + 4u)) = v1;
                        }
                    } else if (pn == 3) { *(u32x4*)(MX + ((unsigned)row * 256u + (unsigned)cl)) = w;
                    } else if (pn == 4) { *(u32x4*)(MV + ((unsigned)row * 256u + (unsigned)cl)) = w;
                    } else if (pn == 5) { *(u32x4*)(MO + ((unsigned)row * 256u + (unsigned)cl)) = w;
                    } else {
                        const int b = row >> 13, s_ = row & 8191, quad = cl >> 2;
                        bf16_t* p = FQ + (((unsigned)(b * 64 + quad) * 8192u + (unsigned)s_) << 2);
                        u32x2 lo, hi; lo.x = w.x; lo.y = w.y; hi.x = w.z; hi.y = w.w;
                        *(u32x2*)p = lo; *(u32x2*)(p + (size_t)8192 * 4) = hi;
                    }
                }
            }
        }
    }
};

struct EpiQ {
    static constexpr bool PERM = true, AFTER_DRAIN = false;
    unsigned char* ws;
    __device__ __forceinline__ void operator()(const f32x4 (&acc)[2][2][4][2], const Unit& u, int wr, int wc, int fr, int fq) const {
        const float* SSQ = (const float*)(ws + B_SSQ); bf16_t* Q = (bf16_t*)(ws + B_Q); const float* ropec = (const float*)(ws + WS_ROPEC); const float* ropes = (const float*)(ws + WS_ROPES);
        const int row0 = u.pm * BM + wr * 64 + fr;
        const int g0 = u.pn * BM + wc * 32; const bool rp0 = (g0 % 192) >= 128, rp1 = ((g0 + HALF) % 192) >= 128; const bool has_rope = rp0 || rp1; const int rbj = rp0 ? 0 : 1;
        const unsigned j0 = has_rope ? ((unsigned)(((g0 + rbj * HALF) % 192) - 128 + 8 * fq) >> 1) : 0u;
        f32x4 cva[2][4], sva[2][4];
#pragma unroll
        for (int ai = 0; ai < 2; ++ai)
#pragma unroll
            for (int m = 0; m < 4; ++m) { cva[ai][m] = (f32x4){1.f, 1.f, 1.f, 1.f}; sva[ai][m] = (f32x4){0.f, 0.f, 0.f, 0.f}; }
        if (has_rope) {
#pragma unroll
            for (int ai = 0; ai < 2; ++ai)
#pragma unroll
                for (int m = 0; m < 4; ++m) { const unsigned ro = (unsigned)(row0 + ai * HALF + m * 16) * 32u + j0; cva[ai][m] = *(const f32x4*)(ropec + ro); sva[ai][m] = *(const f32x4*)(ropes + ro); }
        }
        float rsv[2][4]; rowscales8(rsv, SSQ, row0, 32, 3, fq, 1.0f / 384.0f);
#pragma unroll
        for (int ai = 0; ai < 2; ++ai)
#pragma unroll
            for (int m = 0; m < 4; ++m) asm volatile("" : "+v"(cva[ai][m]), "+v"(sva[ai][m]));
#pragma unroll
        for (int ai = 0; ai < 2; ++ai) {
            const f32x4 (&cv)[4] = cva[ai]; const f32x4 (&sv)[4] = sva[ai];
#pragma unroll
            for (int m = 0; m < 4; ++m) {
                const int row = row0 + ai * HALF + m * 16; const float rs = rsv[ai][m];
#pragma unroll
                for (int bj = 0; bj < 2; ++bj) {
                    const f32x4 v0 = acc[ai][bj][m][0] * rs, v1 = acc[ai][bj][m][1] * rs;
                    const int gcol = u.pn * BM + bj * HALF + wc * 32 + 8 * fq;
                    u32x4 o;
                    if (has_rope && bj == rbj) {
                        const f32x4 c = cv[m], s = sv[m];
                        o.x = cvt_pk_bf16(v0[0] * c[0] - v0[1] * s[0], v0[1] * c[0] + v0[0] * s[0]);
                        o.y = cvt_pk_bf16(v0[2] * c[1] - v0[3] * s[1], v0[3] * c[1] + v0[2] * s[1]);
                        o.z = cvt_pk_bf16(v1[0] * c[2] - v1[1] * s[2], v1[1] * c[2] + v1[0] * s[2]);
                        o.w = cvt_pk_bf16(v1[2] * c[3] - v1[3] * s[3], v1[3] * c[3] + v1[2] * s[3]);
                    } else { o.x = cvt_pk_bf16(v0[0], v0[1]); o.y = cvt_pk_bf16(v0[2], v0[3]); o.z = cvt_pk_bf16(v1[0], v1[1]); o.w = cvt_pk_bf16(v1[2], v1[3]); }
                    *(u32x4*)(Q + ((unsigned)row * 768u + (unsigned)gcol)) = o;
                }
            }
        }
    }
};

struct EpiKV {
    static constexpr bool PERM = true, AFTER_DRAIN = false;
    unsigned char* ws;
    __device__ __forceinline__ void operator()(const f32x4 (&acc)[2][2][4][2], const Unit& u, int wr, int wc, int fr_, int fq_) const {
        int ln_ = (int)__builtin_amdgcn_mbcnt_hi(~0u, __builtin_amdgcn_mbcnt_lo(~0u, 0u)); asm volatile("" : "+v"(ln_));
        const int fr = ln_ & 15, fq = ln_ >> 4; (void)fr_; (void)fq_;
        const float* SSQ = (const float*)(ws + B_SSQ); bf16_t* KN = (bf16_t*)(ws + B_KN); bf16_t* V = (bf16_t*)(ws + B_V);
        const int row0 = u.pm * BM + wr * 64 + fr;
        float rsv[2][4]; rowscales8(rsv, SSQ + 12, row0, 32, 2, fq, 1.0f / 256.0f);
#pragma unroll
        for (int ai = 0; ai < 2; ++ai)
#pragma unroll
            for (int m = 0; m < 4; ++m) {
                const int row = row0 + ai * HALF + m * 16; const float rs = rsv[ai][m];
#pragma unroll
                for (int bj = 0; bj < 2; ++bj) {
                    const f32x4 v0 = acc[ai][bj][m][0] * rs, v1 = acc[ai][bj][m][1] * rs;
                    u32x4 o; o.x = cvt_pk_bf16(v0[0], v0[1]); o.y = cvt_pk_bf16(v0[2], v0[3]); o.z = cvt_pk_bf16(v1[0], v1[1]); o.w = cvt_pk_bf16(v1[2], v1[3]);
                    bf16_t* dst = (bj == 0 ? KN : V) + ((unsigned)row * 512u + u.pn * 128 + wc * 32 + 8 * fq);
                    *(u32x4*)dst = o;
                }
            }
    }
};

struct EpiE {
    static constexpr bool PERM = true, AFTER_DRAIN = false;
    unsigned char* ws; const float* gpost;
    __device__ __forceinline__ void operator()(const f32x4 (&acc)[2][2][4][2], const Unit& u, int wr, int wc, int fr, int fq) const {
        bf16_t* E = (bf16_t*)(ws + B_E); float* SSE = (float*)(ws + B_SSE);
        const int row0 = u.pm * BM + wr * 64 + fr;
        f32x4 gp[2][2];
#pragma unroll
        for (int bj = 0; bj < 2; ++bj)
#pragma unroll
            for (int n = 0; n < 2; ++n) gp[bj][n] = *(const f32x4*)(gpost + u.pn * BM + bj * HALF + wc * 32 + 8 * fq + 4 * n);
#pragma unroll
        for (int ai = 0; ai < 2; ++ai)
#pragma unroll
            for (int m = 0; m < 4; ++m) {
                const int row = row0 + ai * HALF + m * 16; float ssq = 0.f;
#pragma unroll
                for (int bj = 0; bj < 2; ++bj) {
                    const f32x4 v0 = acc[ai][bj][m][0], v1 = acc[ai][bj][m][1]; const f32x4 g0 = gp[bj][0], g1 = gp[bj][1];
                    u32x4 o; o.x = cvt_pk_bf16(v0[0] * g0[0], v0[1] * g0[1]); o.y = cvt_pk_bf16(v0[2] * g0[2], v0[3] * g0[3]); o.z = cvt_pk_bf16(v1[0] * g1[0], v1[1] * g1[1]); o.w = cvt_pk_bf16(v1[2] * g1[2], v1[3] * g1[3]);
                    ssq += (v0[0] * v0[0] + v0[1] * v0[1]) + (v0[2] * v0[2] + v0[3] * v0[3]) + (v1[0] * v1[0] + v1[1] * v1[1]) + (v1[2] * v1[2] + v1[3] * v1[3]);
                    *(u32x4*)(E + ((unsigned)row * 1024u + (unsigned)(u.pn * BM + bj * HALF + wc * 32 + 8 * fq))) = o;
                }
                ssq = sum_fq(ssq);
                if (fq == 0) SSE[(unsigned)row * 16u + (unsigned)(u.pn * 4 + wc)] = ssq;
            }
    }
};

struct EpiPle {
    static constexpr bool PERM = true, AFTER_DRAIN = false;
    unsigned char* ws;
    __device__ __forceinline__ void operator()(const f32x4 (&acc)[2][2][4][2], const Unit& u, int wr, int wc, int fr, int fq) const {
        const bf16_t* SRC = (const bf16_t*)(ws + WS_XB0); bf16_t* DST = (bf16_t*)(ws + B_XB1); float* SSo = (float*)(ws + WS_SS); const float* SSi = SSo + (size_t)MTOK * 16;
        const bf16_t* E = (const bf16_t*)(ws + B_E); const float* SSE = (const float*)(ws + B_SSE);
        const int row0 = u.pm * BM + wr * 64 + fr, col0 = u.pn * BM + wc * 32 + 8 * fq;
#pragma unroll
        for (int ai = 0; ai < 2; ++ai) {
            float rsv[4], rev[4]; rowscales4(rsv, SSi, row0 + ai * HALF, 16, 4, fq, 1.0f / 1024.0f); rowscales4(rev, SSE, row0 + ai * HALF, 16, 4, fq, 1.0f / 1024.0f);
            asm volatile("" ::: "memory");
            u32x4 hx[4][2], ex[4][2];
#pragma unroll
            for (int m = 0; m < 4; ++m)
#pragma unroll
                for (int bj = 0; bj < 2; ++bj) { const unsigned off = (unsigned)(row0 + ai * HALF + m * 16) * 1024u + col0 + bj * HALF; hx[m][bj] = *(const u32x4*)(SRC + off); ex[m][bj] = *(const u32x4*)(E + off); }
#pragma unroll
            for (int m = 0; m < 4; ++m) {
                const int row = row0 + ai * HALF + m * 16; float ssq = 0.f; const float rs = rsv[m], re = rev[m];
#pragma unroll
                for (int bj = 0; bj < 2; ++bj) {
                    float h[8], e[8]; unpack8f(hx[m][bj], h); unpack8f(ex[m][bj], e);
                    const f32x4 a0 = acc[ai][bj][m][0] * rs, a1 = acc[ai][bj][m][1] * rs;
                    h[0] += sigmoidf_(a0[0]) * (e[0] * re); h[1] += sigmoidf_(a0[1]) * (e[1] * re); h[2] += sigmoidf_(a0[2]) * (e[2] * re); h[3] += sigmoidf_(a0[3]) * (e[3] * re);
                    h[4] += sigmoidf_(a1[0]) * (e[4] * re); h[5] += sigmoidf_(a1[1]) * (e[5] * re); h[6] += sigmoidf_(a1[2]) * (e[6] * re); h[7] += sigmoidf_(a1[3]) * (e[7] * re);
                    u32x4 w; w.x = cvt_pk_bf16(h[0], h[1]); w.y = cvt_pk_bf16(h[2], h[3]); w.z = cvt_pk_bf16(h[4], h[5]); w.w = cvt_pk_bf16(h[6], h[7]);
                    *(u32x4*)(DST + (unsigned)row * 1024u + col0 + bj * HALF) = w;
                    ssq += (h[0] * h[0] + h[1] * h[1]) + (h[2] * h[2] + h[3] * h[3]) + (h[4] * h[4] + h[5] * h[5]) + (h[6] * h[6] + h[7] * h[7]);
                }
                ssq = sum_fq(ssq);
                if (fq == 0) SSo[(unsigned)row * 16u + u.pn * 4 + wc] = ssq;
            }
        }
    }
};


struct OneRound : StaticOrder {
    int r;
    __device__ __forceinline__ bool next(int i, Unit& u) const { return i == 0 && StaticOrder::next(r, u); }
};

struct UnitG;
struct EpiQKV {
    static constexpr bool PERM = true, AFTER_DRAIN = false;
    unsigned char* ws;
    template <class U> __device__ __forceinline__ void operator()(const f32x4 (&acc)[2][2][4][2], const U& u, int wr, int wc, int fr, int fq) const {
        const Unit uu{u.pm, u.pn};
        if (u.gi == 0) { const EpiQ e{ws}; e(acc, uu, wr, wc, fr, fq); } else { const EpiKV e{ws}; e(acc, uu, wr, wc, fr, fq); }
    }
};
struct OrderQKV {
    int G, v;
    template <class U> __device__ __forceinline__ bool next(int i, U& u) const {
        int qn = -1, kn = -1;
        if (G == 256) {
            const int pmv = v >> 1;
            if ((v & 1) == 0) { if (i < 3) qn = 3 * pmv + i; else return false; }
            else { if (i < 4) kn = 4 * pmv + i; else return false; }
        } else { const int L = i * G + v; if (L < 384) qn = L; else if (L < 896) kn = L - 384; else return false; }
        if (qn >= 0) { u.pm = qn / 3; u.pn = qn - 3 * (qn / 3); u.gi = 0; } else { u.pm = kn >> 2; u.pn = kn & 3; u.gi = 1; }
        return true;
    }
};

struct TouchOrder : StaticOrder {
    const bf16_t* t0; const bf16_t* t1; PG8_LAS unsigned char* junk; int wv;
    __device__ __forceinline__ void a_ready(const Unit& u) const {
        const int lane = (int)__builtin_amdgcn_mbcnt_hi(~0u, __builtin_amdgcn_mbcnt_lo(~0u, 0u));
#pragma unroll
        for (int k = 0; k < 2; ++k) { const int idx = wv * 128 + k * 64 + lane; const int row = idx >> 2, seg = idx & 3;
            const size_t off = ((size_t)(u.pm * BM + row) * 1024 + u.pn * BM + seg * 64);
            __builtin_amdgcn_global_load_lds((const unsigned*)(t0 + off), (PG8_LAS unsigned*)(junk + wv * 1024), 16, 0, 0);
            if (t1) __builtin_amdgcn_global_load_lds((const unsigned*)(t1 + off), (PG8_LAS unsigned*)(junk + wv * 1024), 16, 0, 0); }
    }
};
template <class Epi, class Sched, bool ALIGN_EPI = false, bool SP2 = false>
__device__ __forceinline__ void gemm_phase(PG8_LAS unsigned char* lds, const Gemm g, const Sched& S, const Epi& E, const int wv) {
    const int tid = opaque_tid(wv), wid = __builtin_amdgcn_readfirstlane(tid >> 6), lane = tid & 63, wr = wid >> 2, wc = wid & 3, fr = lane & 15, fq = lane >> 4;
    int K_ = g.K; asm volatile("" : "+s"(K_)); const int K = K_, nt = K / BK;
    unsigned voffA[2], voffB[2];
#pragma unroll
    for (int i = 0; i < 2; ++i) { int R, C; stage_rc(tid * 16 + i * 8192, R, C); const int Rb = Epi::PERM ? ((R & ~31) + perm32(R & 31)) : R;
        voffA[i] = (unsigned)(R * K + C) * 2u; voffB[i] = (unsigned)(Rb * K + C) * 2u; }
    const size_t kstep = (size_t)(BK * 2);
    const size_t hstep = (size_t)HALF * K * 2;
    const size_t tstep = 2 * hstep;
    const unsigned ldsw = (unsigned)wid * 1024u;
    const int aoff = lds_byte(wr * 64 + fr, fq * 8), boff = lds_byte(wc * 32 + fr, fq * 8);
#define PG8_SA(b, h) (((b) * 2 + (h)) * HTB)
#define PG8_SB(b, h) ((4 + (b) * 2 + (h)) * HTB)
#define PG8_STAGE(bufoff, gbase, voff) do { _Pragma("unroll") for (int _i = 0; _i < 2; ++_i) \
        __builtin_amdgcn_global_load_lds((const unsigned*)((const char*)(gbase) + (voff)[_i]), (PG8_LAS unsigned*)(lds + (bufoff) + ldsw + _i * 8192), 16, 0, 0); } while (0)
#define PG8_LDA(dst, b, h) do { _Pragma("unroll") for (int m = 0; m < 4; ++m) _Pragma("unroll") for (int k = 0; k < 2; ++k) dst[m][k] = *(const PG8_LAS bf16x8*)(lds + PG8_SA(b, h) + aoff + m * 2048 + k * 1024); } while (0)
#define PG8_LDB(dst, b, h) do { _Pragma("unroll") for (int n = 0; n < 2; ++n) _Pragma("unroll") for (int k = 0; k < 2; ++k) dst[n][k] = *(const PG8_LAS bf16x8*)(lds + PG8_SB(b, h) + boff + n * 2048 + k * 1024); } while (0)
#define PG8_MMA(ai, bj, At, Bt) do { __builtin_amdgcn_s_setprio(1); _Pragma("unroll") for (int m = 0; m < 4; ++m) _Pragma("unroll") for (int n = 0; n < 2; ++n) _Pragma("unroll") for (int k = 0; k < 2; ++k) \
        acc[ai][bj][m][n] = __builtin_amdgcn_mfma_f32_16x16x32_bf16(Bt[n][k], At[m][k], acc[ai][bj][m][n], 0, 0, 0); __builtin_amdgcn_s_setprio(0); } while (0)
#define PG8_WAIT_V(n) asm volatile("s_waitcnt vmcnt(" #n ")" ::: "memory")
#define PG8_WAIT_L(n) asm volatile("s_waitcnt lgkmcnt(" #n ")" ::: "memory")
#define PG8_BAR __builtin_amdgcn_s_barrier()
#define PG8_SCHED __builtin_amdgcn_sched_barrier(0)
#ifdef PROBE_GEMM
#define PG8_PON() ({ volatile PG8_LAS unsigned* mm_ = (volatile PG8_LAS unsigned*)(lds + MISC_OFF); (mm_[20] && tid == 0 && blockIdx.x == 0); })
#define PG8_PT(var) do { if (PG8_PON()) var = __builtin_amdgcn_s_memrealtime(); } while (0)
#define PG8_PACC(var) do { if (PG8_PON()) { volatile PG8_LAS unsigned* mm_ = (volatile PG8_LAS unsigned*)(lds + MISC_OFF); const unsigned long long d_ = __builtin_amdgcn_s_memrealtime() - var; \
        unsigned long long a_ = ((unsigned long long)mm_[23] << 32) | mm_[22]; a_ += d_; mm_[22] = (unsigned)a_; mm_[23] = (unsigned)(a_ >> 32); } } while (0)
    unsigned long long pk_ = 0;
#endif
    Unit cur, nxt; int ui = 0;
    if (!S.next(0, cur)) return;
    f32x4 acc[2][2][4][2]; float zz_ = 0.f; asm volatile("" : "+v"(zz_));
#pragma unroll
    for (int a = 0; a < 2; ++a)
#pragma unroll
        for (int b = 0; b < 2; ++b)
#pragma unroll
            for (int m = 0; m < 4; ++m)
#pragma unroll
                for (int n = 0; n < 2; ++n) acc[a][b][m][n] = (f32x4){zz_, zz_, zz_, zz_};
    bf16x8 At[4][2], B0[2][2], B1[2][2];
#ifdef GEMM_FAKE_L2
#define PG8_PMI(x) ((x) & 0)
#else
#define PG8_PMI(x) (x)
#endif
    const char* cA = (const char*)g.A + (size_t)PG8_PMI(cur.pm) * tstep; const char* cB = (const char*)g.Bt + (size_t)PG8_PMI(cur.pn) * tstep;
    S.a_ready(cur);
    if constexpr (SP2) {
        PG8_STAGE(PG8_SB(0, 0), cB, voffB); PG8_STAGE(PG8_SB(0, 1), cB + hstep, voffB); PG8_STAGE(PG8_SA(0, 0), cA, voffA); PG8_STAGE(PG8_SA(0, 1), cA + hstep, voffA);
        if (wr == 1) PG8_BAR;
        PG8_WAIT_V(2); PG8_BAR;
        PG8_STAGE(PG8_SB(1, 0), cB + kstep, voffB); PG8_STAGE(PG8_SA(1, 0), cA + kstep, voffA); PG8_STAGE(PG8_SB(1, 1), cB + hstep + kstep, voffB);
        PG8_WAIT_V(6); PG8_BAR;
    } else {
        PG8_STAGE(PG8_SB(0, 0), cB, voffB); PG8_STAGE(PG8_SA(0, 0), cA, voffA); PG8_STAGE(PG8_SB(0, 1), cB + hstep, voffB); PG8_STAGE(PG8_SA(0, 1), cA + hstep, voffA);
        if (wr == 1) PG8_BAR;
        PG8_WAIT_V(4); PG8_BAR;
        PG8_STAGE(PG8_SB(1, 0), cB + kstep, voffB); PG8_STAGE(PG8_SA(1, 0), cA + kstep, voffA); PG8_STAGE(PG8_SB(1, 1), cB + hstep + kstep, voffB);
        PG8_WAIT_V(6); PG8_BAR;
    }
    for (;;) {
        const bool has_next = S.next(ui + 1, nxt);
        const char* nA = has_next ? (const char*)g.A + (size_t)PG8_PMI(nxt.pm) * tstep : cA; const char* nB = has_next ? (const char*)g.Bt + (size_t)PG8_PMI(nxt.pn) * tstep : cB;
#if defined(PROBE_GEMM) && (PROBE_GEMM == 3)
        PG8_PT(pk_);
#endif
#if defined(PROBE_GEMM) && (PROBE_GEMM == 5)
        if (ui > 0) PG8_PACC(pk_);
#endif
        for (int t = 0; t < nt; t += 2) {
            const bool last = (t == nt - 2);
            const char* a1 = cA + (size_t)(t + 1) * kstep;
            const char* a2 = last ? nA : cA + (size_t)(t + 2) * kstep; const char* b2 = last ? nB : cB + (size_t)(t + 2) * kstep;
            const char* a3 = a2 + kstep; const char* b3 = b2 + kstep;
            if (last && has_next) S.a_ready(nxt);
            if constexpr (SP2) {
            PG8_LDB(B0, 0, 0); PG8_LDB(B1, 0, 1); PG8_SCHED; PG8_LDA(At, 0, 0); PG8_STAGE(PG8_SA(1, 1), a1 + hstep, voffA);
            PG8_WAIT_V(8); PG8_WAIT_L(0); PG8_BAR; PG8_MMA(0, 0, At, B0); PG8_MMA(0, 1, At, B1); PG8_BAR; PG8_SCHED;
            PG8_LDA(At, 0, 1); PG8_STAGE(PG8_SB(0, 0), b2, voffB); PG8_STAGE(PG8_SB(0, 1), b2 + hstep, voffB); PG8_STAGE(PG8_SA(0, 0), a2, voffA);
            PG8_WAIT_V(8); PG8_WAIT_L(0); PG8_BAR; PG8_MMA(1, 0, At, B0); PG8_MMA(1, 1, At, B1); PG8_BAR; PG8_SCHED;
            PG8_LDB(B0, 1, 0); PG8_LDB(B1, 1, 1); PG8_SCHED; PG8_LDA(At, 1, 0); PG8_STAGE(PG8_SA(0, 1), a2 + hstep, voffA);
            PG8_WAIT_V(8); PG8_WAIT_L(0); PG8_BAR; PG8_MMA(0, 0, At, B0); PG8_MMA(0, 1, At, B1); PG8_BAR; PG8_SCHED;
            PG8_LDA(At, 1, 1); PG8_STAGE(PG8_SB(1, 0), b3, voffB); PG8_STAGE(PG8_SB(1, 1), b3 + hstep, voffB); PG8_STAGE(PG8_SA(1, 0), a3, voffA);
            PG8_WAIT_V(8); PG8_WAIT_L(0); PG8_BAR; PG8_MMA(1, 0, At, B0); PG8_MMA(1, 1, At, B1); PG8_BAR; PG8_SCHED;
            } else {
            PG8_LDB(B0, 0, 0); PG8_SCHED; PG8_LDA(At, 0, 0); PG8_STAGE(PG8_SA(1, 1), a1 + hstep, voffA);
            PG8_WAIT_L(8); PG8_BAR; PG8_WAIT_L(0); PG8_MMA(0, 0, At, B0); PG8_BAR; PG8_SCHED;
            PG8_LDB(B1, 0, 1); PG8_STAGE(PG8_SB(0, 0), b2, voffB);
            PG8_BAR; PG8_WAIT_L(0); PG8_MMA(0, 1, At, B1); PG8_BAR;
            PG8_LDA(At, 0, 1); PG8_STAGE(PG8_SA(0, 0), a2, voffA);
            PG8_BAR; PG8_WAIT_L(0); PG8_MMA(1, 0, At, B0); PG8_BAR; PG8_SCHED;
            PG8_STAGE(PG8_SB(0, 1), b2 + hstep, voffB);
            PG8_WAIT_V(6); PG8_BAR; PG8_MMA(1, 1, At, B1); PG8_BAR;
            PG8_LDB(B0, 1, 0); PG8_SCHED; PG8_LDA(At, 1, 0); PG8_STAGE(PG8_SA(0, 1), a2 + hstep, voffA);
            PG8_WAIT_L(8); PG8_BAR; PG8_WAIT_L(0); PG8_MMA(0, 0, At, B0); PG8_BAR; PG8_SCHED;
            PG8_LDB(B1, 1, 1); PG8_STAGE(PG8_SB(1, 0), b3, voffB);
            PG8_BAR; PG8_WAIT_L(0); PG8_MMA(0, 1, At, B1); PG8_BAR;
            PG8_LDA(At, 1, 1); PG8_STAGE(PG8_SA(1, 0), a3, voffA);
            PG8_BAR; PG8_WAIT_L(0); PG8_MMA(1, 0, At, B0); PG8_BAR; PG8_SCHED;
            PG8_STAGE(PG8_SB(1, 1), b3 + hstep, voffB);
            PG8_WAIT_V(6); PG8_BAR; PG8_MMA(1, 1, At, B1); PG8_BAR;
            }
        }
#if defined(PROBE_GEMM) && (PROBE_GEMM == 3)
        PG8_PACC(pk_);
#endif
#if defined(PROBE_GEMM) && (PROBE_GEMM == 4)
        PG8_PT(pk_);
#endif
        if constexpr (ALIGN_EPI) { if (wr == 0) PG8_BAR; }
#if defined(PROBE_GEMM) && (PROBE_GEMM == 4)
        PG8_PACC(pk_);
#endif
#if defined(PROBE_GEMM) && (PROBE_GEMM <= 2)
        unsigned long long pt0_ = 0; { volatile PG8_LAS unsigned* mm_ = (volatile PG8_LAS unsigned*)(lds + MISC_OFF); if (mm_[20] && tid == 0 && blockIdx.x == 0) pt0_ = __builtin_amdgcn_s_memrealtime(); }
#endif
        if constexpr (!Epi::AFTER_DRAIN) { E(acc, cur, wr, wc, fr, fq); S.done(cur); }
#if defined(PROBE_GEMM) && (PROBE_GEMM == 5)
        PG8_PT(pk_);
#endif
#if defined(PROBE_GEMM) && (PROBE_GEMM <= 2)
        { volatile PG8_LAS unsigned* mm_ = (volatile PG8_LAS unsigned*)(lds + MISC_OFF); if (mm_[20] && tid == 0 && blockIdx.x == 0) {
#if PROBE_GEMM == 2
            asm volatile("s_waitcnt vmcnt(0)" ::: "memory");
#endif
            const unsigned long long d_ = __builtin_amdgcn_s_memrealtime() - pt0_; unsigned long long a_ = ((unsigned long long)mm_[23] << 32) | mm_[22]; a_ += d_; mm_[22] = (unsigned)a_; mm_[23] = (unsigned)(a_ >> 32); } }
#endif
        if (!has_next) break;
        zz_ = 0.f; asm volatile("" : "+v"(zz_));
#pragma unroll
        for (int a = 0; a < 2; ++a)
#pragma unroll
            for (int b = 0; b < 2; ++b)
#pragma unroll
                for (int m = 0; m < 4; ++m)
#pragma unroll
                    for (int n = 0; n < 2; ++n) acc[a][b][m][n] = (f32x4){zz_, zz_, zz_, zz_};
        cur = nxt; cA = nA; cB = nB; ++ui;
        if constexpr (ALIGN_EPI) { if (wr == 1) PG8_BAR; }
    }
    PG8_WAIT_V(0);
    if constexpr (!ALIGN_EPI) { if (wr == 0) PG8_BAR; }
    PG8_BAR;
    if constexpr (Epi::AFTER_DRAIN) { E.fused(acc, cur, wr, wc, fr, fq, lds, wid, lane); S.done(cur); }
#undef PG8_SA
#undef PG8_SB
#undef PG8_STAGE
#undef PG8_LDA
#undef PG8_LDB
#undef PG8_MMA
#undef PG8_WAIT_V
#undef PG8_WAIT_L
#undef PG8_BAR
#undef PG8_SCHED
}

struct UnitG { int pm, pn, gi; };
template <class Epi, class Sched>
__device__ __forceinline__ void gemm_phase_mg(PG8_LAS unsigned char* lds, const Gemm g0, const Gemm g1, const Sched& S, const Epi& E, const int wv) {
    const int tid = opaque_tid(wv), wid = __builtin_amdgcn_readfirstlane(tid >> 6), lane = tid & 63, wr = wid >> 2, wc = wid & 3, fr = lane & 15, fq = lane >> 4;
    int K0_ = g0.K, K1_ = g1.K; asm volatile("" : "+s"(K0_), "+s"(K1_)); const int K0 = K0_, K1 = K1_;
    unsigned RA2[2], RB2[2], C2[2];
#pragma unroll
    for (int i = 0; i < 2; ++i) { int R, C; stage_rc(tid * 16 + i * 8192, R, C); const int Rb = Epi::PERM ? ((R & ~31) + perm32(R & 31)) : R; RA2[i] = (unsigned)R * 2u; RB2[i] = (unsigned)Rb * 2u; C2[i] = (unsigned)C * 2u; }
    const size_t kstep = (size_t)(BK * 2);
    const size_t hstep0 = (size_t)HALF * K0 * 2, hstep1 = (size_t)HALF * K1 * 2;
    const unsigned ldsw = (unsigned)wid * 1024u;
    const int aoff = lds_byte(wr * 64 + fr, fq * 8), boff = lds_byte(wc * 32 + fr, fq * 8);
#define PG8_SA(b, h) (((b) * 2 + (h)) * HTB)
#define PG8_SB(b, h) ((4 + (b) * 2 + (h)) * HTB)
#define PG8_STAGE(bufoff, gbase, R2, KK) do { _Pragma("unroll") for (int _i = 0; _i < 2; ++_i) \
        __builtin_amdgcn_global_load_lds((const unsigned*)((const char*)(gbase) + ((R2)[_i] * (unsigned)(KK) + C2[_i])), (PG8_LAS unsigned*)(lds + (bufoff) + ldsw + _i * 8192), 16, 0, 0); } while (0)
#define PG8_LDA(dst, b, h) do { _Pragma("unroll") for (int m = 0; m < 4; ++m) _Pragma("unroll") for (int k = 0; k < 2; ++k) dst[m][k] = *(const PG8_LAS bf16x8*)(lds + PG8_SA(b, h) + aoff + m * 2048 + k * 1024); } while (0)
#define PG8_LDB(dst, b, h) do { _Pragma("unroll") for (int n = 0; n < 2; ++n) _Pragma("unroll") for (int k = 0; k < 2; ++k) dst[n][k] = *(const PG8_LAS bf16x8*)(lds + PG8_SB(b, h) + boff + n * 2048 + k * 1024); } while (0)
#define PG8_MMA(ai, bj, At, Bt) do { __builtin_amdgcn_s_setprio(1); _Pragma("unroll") for (int m = 0; m < 4; ++m) _Pragma("unroll") for (int n = 0; n < 2; ++n) _Pragma("unroll") for (int k = 0; k < 2; ++k) \
        acc[ai][bj][m][n] = __builtin_amdgcn_mfma_f32_16x16x32_bf16(Bt[n][k], At[m][k], acc[ai][bj][m][n], 0, 0, 0); __builtin_amdgcn_s_setprio(0); } while (0)
#define PG8_WAIT_V(n) asm volatile("s_waitcnt vmcnt(" #n ")" ::: "memory")
#define PG8_WAIT_L(n) asm volatile("s_waitcnt lgkmcnt(" #n ")" ::: "memory")
#define PG8_BAR __builtin_amdgcn_s_barrier()
#define PG8_SCHED __builtin_amdgcn_sched_barrier(0)
#ifdef PROBE_GEMM
#define PG8_PON() ({ volatile PG8_LAS unsigned* mm_ = (volatile PG8_LAS unsigned*)(lds + MISC_OFF); (mm_[20] && tid == 0 && blockIdx.x == 0); })
#define PG8_PT(var) do { if (PG8_PON()) var = __builtin_amdgcn_s_memrealtime(); } while (0)
#define PG8_PACC(var) do { if (PG8_PON()) { volatile PG8_LAS unsigned* mm_ = (volatile PG8_LAS unsigned*)(lds + MISC_OFF); const unsigned long long d_ = __builtin_amdgcn_s_memrealtime() - var; \
        unsigned long long a_ = ((unsigned long long)mm_[23] << 32) | mm_[22]; a_ += d_; mm_[22] = (unsigned)a_; mm_[23] = (unsigned)(a_ >> 32); } } while (0)
    unsigned long long pk_ = 0;
#endif
    UnitG cur, nxt; int ui = 0;
    if (!S.next(0, cur)) return;
    f32x4 acc[2][2][4][2]; float zz_ = 0.f; asm volatile("" : "+v"(zz_));
#pragma unroll
    for (int a = 0; a < 2; ++a)
#pragma unroll
        for (int b = 0; b < 2; ++b)
#pragma unroll
            for (int m = 0; m < 4; ++m)
#pragma unroll
                for (int n = 0; n < 2; ++n) acc[a][b][m][n] = (f32x4){zz_, zz_, zz_, zz_};
    bf16x8 At[4][2], B0[2][2], B1[2][2];
    int gic = cur.gi; size_t hsc = gic ? hstep1 : hstep0; int Kc = gic ? K1 : K0; int ntc = Kc / BK;
    const char* cA = (const char*)(gic ? g1.A : g0.A) + (size_t)cur.pm * (2 * hsc); const char* cB = (const char*)(gic ? g1.Bt : g0.Bt) + (size_t)cur.pn * (2 * hsc);
    PG8_STAGE(PG8_SB(0, 0), cB, RB2, Kc); PG8_STAGE(PG8_SB(0, 1), cB + hsc, RB2, Kc); PG8_STAGE(PG8_SA(0, 0), cA, RA2, Kc); PG8_STAGE(PG8_SA(0, 1), cA + hsc, RA2, Kc);
    if (wr == 1) PG8_BAR;
    PG8_WAIT_V(2); PG8_BAR;
    PG8_STAGE(PG8_SB(1, 0), cB + kstep, RB2, Kc); PG8_STAGE(PG8_SA(1, 0), cA + kstep, RA2, Kc); PG8_STAGE(PG8_SB(1, 1), cB + hsc + kstep, RB2, Kc);
    PG8_WAIT_V(6); PG8_BAR;
    for (;;) {
        const bool has_next = S.next(ui + 1, nxt);
        const int gin = has_next ? nxt.gi : gic; const size_t hsn = gin ? hstep1 : hstep0; const int Kn = gin ? K1 : K0;
        const char* nA = has_next ? (const char*)(gin ? g1.A : g0.A) + (size_t)nxt.pm * (2 * hsn) : cA; const char* nB = has_next ? (const char*)(gin ? g1.Bt : g0.Bt) + (size_t)nxt.pn * (2 * hsn) : cB;
#if defined(PROBE_GEMM) && (PROBE_GEMM == 3)
        PG8_PT(pk_);
#endif
        for (int t = 0; t < ntc; t += 2) {
            const bool last = (t == ntc - 2);
            const char* a1 = cA + (size_t)(t + 1) * kstep;
            const char* a2 = last ? nA : cA + (size_t)(t + 2) * kstep; const char* b2 = last ? nB : cB + (size_t)(t + 2) * kstep;
            const char* a3 = a2 + kstep; const char* b3 = b2 + kstep;
            const size_t hs2 = last ? hsn : hsc; const int K2 = last ? Kn : Kc;
            PG8_LDB(B0, 0, 0); PG8_LDB(B1, 0, 1); PG8_SCHED; PG8_LDA(At, 0, 0); PG8_STAGE(PG8_SA(1, 1), a1 + hsc, RA2, Kc);
            PG8_WAIT_V(8); PG8_WAIT_L(0); PG8_BAR; PG8_MMA(0, 0, At, B0); PG8_MMA(0, 1, At, B1); PG8_BAR; PG8_SCHED;
            PG8_LDA(At, 0, 1); PG8_STAGE(PG8_SB(0, 0), b2, RB2, K2); PG8_STAGE(PG8_SB(0, 1), b2 + hs2, RB2, K2); PG8_STAGE(PG8_SA(0, 0), a2, RA2, K2);
            PG8_WAIT_V(8); PG8_WAIT_L(0); PG8_BAR; PG8_MMA(1, 0, At, B0); PG8_MMA(1, 1, At, B1); PG8_BAR; PG8_SCHED;
            PG8_LDB(B0, 1, 0); PG8_LDB(B1, 1, 1); PG8_SCHED; PG8_LDA(At, 1, 0); PG8_STAGE(PG8_SA(0, 1), a2 + hs2, RA2, K2);
            PG8_WAIT_V(8); PG8_WAIT_L(0); PG8_BAR; PG8_MMA(0, 0, At, B0); PG8_MMA(0, 1, At, B1); PG8_BAR; PG8_SCHED;
            PG8_LDA(At, 1, 1); PG8_STAGE(PG8_SB(1, 0), b3, RB2, K2); PG8_STAGE(PG8_SB(1, 1), b3 + hs2, RB2, K2); PG8_STAGE(PG8_SA(1, 0), a3, RA2, K2);
            PG8_WAIT_V(8); PG8_WAIT_L(0); PG8_BAR; PG8_MMA(1, 0, At, B0); PG8_MMA(1, 1, At, B1); PG8_BAR; PG8_SCHED;
        }
#if defined(PROBE_GEMM) && (PROBE_GEMM == 3)
        PG8_PACC(pk_);
#endif
        if (wr == 0) PG8_BAR;
#if defined(PROBE_GEMM) && (PROBE_GEMM == 1)
        PG8_PT(pk_);
#endif
        E(acc, cur, wr, wc, fr, fq);
#if defined(PROBE_GEMM) && (PROBE_GEMM == 1)
        PG8_PACC(pk_);
#endif
        if (!has_next) break;
        zz_ = 0.f; asm volatile("" : "+v"(zz_));
#pragma unroll
        for (int a = 0; a < 2; ++a)
#pragma unroll
            for (int b = 0; b < 2; ++b)
#pragma unroll
                for (int m = 0; m < 4; ++m)
#pragma unroll
                    for (int n = 0; n < 2; ++n) acc[a][b][m][n] = (f32x4){zz_, zz_, zz_, zz_};
        cur = nxt; cA = nA; cB = nB; ++ui; gic = gin; hsc = hsn; Kc = Kn; ntc = Kc / BK;
        if (wr == 1) PG8_BAR;
    }
    PG8_WAIT_V(0);
    PG8_BAR;
#undef PG8_SA
#undef PG8_SB
#undef PG8_STAGE
#undef PG8_LDA
#undef PG8_LDB
#undef PG8_MMA
#undef PG8_WAIT_V
#undef PG8_WAIT_L
#undef PG8_BAR
#undef PG8_SCHED
}
}
#define XB_TMO      128
#define XB_XCNT(j)  (256  + 64 * (j))
#define XB_XSUB(j)  (1280 + 64 * (j))
#define XB_XGEN(j)  (2304 + 64 * (j))
#define XB_TOP      3328
#define XB_TOPGEN   3392
#define XCD_BAR_WORDS 3456
#define XB_SPIN_CAP (1u << 18)

__device__ __forceinline__ unsigned xb_ld(unsigned* p)              { return __hip_atomic_load(p, __ATOMIC_RELAXED, __HIP_MEMORY_SCOPE_AGENT); }
__device__ __forceinline__ unsigned xb_add(unsigned* p, unsigned v) { return __hip_atomic_fetch_add(p, v, __ATOMIC_RELAXED, __HIP_MEMORY_SCOPE_AGENT); }
__device__ __forceinline__ unsigned xb_xcc_id() { return (unsigned)__builtin_amdgcn_s_getreg((3 << 11) | 20) & 0xFu; }
#define XB_SPIN(cond, bar) do { unsigned _sp = 0; while (cond) { __builtin_amdgcn_s_sleep(1); \
    if ((++_sp & 255u) == 0u) { if (xb_ld(&(bar)[XB_TMO])) break; if (_sp > XB_SPIN_CAP) { atomicAdd(&(bar)[XB_TMO], 1u); break; } } } } while (0)

struct XcdBarrier {
    unsigned* bar; unsigned x;
    volatile LAS unsigned* st;
    int wv;
};

__device__ __forceinline__ XcdBarrier xcd_barrier_post(unsigned* bar, volatile LAS unsigned* st) {
    XcdBarrier b; b.bar = bar; b.x = xb_xcc_id(); b.st = st;
    if (threadIdx.x == 0) (void)xb_add(&bar[XB_XCNT(b.x)], 1u);
    return b;
}
__device__ __forceinline__ void xcd_barrier_complete(unsigned* bar, unsigned x, unsigned& nloc, unsigned& nx) {
    const unsigned G = gridDim.x * gridDim.y * gridDim.z;
    unsigned sum, cnt, mine, sp = 0u;
    for (;;) {
        sum = 0u; cnt = 0u; mine = 0u;
#pragma unroll
        for (unsigned j = 0; j < 16; ++j) { const unsigned c = xb_ld(&bar[XB_XCNT(j)]); sum += c; cnt += (c > 0u) ? 1u : 0u; mine = (j == x) ? c : mine; }
        if (sum == G) break;
        __builtin_amdgcn_s_sleep(1);
        if ((++sp & 255u) == 0u) { if (xb_ld(&bar[XB_TMO])) break; if (sp > XB_SPIN_CAP) { atomicAdd(&bar[XB_TMO], 1u); break; } }
    }
    nloc = mine > 0u ? mine : 1u; nx = cnt > 0u ? cnt : 1u;
}

__device__ __forceinline__ void xcd_barrier(const XcdBarrier& b) {
    asm volatile("s_waitcnt vmcnt(0)" ::: "memory");
    __syncthreads();
    if (b.wv == 0 && __builtin_amdgcn_mbcnt_hi(~0u, __builtin_amdgcn_mbcnt_lo(~0u, 0u)) == 0u) {
        unsigned* bar = b.bar;
        __builtin_amdgcn_s_waitcnt(0);
        unsigned nloc = b.st[0], nx = b.st[1];
        if (nloc == 0u) { xcd_barrier_complete(bar, b.x, nloc, nx); b.st[0] = nloc; b.st[1] = nx; }
        const unsigned old = xb_add(&bar[XB_XSUB(b.x)], 1u);
        const unsigned gen = old / nloc;
        if (old + 1u == (gen + 1u) * nloc) {
            __builtin_amdgcn_fence(__ATOMIC_RELEASE, "agent");
            asm volatile("s_waitcnt vmcnt(0)" ::: "memory");
            const unsigned og = xb_add(&bar[XB_TOP], 1u);
            const unsigned tg = og / nx;
            if (og + 1u == (tg + 1u) * nx) xb_add(&bar[XB_TOPGEN], 1u);
            else XB_SPIN(xb_ld(&bar[XB_TOPGEN]) == tg, bar);
            __builtin_amdgcn_fence(__ATOMIC_ACQUIRE, "agent");
            xb_add(&bar[XB_XGEN(b.x)], 1u);
            asm volatile("s_waitcnt vmcnt(0)" ::: "memory");
        } else {
            XB_SPIN(xb_ld(&bar[XB_XGEN(b.x)]) == gen, bar);
            __builtin_amdgcn_fence(__ATOMIC_ACQUIRE, "agent");
            asm volatile("s_waitcnt vmcnt(0)" ::: "memory");
        }
    }
    __syncthreads();
}

__device__ __forceinline__ void xcd_arrive(const XcdBarrier& b, unsigned* bar2) {
    asm volatile("s_waitcnt vmcnt(0)" ::: "memory");
    __syncthreads();
    if (b.wv == 0 && __builtin_amdgcn_mbcnt_hi(~0u, __builtin_amdgcn_mbcnt_lo(~0u, 0u)) == 0u) {
        __builtin_amdgcn_s_waitcnt(0);
        const unsigned nloc = b.st[0], nx = b.st[1];
        const unsigned old = xb_add(&bar2[XB_XSUB(b.x)], 1u);
        const unsigned gen = old / nloc;
        if (old + 1u == (gen + 1u) * nloc) {
            __builtin_amdgcn_fence(__ATOMIC_RELEASE, "agent");
            asm volatile("s_waitcnt vmcnt(0)" ::: "memory");
            const unsigned og = xb_add(&bar2[XB_TOP], 1u);
            const unsigned tg = og / nx;
            if (og + 1u == (tg + 1u) * nx) xb_add(&bar2[XB_TOPGEN], 1u);
        }
    }
}
__device__ __forceinline__ void xcd_wait(const XcdBarrier& b, unsigned* bar2, unsigned k) {
    asm volatile("s_waitcnt vmcnt(0)" ::: "memory");
    __syncthreads();
    if (b.wv == 0 && __builtin_amdgcn_mbcnt_hi(~0u, __builtin_amdgcn_mbcnt_lo(~0u, 0u)) == 0u) {
        XB_SPIN(xb_ld(&bar2[XB_TOPGEN]) < k, b.bar);
        __builtin_amdgcn_fence(__ATOMIC_ACQUIRE, "agent");
        asm volatile("s_waitcnt vmcnt(0)" ::: "memory");
    }
    __syncthreads();
}
typedef short bf16x8 __attribute__((ext_vector_type(8)));
typedef float f32x4 __attribute__((ext_vector_type(4)));
typedef float f32x16 __attribute__((ext_vector_type(16)));
struct Frame {
    LAS unsigned char* lds;
    volatile LAS unsigned* MISC;
    int tid, lane, wave;
    int vcu, G;
    unsigned char* ws;
    const void* const* in_unused;
};
__device__ __forceinline__ float wave_sum(float v, int lane) {
#pragma unroll
    for (int o = 1; o < 64; o <<= 1) v += bperm(lane ^ o, v);
    return v;
}
template <int CTRL, int RM> __device__ __forceinline__ float dpp_keep(float old, float v) { return __int_as_float(__builtin_amdgcn_update_dpp(__float_as_int(old), __float_as_int(v), CTRL, RM, 0xf, false)); }
__device__ __forceinline__ float wave_incl_sum(float v, int) {
    v += dpp_keep<0x111, 0xf>(0.f, v); v += dpp_keep<0x112, 0xf>(0.f, v); v += dpp_keep<0x114, 0xf>(0.f, v); v += dpp_keep<0x118, 0xf>(0.f, v);
    v += dpp_keep<0x142, 0xa>(0.f, v); v += dpp_keep<0x143, 0xc>(0.f, v);
    return v;
}
__device__ __forceinline__ float wave_incl_max(float v, int) {
    v = fmaxf(v, dpp_keep<0x111, 0xf>(v, v)); v = fmaxf(v, dpp_keep<0x112, 0xf>(v, v)); v = fmaxf(v, dpp_keep<0x114, 0xf>(v, v)); v = fmaxf(v, dpp_keep<0x118, 0xf>(v, v));
    v = fmaxf(v, dpp_keep<0x142, 0xa>(v, v)); v = fmaxf(v, dpp_keep<0x143, 0xc>(v, v));
    return v;
}
__device__ __forceinline__ float quad_sum(float v) { v += dpp_keep<0xB1, 0xf>(v, v); v += dpp_keep<0x4E, 0xf>(v, v); return v; }
__device__ __forceinline__ float oct_sum(float v) { v = quad_sum(v); v += dpp_keep<0x141, 0xf>(v, v); return v; }
__device__ __forceinline__ float lane_bcast(float v, int src) { return __int_as_float(__builtin_amdgcn_readlane(__float_as_int(v), src)); }
__device__ __forceinline__ float wave_max(float v, int lane) { return lane_bcast(wave_incl_max(v, lane), 63); }
__device__ __forceinline__ float logsigmoidf_(float x) { return fminf(x, 0.f) - log1pf(__expf(-fabsf(x))); }
__device__ __forceinline__ int crow32(int r, int hi) { return (r & 3) + 8 * (r >> 2) + 4 * hi; }
__device__ __forceinline__ void unpack8(const v4u w, float (&f)[8]) {
    f[0] = bflo(w.x); f[1] = bfhi(w.x); f[2] = bflo(w.y); f[3] = bfhi(w.y); f[4] = bflo(w.z); f[5] = bfhi(w.z); f[6] = bflo(w.w); f[7] = bfhi(w.w);
}
__device__ __forceinline__ v4u pack8(const float (&f)[8]) { v4u w; w.x = pk2(f[0], f[1]); w.y = pk2(f[2], f[3]); w.z = pk2(f[4], f[5]); w.w = pk2(f[6], f[7]); return w; }

__device__ __forceinline__ f32x16 mma_tile(const LAS bf16* A, int lda, const LAS bf16* Bt, int ldb, int K, int lane) {
    const int r = lane & 31, hh = lane >> 5; f32x16 acc = {};
    const LAS bf16* ap = A + r * lda + 8 * hh; const LAS bf16* bp = Bt + r * ldb + 8 * hh;
    for (int k0 = 0; k0 < K; k0 += 16) {
        const bf16x8 a = *(const LAS bf16x8*)(ap + k0), b = *(const LAS bf16x8*)(bp + k0);
        acc = __builtin_amdgcn_mfma_f32_32x32x16_bf16(a, b, acc, 0, 0, 0);
    }
    return acc;
}

__device__ __forceinline__ int cvt_dst_row(int mode, int row0, int n) {
    if (mode == 0) return row0 + n;
    if (mode == 1) return row0 + 2 * n;
    if (mode == 2) return row0 + (n & ~63) + 2 * (n & 31) + ((n >> 5) & 1);
    if (mode == 4) return row0 + ((n >> 7) << 8) + (n & 127);
    const int blk = n / 192, p = n - blk * 192;
    return row0 + blk * 192 + (p < 128 ? p : 128 + 2 * ((p - 128) & 31) + ((p - 128) >> 5));
}
struct CvtJob { const float* W; int ldw, K, src_col0, ncols; bf16* WT; int ldd, row0, mode; const float* gain; };
__device__ __forceinline__ void cvt_item(const CvtJob& J, LAS float* scr, int item, int lane) {
    const int nblk = J.ncols / 32, kb = item / nblk, nb = item - kb * nblk, k0 = 64 * kb, n0 = 32 * nb;
    const float* src = J.W + (size_t)(k0 + (lane >> 5)) * J.ldw + J.src_col0 + n0 + (lane & 31);
    float v[32];
#pragma unroll
    for (int i = 0; i < 32; ++i) v[i] = src[(size_t)(2 * i) * J.ldw];
    const int c = lane & 7;
    f32x4 g0 = {1.f, 1.f, 1.f, 1.f}, g1 = {1.f, 1.f, 1.f, 1.f};
    if (J.gain) { g0 = *(const f32x4*)(J.gain + k0 + 8 * c); g1 = *(const f32x4*)(J.gain + k0 + 8 * c + 4); }
#pragma unroll
    for (int i = 0; i < 32; ++i) scr[(2 * i + (lane >> 5)) * 33 + (lane & 31)] = v[i];
    LDS_WAIT(); asm volatile("" ::: "memory");
#pragma unroll
    for (int j = 0; j < 4; ++j) { const int n = (lane >> 3) + 8 * j; const LAS float* s = scr + (8 * c) * 33 + n;
        v4u o; o.x = pk2(s[0 * 33] * g0[0], s[1 * 33] * g0[1]); o.y = pk2(s[2 * 33] * g0[2], s[3 * 33] * g0[3]); o.z = pk2(s[4 * 33] * g1[0], s[5 * 33] * g1[1]); o.w = pk2(s[6 * 33] * g1[2], s[7 * 33] * g1[3]);
        *(GAS v4u*)(J.WT + (size_t)cvt_dst_row(J.mode, J.row0, n0 + n) * J.ldd + k0 + 8 * c) = o; }
    LDS_WAIT(); asm volatile("" ::: "memory");
}
__device__ __forceinline__ void cvt_job(Frame& F, const CvtJob& J, int& base) {
    LAS float* scr = (LAS float*)(F.lds + F.wave * 16384);
    const int gw = F.vcu * 8 + F.wave, NGW = F.G * 8, nitems = (J.K / 64) * (J.ncols / 32);
    int first = (gw - base) % NGW; if (first < 0) first += NGW;
    for (int it = first; it < nitems; it += NGW) cvt_item(J, scr, it, F.lane);
    base += nitems;
}

namespace att {
#ifdef PROBE_ATT
__device__ unsigned long long* att_probe_acc;
#endif
using bf16x8 = __attribute__((ext_vector_type(8))) short;
using s16x4  = __attribute__((ext_vector_type(4))) short;
using f32x16 = __attribute__((ext_vector_type(16))) float;
using u32x4  = __attribute__((ext_vector_type(4))) unsigned;
constexpr int NW = 8, QBLK = 32, KVBLK = 64;
constexpr float SCALE = 0.07216878364870322f;
constexpr float THR = 8.f;
constexpr int LDQ = 768, LDKN = 512, LDKR = 64, LDV = 512, LDO = 1280;
constexpr int SHM_V = KVBLK * 128 * 2, SHM_KN = KVBLK * 128 * 2, SHM_KR = KVBLK * 64 * 2;
constexpr int OFF_V = 0, OFF_KN = 2 * SHM_V, OFF_KR = OFF_KN + 2 * SHM_KN, OFF_WS = OFF_KR + 2 * SHM_KR, OFF_QR = OFF_WS + NW * 64 * 4, NQR = ATT_NQR, QR_PITCH = (12 - NQR) * 32 + 16, QR_WAVE = 32 * QR_PITCH, SHM_ATTN = OFF_QR + NW * QR_WAVE;
#define KSWZ(row, colB) ((row) * 256 + ((colB) ^ ((((row) & 7) | ((((row) >> 4) & 1) << 3)) << 4)))
#define KRSWZ(row, colB) ((row) * 128 + ((colB) ^ ((((row) >> 1) & 7) << 4)))
#define SBAR() __builtin_amdgcn_sched_barrier(0)
__device__ __forceinline__ int crow(int r, int hi) { return (r & 3) + 8 * (r >> 2) + 4 * hi; }
__device__ __forceinline__ unsigned cvtpk(float lo, float hi) { unsigned r; asm volatile("v_cvt_pk_bf16_f32 %0, %1, %2" : "=v"(r) : "v"(lo), "v"(hi)); return r; }

__device__ __forceinline__ void partialSM(f32x16& p0, f32x16& p1, float& m_reg, float& mn, float& alpha) {
#ifdef ATT_X_NOVALU
  mn = m_reg; alpha = 1.f; return;
#endif
  constexpr float C = SCALE * 1.4426950408889634f;
  float pmax = p0[0];
#pragma unroll
  for (int r = 1; r < 16; ++r) pmax = fmaxf(pmax, p0[r]);
#pragma unroll
  for (int r = 0; r < 16; ++r) pmax = fmaxf(pmax, p1[r]);
  { auto rr = __builtin_amdgcn_permlane32_swap(__float_as_uint(pmax), __float_as_uint(pmax), false, false);
    pmax = fmaxf(__uint_as_float(rr[0]), __uint_as_float(rr[1])); }
  if (__builtin_expect(__all(pmax - m_reg <= THR / SCALE), 1)) { mn = m_reg; alpha = 1.f; }
  else { mn = fmaxf(m_reg, pmax); alpha = __builtin_amdgcn_exp2f((m_reg - mn) * C); m_reg = mn; }
  float mnC = -mn * C;
#pragma unroll
  for (int r = 0; r < 16; ++r) p0[r] = fmaf(p0[r], C, mnC);
#pragma unroll
  for (int r = 0; r < 16; ++r) p1[r] = fmaf(p1[r], C, mnC);
#pragma unroll
  for (int r = 0; r < 16; ++r) p0[r] = __builtin_amdgcn_exp2f(p0[r]);
}
__device__ __forceinline__ void finishSM(f32x16& p0, f32x16& p1, float alpha, float& l_reg, bf16x8& pa0, bf16x8& pa1, bf16x8& pa2, bf16x8& pa3) {
#ifdef ATT_X_NOVALU
  { f32x4 t0 = {p0[0], p0[1], p0[2], p0[3]}, t1 = {p0[4], p0[5], p0[6], p0[7]}, t2 = {p1[0], p1[1], p1[2], p1[3]}, t3 = {p1[4], p1[5], p1[6], p1[7]};
    pa0 = __builtin_bit_cast(bf16x8, t0); pa1 = __builtin_bit_cast(bf16x8, t1); pa2 = __builtin_bit_cast(bf16x8, t2); pa3 = __builtin_bit_cast(bf16x8, t3); return; }
#endif
#pragma unroll
  for (int r = 0; r < 16; ++r) p1[r] = __builtin_amdgcn_exp2f(p1[r]);
  float ps = 0;
#pragma unroll
  for (int r = 0; r < 16; ++r) ps += p0[r];
#pragma unroll
  for (int r = 0; r < 16; ++r) ps += p1[r];
  { auto rr = __builtin_amdgcn_permlane32_swap(__float_as_uint(ps), __float_as_uint(ps), false, false);
    ps = __uint_as_float(rr[0]) + __uint_as_float(rr[1]); }
  l_reg = l_reg * alpha + ps;
#define PK4(P, BASE, OUT) do { unsigned a0 = cvtpk(P[BASE + 0], P[BASE + 1]), a1 = cvtpk(P[BASE + 2], P[BASE + 3]);   \
    unsigned b0 = cvtpk(P[BASE + 4], P[BASE + 5]), b1 = cvtpk(P[BASE + 6], P[BASE + 7]);                              \
    auto r0 = __builtin_amdgcn_permlane32_swap(a0, b0, false, false); auto r1 = __builtin_amdgcn_permlane32_swap(a1, b1, false, false); \
    u32x4 w = {r0[0], r1[0], r0[1], r1[1]}; OUT = *reinterpret_cast<bf16x8*>(&w); } while (0)
  PK4(p0, 0, pa0); PK4(p0, 8, pa1); PK4(p1, 0, pa2); PK4(p1, 8, pa3);
#undef PK4
}
#define QK_FENCE() __builtin_amdgcn_sched_barrier(0x2 | 0x4 | 0x400)
template <int D0> __device__ __forceinline__ void qk_frag(bf16x8& b0, bf16x8& b1, bf16x8& qv, const char* KNs, const char* KRs, const char* qrl, int r32, int hi) {
#ifdef ATT_X_NOLDSR
  { asm volatile("" : "=v"(b0), "=v"(b1), "=v"(qv)); return; }
#endif
  if constexpr (D0 < 8) { const int cb = (D0 * 16 + hi * 8) * 2;
    b0 = *reinterpret_cast<const bf16x8*>(KNs + KSWZ(r32, cb)); b1 = *reinterpret_cast<const bf16x8*>(KNs + KSWZ(32 + r32, cb));
  } else { const int cb = ((D0 - 8) * 16 + hi * 8) * 2;
    b0 = *reinterpret_cast<const bf16x8*>(KRs + KRSWZ(r32, cb)); b1 = *reinterpret_cast<const bf16x8*>(KRs + KRSWZ(32 + r32, cb)); }
  if constexpr (D0 >= NQR) qv = *reinterpret_cast<const bf16x8*>(qrl + (D0 - NQR) * 32);
}
template <int D0> __device__ __forceinline__ void qk_step(f32x16& p0, f32x16& p1, bf16x8 (&b0)[2], bf16x8 (&b1)[2], bf16x8 (&qv)[2], const char* KNs, const char* KRs, const bf16x8* qr, const char* qrl, int r32, int hi) {
  if constexpr (D0 + 1 < 12) qk_frag<D0 + 1>(b0[(D0 + 1) & 1], b1[(D0 + 1) & 1], qv[(D0 + 1) & 1], KNs, KRs, qrl, r32, hi);
  QK_FENCE();
  bf16x8 q; if constexpr (D0 < NQR) q = qr[D0]; else q = qv[D0 & 1];
  p0 = __builtin_amdgcn_mfma_f32_32x32x16_bf16(b0[D0 & 1], q, p0, 0, 0, 0);
  p1 = __builtin_amdgcn_mfma_f32_32x32x16_bf16(b1[D0 & 1], q, p1, 0, 0, 0);
  QK_FENCE();
}
#if ATT_QKPIPE
__device__ __forceinline__ void qkt(f32x16& p0, f32x16& p1, const char* KNs, const char* KRs, const bf16x8* qr, const char* qrl, int r32, int hi) {
  p0 = f32x16{}; p1 = f32x16{};
  bf16x8 b0[2], b1[2], qv[2];
  qk_frag<0>(b0[0], b1[0], qv[0], KNs, KRs, qrl, r32, hi);
  qk_step<0>(p0, p1, b0, b1, qv, KNs, KRs, qr, qrl, r32, hi); qk_step<1>(p0, p1, b0, b1, qv, KNs, KRs, qr, qrl, r32, hi);
  qk_step<2>(p0, p1, b0, b1, qv, KNs, KRs, qr, qrl, r32, hi); qk_step<3>(p0, p1, b0, b1, qv, KNs, KRs, qr, qrl, r32, hi);
  qk_step<4>(p0, p1, b0, b1, qv, KNs, KRs, qr, qrl, r32, hi); qk_step<5>(p0, p1, b0, b1, qv, KNs, KRs, qr, qrl, r32, hi);
  qk_step<6>(p0, p1, b0, b1, qv, KNs, KRs, qr, qrl, r32, hi); qk_step<7>(p0, p1, b0, b1, qv, KNs, KRs, qr, qrl, r32, hi);
  qk_step<8>(p0, p1, b0, b1, qv, KNs, KRs, qr, qrl, r32, hi); qk_step<9>(p0, p1, b0, b1, qv, KNs, KRs, qr, qrl, r32, hi);
  qk_step<10>(p0, p1, b0, b1, qv, KNs, KRs, qr, qrl, r32, hi); qk_step<11>(p0, p1, b0, b1, qv, KNs, KRs, qr, qrl, r32, hi);
}
#else
__device__ __forceinline__ void qkt(f32x16& p0, f32x16& p1, const char* KNs, const char* KRs, const bf16x8* qr, const char* qrl, int r32, int hi) {
  p0 = f32x16{}; p1 = f32x16{};
#pragma unroll
  for (int d0 = 0; d0 < 8; ++d0) { int cb = (d0 * 16 + hi * 8) * 2;
    bf16x8 b0 = *reinterpret_cast<const bf16x8*>(KNs + KSWZ(r32, cb));
    bf16x8 b1 = *reinterpret_cast<const bf16x8*>(KNs + KSWZ(32 + r32, cb));
    bf16x8 qv; if (d0 < NQR) qv = qr[d0]; else qv = *reinterpret_cast<const bf16x8*>(qrl + (d0 - NQR) * 32);
    p0 = __builtin_amdgcn_mfma_f32_32x32x16_bf16(b0, qv, p0, 0, 0, 0);
    p1 = __builtin_amdgcn_mfma_f32_32x32x16_bf16(b1, qv, p1, 0, 0, 0); }
#pragma unroll
  for (int d0 = 8; d0 < 12; ++d0) { int cb = ((d0 - 8) * 16 + hi * 8) * 2;
    bf16x8 b0 = *reinterpret_cast<const bf16x8*>(KRs + KRSWZ(r32, cb));
    bf16x8 b1 = *reinterpret_cast<const bf16x8*>(KRs + KRSWZ(32 + r32, cb));
    bf16x8 qv; if (d0 < NQR) qv = qr[d0]; else qv = *reinterpret_cast<const bf16x8*>(qrl + (d0 - NQR) * 32);
    p0 = __builtin_amdgcn_mfma_f32_32x32x16_bf16(b0, qv, p0, 0, 0, 0);
    p1 = __builtin_amdgcn_mfma_f32_32x32x16_bf16(b1, qv, p1, 0, 0, 0); }
}
#endif
__device__ __forceinline__ int v_st(int k, int c) { const int kk = (k & ~0xC) | ((k & 4) << 1) | ((k & 8) >> 1); return ((kk >> 3) * 4 + (c >> 5)) * 512 + ((kk & 7) * 32 + (c & 31)) * 2; }
__device__ __forceinline__ int v_rd_base(int lane) { return ((lane & 3) << 3) | (((lane >> 2) & 3) << 6) | (((lane >> 4) & 1) << 5) | (((lane >> 5) & 1) << 8); }
constexpr int v_rd_off(int d0, int ks, int half) { return d0 * 512 + ks * 4096 + half * 2048; }
template <int OFF> __device__ __forceinline__ s16x4 tr_read(int vb) {
  s16x4 r; asm volatile("ds_read_b64_tr_b16 %0, %1 offset:%2" : "=&v"(r) : "v"(vb), "i"(OFF) : "memory"); return r;
}
template <int D0> __device__ __forceinline__ void pv_one(f32x16& od, int vb, bf16x8 pa0, bf16x8 pa1, bf16x8 pa2, bf16x8 pa3) {
#ifdef ATT_X_NOLDSR
  { od = __builtin_amdgcn_mfma_f32_32x32x16_bf16(pa0, pa1, od, 0, 0, 0); od = __builtin_amdgcn_mfma_f32_32x32x16_bf16(pa1, pa2, od, 0, 0, 0); od = __builtin_amdgcn_mfma_f32_32x32x16_bf16(pa2, pa3, od, 0, 0, 0); od = __builtin_amdgcn_mfma_f32_32x32x16_bf16(pa3, pa0, od, 0, 0, 0); return; }
#endif
  const s16x4 l0 = tr_read<v_rd_off(D0, 0, 0)>(vb), h0 = tr_read<v_rd_off(D0, 0, 1)>(vb), l1 = tr_read<v_rd_off(D0, 1, 0)>(vb), h1 = tr_read<v_rd_off(D0, 1, 1)>(vb);
  const s16x4 l2 = tr_read<v_rd_off(D0, 2, 0)>(vb), h2 = tr_read<v_rd_off(D0, 2, 1)>(vb), l3 = tr_read<v_rd_off(D0, 3, 0)>(vb), h3 = tr_read<v_rd_off(D0, 3, 1)>(vb);
  asm volatile("s_waitcnt lgkmcnt(0)" ::: "memory"); SBAR();
#define PK(L, H) (bf16x8){L[0], L[1], L[2], L[3], H[0], H[1], H[2], H[3]}
  od = __builtin_amdgcn_mfma_f32_32x32x16_bf16(pa0, PK(l0, h0), od, 0, 0, 0);
  od = __builtin_amdgcn_mfma_f32_32x32x16_bf16(pa1, PK(l1, h1), od, 0, 0, 0);
  od = __builtin_amdgcn_mfma_f32_32x32x16_bf16(pa2, PK(l2, h2), od, 0, 0, 0);
  od = __builtin_amdgcn_mfma_f32_32x32x16_bf16(pa3, PK(l3, h3), od, 0, 0, 0);
#undef PK
}
__device__ __forceinline__ void pv_d0(f32x16* o, int vb, bf16x8 pa0, bf16x8 pa1, bf16x8 pa2, bf16x8 pa3) {
  pv_one<0>(o[0], vb, pa0, pa1, pa2, pa3); pv_one<1>(o[1], vb, pa0, pa1, pa2, pa3); pv_one<2>(o[2], vb, pa0, pa1, pa2, pa3); pv_one<3>(o[3], vb, pa0, pa1, pa2, pa3);
}

template <int SDEPTH>
__device__ __forceinline__ void attn_dense_body(const bf16* __restrict__ Qb, const bf16* __restrict__ KNh, const bf16* __restrict__ KRb, const bf16* __restrict__ Vh,
                                                bf16* __restrict__ Ob, int seq, char* lds, const int wv) {
  const int tid = opaque_tid(wv), wid = tid >> 6, lane = tid & 63, r32 = lane & 31, hi = lane >> 5;
  char* V_lds = lds + OFF_V; char* KN_lds = lds + OFF_KN; char* KR_lds = lds + OFF_KR;
  float* ws = (float*)(lds + OFF_WS) + wid * 64; float* li_l = ws; float* al_l = ws + 32;
  float m_reg = -1e30f, l_reg = 0; f32x16 o[4] = {}; bf16x8 qr[NQR];
  const bf16* Qw = Qb + (long)(wid * QBLK + r32) * LDQ + hi * 8;
#pragma unroll
  for (int d0 = 0; d0 < NQR; ++d0) qr[d0] = *reinterpret_cast<const bf16x8*>(Qw + d0 * 16);
  char* qrl = lds + OFF_QR + wid * QR_WAVE + r32 * QR_PITCH + hi * 16;
#pragma unroll
  for (int d0 = NQR; d0 < 12; ++d0) *reinterpret_cast<bf16x8*>(qrl + (d0 - NQR) * 32) = *reinterpret_cast<const bf16x8*>(Qw + d0 * 16);
  const int sr = tid >> 4, sc = (tid & 15) * 8, vst0 = v_st(sr, sc), vst1 = v_st(32 + sr, sc);
  const int rr_ = tid >> 3, rc = (tid & 7) * 8;
  const int vb0 = (int)(uintptr_t)V_lds + v_rd_base(lane);
  struct { bf16x8 vs0, vs1, ks0, ks1, kr; } sr_[SDEPTH];
#define SLOAD(i, k0) do { sr_[i].vs0 = *reinterpret_cast<const bf16x8*>(&Vh[(long)((k0) + sr) * LDV + sc]); sr_[i].vs1 = *reinterpret_cast<const bf16x8*>(&Vh[(long)((k0) + 32 + sr) * LDV + sc]); \
    sr_[i].ks0 = *reinterpret_cast<const bf16x8*>(&KNh[(long)((k0) + sr) * LDKN + sc]); sr_[i].ks1 = *reinterpret_cast<const bf16x8*>(&KNh[(long)((k0) + 32 + sr) * LDKN + sc]); \
    sr_[i].kr = *reinterpret_cast<const bf16x8*>(&KRb[(long)((k0) + rr_) * LDKR + rc]); } while (0)
#define SWRITE(b, i) do { *(bf16x8*)(V_lds + (b) * SHM_V + vst0) = sr_[i].vs0; *(bf16x8*)(V_lds + (b) * SHM_V + vst1) = sr_[i].vs1; int kc = sc * 2; \
    *(bf16x8*)(KN_lds + (b) * SHM_KN + KSWZ(sr, kc)) = sr_[i].ks0; *(bf16x8*)(KN_lds + (b) * SHM_KN + KSWZ(32 + sr, kc)) = sr_[i].ks1; \
    *(bf16x8*)(KR_lds + (b) * SHM_KR + KRSWZ(rr_, rc * 2)) = sr_[i].kr; } while (0)
#define SWAIT() do { if constexpr (SDEPTH == 2) asm volatile("s_waitcnt vmcnt(5)" ::: "memory"); else asm volatile("s_waitcnt vmcnt(0)" ::: "memory"); } while (0)
#define RESC(a) do { if (__any((a) < 1.f)) { if (hi == 0) al_l[r32] = (a); asm volatile("s_waitcnt lgkmcnt(0)" ::: "memory"); \
    _Pragma("unroll") for (int d = 0; d < 4; ++d) _Pragma("unroll") for (int r = 0; r < 16; ++r) o[d][r] *= al_l[crow(r, hi)]; } } while (0)
  f32x16 pA0, pA1, pB0, pB1; float mnA, mnB, alA, alB; bf16x8 pa0, pa1, pa2, pa3; const int NT = seq / KVBLK;
#if ATT_PRIO
  if (wv >= 4) __builtin_amdgcn_s_setprio(1);
#endif
#if ATT_V2
#if ATT_DMA
  unsigned offKN[2], offV[2], offKR;
#pragma unroll
  for (int i = 0; i < 2; ++i) { const int q = (wid * 2 + i) * 64 + lane; { const int row = q >> 4, slot = q & 15, f = (row & 7) | (((row >> 4) & 1) << 3); offKN[i] = (unsigned)(row * LDKN + ((slot ^ f) << 3)) * 2u; }
    { const int sub = q >> 5, kk = (sub >> 2) * 8 + ((q >> 2) & 7), cc = (sub & 3) * 32 + (q & 3) * 8, k = (kk & ~0xC) | ((kk & 4) << 1) | ((kk & 8) >> 1); offV[i] = (unsigned)(k * LDV + cc) * 2u; } }
  { const int q = wid * 64 + lane, row = q >> 3, slot = q & 7; offKR = (unsigned)(row * LDKR + ((slot ^ ((row >> 1) & 7)) << 3)) * 2u; }
  typedef __attribute__((address_space(3))) unsigned lds_u32;
#define DMA16(gp, ldsp) __builtin_amdgcn_global_load_lds((const unsigned*)(gp), (lds_u32*)(ldsp), 16, 0, 0)
#define SLOADK_TO(k0, b) do { const char* kb_ = (const char*)KNh + (size_t)(k0) * (LDKN * 2); const char* rb_ = (const char*)KRb + (size_t)(k0) * (LDKR * 2); \
    DMA16(kb_ + offKN[0], KN_lds + (b) * SHM_KN + (wid * 2 + 0) * 1024); DMA16(kb_ + offKN[1], KN_lds + (b) * SHM_KN + (wid * 2 + 1) * 1024); DMA16(rb_ + offKR, KR_lds + (b) * SHM_KR + wid * 1024); } while (0)
#define SLOADV_TO(k0, b) do { const char* vb_ = (const char*)Vh + (size_t)(k0) * (LDV * 2); \
    DMA16(vb_ + offV[0], V_lds + (b) * SHM_V + (wid * 2 + 0) * 1024); DMA16(vb_ + offV[1], V_lds + (b) * SHM_V + (wid * 2 + 1) * 1024); } while (0)
#define SLOADK(k0) do { } while (0)
#define SLOADV(k0) do { } while (0)
#define SWRITEK(b) do { } while (0)
#define SWRITEV(b) do { } while (0)
#else
#ifdef ATT_X_NOSTAGE
#define SLOADK_TO(k0, b) do { } while (0)
#define SLOADV_TO(k0, b) do { } while (0)
#else
#define SLOADK_TO(k0, b) SLOADK(k0)
#define SLOADV_TO(k0, b) SLOADV(k0)
#endif
#define SLOADK(k0) do { sr_[0].ks0 = *reinterpret_cast<const bf16x8*>(&KNh[(long)((k0) + sr) * LDKN + sc]); sr_[0].ks1 = *reinterpret_cast<const bf16x8*>(&KNh[(long)((k0) + 32 + sr) * LDKN + sc]); \
    sr_[0].kr = *reinterpret_cast<const bf16x8*>(&KRb[(long)((k0) + rr_) * LDKR + rc]); } while (0)
#define SLOADV(k0) do { sr_[0].vs0 = *reinterpret_cast<const bf16x8*>(&Vh[(long)((k0) + sr) * LDV + sc]); sr_[0].vs1 = *reinterpret_cast<const bf16x8*>(&Vh[(long)((k0) + 32 + sr) * LDV + sc]); } while (0)
#define SWRITEK(b) do { const int kc = sc * 2; *(bf16x8*)(KN_lds + (b) * SHM_KN + KSWZ(sr, kc)) = sr_[0].ks0; *(bf16x8*)(KN_lds + (b) * SHM_KN + KSWZ(32 + sr, kc)) = sr_[0].ks1; \
    *(bf16x8*)(KR_lds + (b) * SHM_KR + KRSWZ(rr_, rc * 2)) = sr_[0].kr; } while (0)
#define SWRITEV(b) do { *(bf16x8*)(V_lds + (b) * SHM_V + vst0) = sr_[0].vs0; *(bf16x8*)(V_lds + (b) * SHM_V + vst1) = sr_[0].vs1; } while (0)
#endif
#define VWAIT() asm volatile("s_waitcnt vmcnt(0)" ::: "memory")
#ifdef ATT_X_NOSTAGE
#undef SWRITEK
#undef SWRITEV
#define SWRITEK(b) do { } while (0)
#define SWRITEV(b) do { } while (0)
#endif
  SLOADK_TO(0, 0); VWAIT(); SWRITEK(0); __syncthreads();
  qkt(pA0, pA1, KN_lds, KR_lds, qr, qrl, r32, hi);
  SLOADK_TO(KVBLK, 1); SLOADV_TO(0, 0); SBAR();
  partialSM(pA0, pA1, m_reg, mnA, alA);
  VWAIT(); SWRITEK(1); SWRITEV(0);
  __syncthreads();
  for (int j = 1; j + 1 < NT; j += 2) {
#ifdef PROBE_ATT
    unsigned long long pt_[5]; const bool pw_ = (blockIdx.x == 0 && tid == 0);
#define PT_(i) do { if (pw_) pt_[i] = __builtin_amdgcn_s_memtime(); } while (0)
#else
#define PT_(i) do { } while (0)
#endif
    PT_(0);
    SBAR(); qkt(pB0, pB1, KN_lds + SHM_KN, KR_lds + SHM_KR, qr, qrl, r32, hi);
    finishSM(pA0, pA1, alA, l_reg, pa0, pa1, pa2, pa3); SBAR();
    PT_(1);
    SLOADK_TO((j + 1) * KVBLK, 0); SLOADV_TO(j * KVBLK, 1); SBAR();
    pv_d0(o, vb0, pa0, pa1, pa2, pa3); partialSM(pB0, pB1, m_reg, mnB, alB);
    PT_(2);
    VWAIT();
    PT_(3);
    SWRITEK(0); SWRITEV(1);
    RESC(alB);
#ifndef ATT_X_NOBAR
    __syncthreads();
#endif
    PT_(4);
#ifdef PROBE_ATT
    if (pw_) { volatile unsigned long long* acc_ = (volatile unsigned long long*)att_probe_acc; for (int q_ = 0; q_ < 4; ++q_) acc_[q_] += pt_[q_ + 1] - pt_[q_]; }
#endif
#undef PT_
    SBAR(); qkt(pA0, pA1, KN_lds, KR_lds, qr, qrl, r32, hi);
    finishSM(pB0, pB1, alB, l_reg, pa0, pa1, pa2, pa3); SBAR();
    SLOADK_TO((j + 2) * KVBLK, 1); SLOADV_TO((j + 1) * KVBLK, 0); SBAR();
    pv_d0(o, vb0 + SHM_V, pa0, pa1, pa2, pa3); partialSM(pA0, pA1, m_reg, mnA, alA);
    VWAIT(); SWRITEK(1); SWRITEV(0);
    RESC(alA);
#ifndef ATT_X_NOBAR
    __syncthreads();
#endif
  }
  SBAR(); qkt(pB0, pB1, KN_lds + SHM_KN, KR_lds + SHM_KR, qr, qrl, r32, hi);
  finishSM(pA0, pA1, alA, l_reg, pa0, pa1, pa2, pa3); SBAR();
  SLOADV_TO((NT - 1) * KVBLK, 1); SBAR();
  pv_d0(o, vb0, pa0, pa1, pa2, pa3); partialSM(pB0, pB1, m_reg, mnB, alB);
  VWAIT(); SWRITEV(1); RESC(alB); __syncthreads();
  finishSM(pB0, pB1, alB, l_reg, pa0, pa1, pa2, pa3); SBAR();
  pv_d0(o, vb0 + SHM_V, pa0, pa1, pa2, pa3);
#undef SLOADK
#undef SLOADV
#undef SWRITEK
#undef SWRITEV
#undef VWAIT
#undef SLOADK_TO
#undef SLOADV_TO
#else
  constexpr int SE = 0, SO = SDEPTH - 1;
  SLOAD(SE, 0); asm volatile("s_waitcnt vmcnt(0)" ::: "memory"); SWRITE(0, SE); __syncthreads();
  qkt(pA0, pA1, KN_lds, KR_lds, qr, qrl, r32, hi); partialSM(pA0, pA1, m_reg, mnA, alA);
  SLOAD(SO, KVBLK); if constexpr (SDEPTH == 2) { if (2 < NT) SLOAD(SE, 2 * KVBLK); }
  SWAIT(); SWRITE(1, SO); __syncthreads();
  for (int j = 1; j + 1 < NT; j += 2) {
    SBAR(); qkt(pB0, pB1, KN_lds + SHM_KN, KR_lds + SHM_KR, qr, qrl, r32, hi);
    finishSM(pA0, pA1, alA, l_reg, pa0, pa1, pa2, pa3); SBAR();
    SLOAD(SO, (j + SDEPTH) * KVBLK); SBAR();
    pv_d0(o, vb0, pa0, pa1, pa2, pa3); partialSM(pB0, pB1, m_reg, mnB, alB);
    __syncthreads(); SWAIT(); SWRITE(0, SE);
    RESC(alB); __syncthreads();
    SBAR(); qkt(pA0, pA1, KN_lds, KR_lds, qr, qrl, r32, hi);
    finishSM(pB0, pB1, alB, l_reg, pa0, pa1, pa2, pa3); SBAR();
    if (SDEPTH == 1 || j + 3 < NT) SLOAD(SE, (j + 1 + SDEPTH) * KVBLK); SBAR();
    pv_d0(o, vb0 + SHM_V, pa0, pa1, pa2, pa3); partialSM(pA0, pA1, m_reg, mnA, alA);
    __syncthreads(); SWAIT(); SWRITE(1, SO);
    RESC(alA); __syncthreads();
  }
  SBAR(); qkt(pB0, pB1, KN_lds + SHM_KN, KR_lds + SHM_KR, qr, qrl, r32, hi);
  finishSM(pA0, pA1, alA, l_reg, pa0, pa1, pa2, pa3); SBAR();
  pv_d0(o, vb0, pa0, pa1, pa2, pa3); partialSM(pB0, pB1, m_reg, mnB, alB);
  __syncthreads(); RESC(alB);
  finishSM(pB0, pB1, alB, l_reg, pa0, pa1, pa2, pa3); SBAR();
  pv_d0(o, vb0 + SHM_V, pa0, pa1, pa2, pa3);
#endif
#if ATT_PRIO
  __builtin_amdgcn_s_setprio(0);
#endif
  if (hi == 0) li_l[r32] = l_reg; asm volatile("s_waitcnt lgkmcnt(0)" ::: "memory");
  float rli[16];
#pragma unroll
  for (int r = 0; r < 16; ++r) rli[r] = __builtin_amdgcn_rcpf(li_l[crow(r, hi)]);
  bf16* Ow = Ob + (long)(wid * QBLK) * LDO;
  __syncthreads();
  { char* ost = lds + wid * (32 * 272);
#pragma unroll
    for (int r = 0; r < 16; ++r) { const int orow = crow(r, hi);
#pragma unroll
      for (int d0 = 0; d0 < 4; ++d0) *reinterpret_cast<bf16*>(ost + orow * 272 + (d0 * 32 + r32) * 2) = (bf16)f2bf(o[d0][r] * rli[r]); }
    asm volatile("s_waitcnt lgkmcnt(0)" ::: "memory");
#pragma unroll
    for (int i = 0; i < 8; ++i) { const int ch = i * 64 + lane, row = ch >> 4, c16 = ch & 15;
      const u32x4 v = *reinterpret_cast<const u32x4*>(ost + row * 272 + c16 * 16);
      *reinterpret_cast<u32x4*>(Ow + (long)row * LDO + c16 * 8) = v; }
  }
  __syncthreads();
#undef SLOAD
#undef SWRITE
#undef SWAIT
#undef RESC
}

#define PK4F(P, BASE, OUT) do { unsigned a0 = cvtpk(P[BASE + 0], P[BASE + 1]), a1 = cvtpk(P[BASE + 2], P[BASE + 3]);   \
    unsigned b0 = cvtpk(P[BASE + 4], P[BASE + 5]), b1 = cvtpk(P[BASE + 6], P[BASE + 7]);                              \
    auto r0 = __builtin_amdgcn_permlane32_swap(a0, b0, false, false); auto r1 = __builtin_amdgcn_permlane32_swap(a1, b1, false, false); \
    u32x4 w = {r0[0], r1[0], r0[1], r1[1]}; OUT = *reinterpret_cast<bf16x8*>(&w); } while (0)
template <int D0> __device__ __forceinline__ void fin_chunk(f32x16& q0, f32x16& q1, float alpha, float& l_reg, float& ps, bf16x8& pa0, bf16x8& pa1, bf16x8& pa2, bf16x8& pa3) {
  if constexpr (D0 < 8) { q1[2 * D0] = __builtin_amdgcn_exp2f(q1[2 * D0]); q1[2 * D0 + 1] = __builtin_amdgcn_exp2f(q1[2 * D0 + 1]); }
  if constexpr (D0 < 4) { ps += (q0[4 * D0] + q0[4 * D0 + 1]) + (q0[4 * D0 + 2] + q0[4 * D0 + 3]); }
  if constexpr (D0 == 4) PK4F(q0, 0, pa0);
  if constexpr (D0 == 5) PK4F(q0, 8, pa1);
  if constexpr (D0 == 8) { ps += ((q1[0] + q1[1]) + (q1[2] + q1[3])) + ((q1[4] + q1[5]) + (q1[6] + q1[7])); PK4F(q1, 0, pa2); }
  if constexpr (D0 == 9) { ps += ((q1[8] + q1[9]) + (q1[10] + q1[11])) + ((q1[12] + q1[13]) + (q1[14] + q1[15])); PK4F(q1, 8, pa3); }
  if constexpr (D0 == 10) { auto rr = __builtin_amdgcn_permlane32_swap(__float_as_uint(ps), __float_as_uint(ps), false, false);
    l_reg = l_reg * alpha + (__uint_as_float(rr[0]) + __uint_as_float(rr[1])); }
}
template <int D0> __device__ __forceinline__ void qk_step_f(f32x16& p0, f32x16& p1, bf16x8 (&b0)[2], bf16x8 (&b1)[2], bf16x8 (&qv)[2], const char* KNs, const char* KRs, const bf16x8* qr, const char* qrl, int r32, int hi,
                                                          f32x16& q0, f32x16& q1, float alpha, float& l_reg, float& ps, bf16x8& pa0, bf16x8& pa1, bf16x8& pa2, bf16x8& pa3) {
  if constexpr (D0 + 1 < 12) qk_frag<D0 + 1>(b0[(D0 + 1) & 1], b1[(D0 + 1) & 1], qv[(D0 + 1) & 1], KNs, KRs, qrl, r32, hi);
  SBAR();
  bf16x8 q; if constexpr (D0 < NQR) q = qr[D0]; else q = qv[D0 & 1];
  p0 = __builtin_amdgcn_mfma_f32_32x32x16_bf16(b0[D0 & 1], q, p0, 0, 0, 0);
  p1 = __builtin_amdgcn_mfma_f32_32x32x16_bf16(b1[D0 & 1], q, p1, 0, 0, 0);
  fin_chunk<D0>(q0, q1, alpha, l_reg, ps, pa0, pa1, pa2, pa3);
  if constexpr (D0 < 8) asm volatile("" : "+v"(q1), "+v"(ps)); else asm volatile("" : "+v"(ps), "+v"(l_reg));
  if constexpr (D0 == 4) asm volatile("" : "+v"(pa0)); if constexpr (D0 == 5) asm volatile("" : "+v"(pa1)); if constexpr (D0 == 8) asm volatile("" : "+v"(pa2)); if constexpr (D0 == 9) asm volatile("" : "+v"(pa3));
  SBAR();
}
__device__ __forceinline__ void qkt_fin(f32x16& p0, f32x16& p1, const char* KNs, const char* KRs, const bf16x8* qr, const char* qrl, int r32, int hi,
                                        f32x16& q0, f32x16& q1, float alpha, float& l_reg, bf16x8& pa0, bf16x8& pa1, bf16x8& pa2, bf16x8& pa3) {
  p0 = f32x16{}; p1 = f32x16{}; float ps = 0.f;
  bf16x8 b0[2], b1[2], qv[2];
  qk_frag<0>(b0[0], b1[0], qv[0], KNs, KRs, qrl, r32, hi);
#define QSF(D) qk_step_f<D>(p0, p1, b0, b1, qv, KNs, KRs, qr, qrl, r32, hi, q0, q1, alpha, l_reg, ps, pa0, pa1, pa2, pa3)
  QSF(0); QSF(1); QSF(2); QSF(3); QSF(4); QSF(5); QSF(6); QSF(7); QSF(8); QSF(9); QSF(10); QSF(11);
#undef QSF
}
__device__ __forceinline__ void pv_part(f32x16* o, int vb, bf16x8 pa0, bf16x8 pa1, bf16x8 pa2, bf16x8 pa3, f32x16& p0, f32x16& p1, float& m_reg, float& mn, float& alpha) {
  constexpr float C = SCALE * 1.4426950408889634f;
  pv_one<0>(o[0], vb, pa0, pa1, pa2, pa3);
  { float a = fmaxf(fmaxf(p0[0], p0[1]), p1[0]), b = fmaxf(fmaxf(p0[2], p0[3]), p1[1]); a = fmaxf(fmaxf(a, p1[2]), p1[3]);
#pragma unroll
    for (int r = 4; r < 16; r += 4) { a = fmaxf(fmaxf(a, p0[r]), p0[r + 1]); b = fmaxf(fmaxf(b, p0[r + 2]), p0[r + 3]); a = fmaxf(fmaxf(a, p1[r]), p1[r + 1]); b = fmaxf(fmaxf(b, p1[r + 2]), p1[r + 3]); }
    float pmax = fmaxf(a, b);
    { auto rr = __builtin_amdgcn_permlane32_swap(__float_as_uint(pmax), __float_as_uint(pmax), false, false); pmax = fmaxf(__uint_as_float(rr[0]), __uint_as_float(rr[1])); }
    if (__builtin_expect(__all(pmax - m_reg <= THR / SCALE), 1)) { mn = m_reg; alpha = 1.f; }
    else { mn = fmaxf(m_reg, pmax); alpha = __builtin_amdgcn_exp2f((m_reg - mn) * C); m_reg = mn; } }
  asm volatile("" : "+v"(mn), "+v"(alpha)); SBAR();
  pv_one<1>(o[1], vb, pa0, pa1, pa2, pa3);
  { const float mnC = -mn * C;
#pragma unroll
    for (int r = 0; r < 16; ++r) p0[r] = fmaf(p0[r], C, mnC);
#pragma unroll
    for (int r = 0; r < 16; ++r) p1[r] = fmaf(p1[r], C, mnC); }
  asm volatile("" : "+v"(p0), "+v"(p1)); SBAR();
  pv_one<2>(o[2], vb, pa0, pa1, pa2, pa3);
#pragma unroll
  for (int r = 0; r < 8; ++r) p0[r] = __builtin_amdgcn_exp2f(p0[r]);
  asm volatile("" : "+v"(p0)); SBAR();
  pv_one<3>(o[3], vb, pa0, pa1, pa2, pa3);
#pragma unroll
  for (int r = 8; r < 16; ++r) p0[r] = __builtin_amdgcn_exp2f(p0[r]);
  asm volatile("" : "+v"(p0)); SBAR();
}


__device__ __forceinline__ void softmax_tile(f32x16& p0, f32x16& p1, float& m_reg, float& l_reg, float& alpha, bf16x8& pa0, bf16x8& pa1, bf16x8& pa2, bf16x8& pa3) {
  constexpr float C = SCALE * 1.4426950408889634f;
  float a = fmaxf(fmaxf(p0[0], p0[1]), p1[0]), b = fmaxf(fmaxf(p0[2], p0[3]), p1[1]); a = fmaxf(fmaxf(a, p1[2]), p1[3]);
#pragma unroll
  for (int r = 4; r < 16; r += 4) { a = fmaxf(fmaxf(a, p0[r]), p0[r + 1]); b = fmaxf(fmaxf(b, p0[r + 2]), p0[r + 3]); a = fmaxf(fmaxf(a, p1[r]), p1[r + 1]); b = fmaxf(fmaxf(b, p1[r + 2]), p1[r + 3]); }
  float pmax = fmaxf(a, b);
  { auto rr = __builtin_amdgcn_permlane32_swap(__float_as_uint(pmax), __float_as_uint(pmax), false, false); pmax = fmaxf(__uint_as_float(rr[0]), __uint_as_float(rr[1])); }
  float mn;
  if (__builtin_expect(__all(pmax - m_reg <= THR / SCALE), 1)) { mn = m_reg; alpha = 1.f; }
  else { mn = fmaxf(m_reg, pmax); alpha = __builtin_amdgcn_exp2f((m_reg - mn) * C); m_reg = mn; }
  const float mnC = -mn * C;
#pragma unroll
  for (int r = 0; r < 16; ++r) { p0[r] = __builtin_amdgcn_exp2f(fmaf(p0[r], C, mnC)); p1[r] = __builtin_amdgcn_exp2f(fmaf(p1[r], C, mnC)); }
  float ps = 0.f, ps2 = 0.f;
#pragma unroll
  for (int r = 0; r < 16; ++r) { ps += p0[r]; ps2 += p1[r]; }
  ps += ps2;
  { auto rr = __builtin_amdgcn_permlane32_swap(__float_as_uint(ps), __float_as_uint(ps), false, false); ps = __uint_as_float(rr[0]) + __uint_as_float(rr[1]); }
  l_reg = l_reg * alpha + ps;
#define PK4V(P, BASE, OUT) do { unsigned a0 = cvtpk(P[BASE + 0], P[BASE + 1]), a1 = cvtpk(P[BASE + 2], P[BASE + 3]);   \
    unsigned b0 = cvtpk(P[BASE + 4], P[BASE + 5]), b1 = cvtpk(P[BASE + 6], P[BASE + 7]);                              \
    auto r0 = __builtin_amdgcn_permlane32_swap(a0, b0, false, false); auto r1 = __builtin_amdgcn_permlane32_swap(a1, b1, false, false); \
    u32x4 w = {r0[0], r1[0], r0[1], r1[1]}; OUT = *reinterpret_cast<bf16x8*>(&w); } while (0)
  PK4V(p0, 0, pa0); PK4V(p0, 8, pa1); PK4V(p1, 0, pa2); PK4V(p1, 8, pa3);
#undef PK4V
}
__device__ __forceinline__ void qkt12(f32x16& p0, f32x16& p1, const char* KNs, const char* KRs, const bf16x8* qr, const char* qrl, int r32, int hi) {
  p0 = f32x16{}; p1 = f32x16{};
#pragma unroll
  for (int d0 = 0; d0 < 8; ++d0) { const int cb = (d0 * 16 + hi * 8) * 2;
    const bf16x8 b0 = *reinterpret_cast<const bf16x8*>(KNs + KSWZ(r32, cb)), b1 = *reinterpret_cast<const bf16x8*>(KNs + KSWZ(32 + r32, cb));
    p0 = __builtin_amdgcn_mfma_f32_32x32x16_bf16(b0, qr[d0], p0, 0, 0, 0); p1 = __builtin_amdgcn_mfma_f32_32x32x16_bf16(b1, qr[d0], p1, 0, 0, 0); }
#pragma unroll
  for (int d0 = 0; d0 < 4; ++d0) { const int cb = (d0 * 16 + hi * 8) * 2;
    const bf16x8 b0 = *reinterpret_cast<const bf16x8*>(KRs + KRSWZ(r32, cb)), b1 = *reinterpret_cast<const bf16x8*>(KRs + KRSWZ(32 + r32, cb));
    const bf16x8 q = *reinterpret_cast<const bf16x8*>(qrl + d0 * 32);
    p0 = __builtin_amdgcn_mfma_f32_32x32x16_bf16(b0, q, p0, 0, 0, 0); p1 = __builtin_amdgcn_mfma_f32_32x32x16_bf16(b1, q, p1, 0, 0, 0); }
}
typedef __attribute__((address_space(3))) const char* lcp_t;
typedef short v4i16_t __attribute__((ext_vector_type(4)));
__device__ __forceinline__ s16x4 vtr3(lcp_t p) { return __builtin_bit_cast(s16x4, __builtin_amdgcn_ds_read_tr16_b64_v4i16((__attribute__((address_space(3))) v4i16_t*)p)); }
template <int G> __device__ __forceinline__ void kfrag3(bf16x8 (&kf)[3][2], lcp_t KNs, lcp_t KRs, int r32, int hi) {
#pragma unroll
  for (int s = 0; s < 3; ++s) { constexpr int dummy = 0; const int d0 = 3 * G + s;
    if (d0 < 8) { const int cb = (d0 * 16 + hi * 8) * 2; kf[s][0] = *(const __attribute__((address_space(3))) bf16x8*)(KNs + KSWZ(r32, cb)); kf[s][1] = *(const __attribute__((address_space(3))) bf16x8*)(KNs + KSWZ(32 + r32, cb)); }
    else { const int cb = ((d0 - 8) * 16 + hi * 8) * 2; kf[s][0] = *(const __attribute__((address_space(3))) bf16x8*)(KRs + KRSWZ(r32, cb)); kf[s][1] = *(const __attribute__((address_space(3))) bf16x8*)(KRs + KRSWZ(32 + r32, cb)); } }
}
template <int G> __device__ __forceinline__ void vfrag3(s16x4 (&vl)[4], s16x4 (&vh)[4], lcp_t vb) {
#pragma unroll
  for (int ks = 0; ks < 4; ++ks) { vl[ks] = vtr3(vb + v_rd_off(G, ks, 0)); vh[ks] = vtr3(vb + v_rd_off(G, ks, 1)); }
}
template <int G> __device__ __forceinline__ void mgroup3(f32x16& p0, f32x16& p1, f32x16& og, bf16x8 (&kf)[3][2], s16x4 (&vl)[4], s16x4 (&vh)[4], const bf16x8* qr, lcp_t qrl, lcp_t KNs, lcp_t KRs, lcp_t vb,
                                                         bf16x8 pa0, bf16x8 pa1, bf16x8 pa2, bf16x8 pa3, int r32, int hi) {
  vfrag3<G>(vl, vh, vb);
  bf16x8 qx[3];
#pragma unroll
  for (int s = 0; s < 3; ++s) if (3 * G + s >= 8) qx[s] = *(const __attribute__((address_space(3))) bf16x8*)(qrl + (3 * G + s - 8) * 32);
  SBAR();
#pragma unroll
  for (int s = 0; s < 3; ++s) { const bf16x8 q = (3 * G + s < 8) ? qr[(3 * G + s) & 7] : qx[s];
    p0 = __builtin_amdgcn_mfma_f32_32x32x16_bf16(kf[s][0], q, p0, 0, 0, 0); p1 = __builtin_amdgcn_mfma_f32_32x32x16_bf16(kf[s][1], q, p1, 0, 0, 0); }
  SBAR();
  if constexpr (G < 3) { kfrag3<G + 1>(kf, KNs, KRs, r32, hi); SBAR(); }
#define PKV(L, H) (bf16x8){L[0], L[1], L[2], L[3], H[0], H[1], H[2], H[3]}
  og = __builtin_amdgcn_mfma_f32_32x32x16_bf16(pa0, PKV(vl[0], vh[0]), og, 0, 0, 0);
  og = __builtin_amdgcn_mfma_f32_32x32x16_bf16(pa1, PKV(vl[1], vh[1]), og, 0, 0, 0);
  og = __builtin_amdgcn_mfma_f32_32x32x16_bf16(pa2, PKV(vl[2], vh[2]), og, 0, 0, 0);
  og = __builtin_amdgcn_mfma_f32_32x32x16_bf16(pa3, PKV(vl[3], vh[3]), og, 0, 0, 0);
#undef PKV
  SBAR();
}
__device__ __forceinline__ void mseg3(f32x16& p0, f32x16& p1, f32x16* o, const bf16x8* qr, lcp_t qrl, lcp_t KNs, lcp_t KRs, lcp_t vb, bf16x8 pa0, bf16x8 pa1, bf16x8 pa2, bf16x8 pa3, int r32, int hi) {
  p0 = f32x16{}; p1 = f32x16{};
  bf16x8 kf[3][2]; s16x4 vl[4], vh[4];
  kfrag3<0>(kf, KNs, KRs, r32, hi); SBAR();
  mgroup3<0>(p0, p1, o[0], kf, vl, vh, qr, qrl, KNs, KRs, vb, pa0, pa1, pa2, pa3, r32, hi);
  mgroup3<1>(p0, p1, o[1], kf, vl, vh, qr, qrl, KNs, KRs, vb, pa0, pa1, pa2, pa3, r32, hi);
  mgroup3<2>(p0, p1, o[2], kf, vl, vh, qr, qrl, KNs, KRs, vb, pa0, pa1, pa2, pa3, r32, hi);
  mgroup3<3>(p0, p1, o[3], kf, vl, vh, qr, qrl, KNs, KRs, vb, pa0, pa1, pa2, pa3, r32, hi);
}
__device__ __forceinline__ void attn_dense_body_v3(const bf16* __restrict__ Qb, const bf16* __restrict__ KNh, const bf16* __restrict__ KRb, const bf16* __restrict__ Vh,
                                                   bf16* __restrict__ Ob, int seq, char* lds, const int wv) {
  const int tid = opaque_tid(wv), wid = tid >> 6, lane = tid & 63, r32 = lane & 31, hi = lane >> 5; const int half = wv >> 2;
  char* V_lds = lds + OFF_V; char* KN_lds = lds + OFF_KN; char* KR_lds = lds + OFF_KR;
  float* ws = (float*)(lds + OFF_WS) + wid * 64; float* li_l = ws; float* al_l = ws + 32;
  float m_reg = -1e30f, l_reg = 0.f, alpha = 1.f; f32x16 o[4] = {}; bf16x8 qr[8];
  const bf16* Qw = Qb + (long)(wid * QBLK + r32) * LDQ + hi * 8;
#pragma unroll
  for (int d0 = 0; d0 < 8; ++d0) qr[d0] = *reinterpret_cast<const bf16x8*>(Qw + d0 * 16);
  char* qrl = lds + OFF_QR + wid * (32 * 144) + r32 * 144 + hi * 16;
#pragma unroll
  for (int d0 = 0; d0 < 4; ++d0) *reinterpret_cast<bf16x8*>(qrl + d0 * 32) = *reinterpret_cast<const bf16x8*>(Qw + (8 + d0) * 16);
  const int sr = tid >> 4, sc = (tid & 15) * 8, vst0 = v_st(sr, sc), vst1 = v_st(32 + sr, sc);
  const int rr_ = tid >> 3, rc = (tid & 7) * 8;
  const int vb0 = (int)(uintptr_t)V_lds + v_rd_base(lane);
  bf16x8 s_vs0, s_vs1, s_ks0, s_ks1, s_kr;
#define LDK3(k0) do { s_ks0 = *reinterpret_cast<const bf16x8*>(&KNh[(long)((k0) + sr) * LDKN + sc]); s_ks1 = *reinterpret_cast<const bf16x8*>(&KNh[(long)((k0) + 32 + sr) * LDKN + sc]); \
    s_kr = *reinterpret_cast<const bf16x8*>(&KRb[(long)((k0) + rr_) * LDKR + rc]); } while (0)
#define LDV3(k0) do { s_vs0 = *reinterpret_cast<const bf16x8*>(&Vh[(long)((k0) + sr) * LDV + sc]); s_vs1 = *reinterpret_cast<const bf16x8*>(&Vh[(long)((k0) + 32 + sr) * LDV + sc]); } while (0)
#define STK3(b) do { const int kc = sc * 2; *(bf16x8*)(KN_lds + (b) * SHM_KN + KSWZ(sr, kc)) = s_ks0; *(bf16x8*)(KN_lds + (b) * SHM_KN + KSWZ(32 + sr, kc)) = s_ks1; \
    *(bf16x8*)(KR_lds + (b) * SHM_KR + KRSWZ(rr_, rc * 2)) = s_kr; } while (0)
#define STV3(b) do { *(bf16x8*)(V_lds + (b) * SHM_V + vst0) = s_vs0; *(bf16x8*)(V_lds + (b) * SHM_V + vst1) = s_vs1; } while (0)
#define BAR3() do { asm volatile("s_waitcnt lgkmcnt(0)" ::: "memory"); __builtin_amdgcn_s_barrier(); asm volatile("" ::: "memory"); } while (0)
#define VW3() asm volatile("s_waitcnt vmcnt(0)" ::: "memory")
#define RESC3(a) do { if (__any((a) < 1.f)) { if (hi == 0) al_l[r32] = (a); asm volatile("s_waitcnt lgkmcnt(0)" ::: "memory"); \
    _Pragma("unroll") for (int d = 0; d < 4; ++d) _Pragma("unroll") for (int r = 0; r < 16; ++r) o[d][r] *= al_l[crow(r, hi)]; } } while (0)
  f32x16 p0, p1; bf16x8 pa0, pa1, pa2, pa3; const int NT = seq / KVBLK;
  LDK3(0); VW3(); STK3(0); BAR3();
  if (half) { LDK3(KVBLK); LDV3(0); VW3(); STK3(1); STV3(0); BAR3(); }
  for (int t = 0; t < NT; ++t) {
    const int kt = t + 1 + half, vt = t + half;
    { int r32_ = r32, hi_ = hi, ln_ = lane; asm volatile("" : "+v"(r32_), "+v"(hi_), "+v"(ln_));
      if (t == 0) qkt12(p0, p1, KN_lds, KR_lds, qr, qrl, r32_, hi_);
      else mseg3(p0, p1, o, qr, (lcp_t)qrl, (lcp_t)(KN_lds + (t & 1) * SHM_KN), (lcp_t)(KR_lds + (t & 1) * SHM_KR), (lcp_t)(V_lds + ((t - 1) & 1) * SHM_V) + v_rd_base(ln_), pa0, pa1, pa2, pa3, r32_, hi_); }
    SBAR();
    if (kt < NT) LDK3(kt * KVBLK);
    if (vt < NT) LDV3(vt * KVBLK);
    BAR3();
    softmax_tile(p0, p1, m_reg, l_reg, alpha, pa0, pa1, pa2, pa3);
    RESC3(alpha);
    VW3();
    if (kt < NT) STK3(kt & 1);
    if (vt < NT) STV3(vt & 1);
    BAR3();
  }
  pv_d0(o, vb0 + ((NT - 1) & 1) * SHM_V, pa0, pa1, pa2, pa3);
  BAR3();
  if (!half) BAR3();
  if (hi == 0) li_l[r32] = l_reg; asm volatile("s_waitcnt lgkmcnt(0)" ::: "memory");
  float rli[16];
#pragma unroll
  for (int r = 0; r < 16; ++r) rli[r] = __builtin_amdgcn_rcpf(li_l[crow(r, hi)]);
  bf16* Ow = Ob + (long)(wid * QBLK) * LDO;
  __syncthreads();
  { char* ost = lds + wid * (32 * 272);
#pragma unroll
    for (int r = 0; r < 16; ++r) { const int orow = crow(r, hi);
#pragma unroll
      for (int d0 = 0; d0 < 4; ++d0) *reinterpret_cast<bf16*>(ost + orow * 272 + (d0 * 32 + r32) * 2) = (bf16)f2bf(o[d0][r] * rli[r]); }
    asm volatile("s_waitcnt lgkmcnt(0)" ::: "memory");
#pragma unroll
    for (int i = 0; i < 8; ++i) { const int ch = i * 64 + lane, row = ch >> 4, c16 = ch & 15;
      const u32x4 v = *reinterpret_cast<const u32x4*>(ost + row * 272 + c16 * 16);
      *reinterpret_cast<u32x4*>(Ow + (long)row * LDO + c16 * 8) = v; }
  }
  __syncthreads();
#undef LDK3
#undef LDV3
#undef STK3
#undef STV3
#undef BAR3
#undef VW3
#undef RESC3
}

__device__ __forceinline__ void attn_dense_body_v4(const bf16* __restrict__ Qb, const bf16* __restrict__ KNh, const bf16* __restrict__ KRb, const bf16* __restrict__ Vh,
                                                   bf16* __restrict__ Ob, int seq, char* lds, const int wv) {
  const int tid = opaque_tid(wv), wid = tid >> 6, lane = tid & 63, r32 = lane & 31, hi = lane >> 5;
  char* V_lds = lds + OFF_V; char* KN_lds = lds + OFF_KN; char* KR_lds = lds + OFF_KR;
  const int NT = seq / KVBLK;
#define BAR4() do { asm volatile("s_waitcnt lgkmcnt(0)" ::: "memory"); __builtin_amdgcn_s_barrier(); asm volatile("" ::: "memory"); } while (0)
  if (wv >= 4) {
    const int lt = tid - 256;
    unsigned gKN[4], gV[4], gKR[2]; int dKN[4], dV[4], dKR[2];
#pragma unroll
    for (int i = 0; i < 4; ++i) { const int cidx = lt + 256 * i, row = cidx >> 4, ch = cidx & 15;
      gKN[i] = (unsigned)(row * LDKN + ch * 8) * 2u; dKN[i] = KSWZ(row, ch * 16); gV[i] = (unsigned)(row * LDV + ch * 8) * 2u; dV[i] = v_st(row, ch * 8); }
#pragma unroll
    for (int i = 0; i < 2; ++i) { const int cidx = lt + 256 * i, row = cidx >> 3, ch = cidx & 7; gKR[i] = (unsigned)(row * LDKR + ch * 8) * 2u; dKR[i] = KRSWZ(row, ch * 16); }
    bf16x8 sK[4], sV[4], sR[2];
#define L4K(t) do { const char* kb_ = (const char*)KNh + (size_t)(t) * (KVBLK * LDKN * 2); const char* rb_ = (const char*)KRb + (size_t)(t) * (KVBLK * LDKR * 2); \
    _Pragma("unroll") for (int i = 0; i < 4; ++i) sK[i] = *reinterpret_cast<const bf16x8*>(kb_ + gKN[i]); _Pragma("unroll") for (int i = 0; i < 2; ++i) sR[i] = *reinterpret_cast<const bf16x8*>(rb_ + gKR[i]); } while (0)
#define L4V(t) do { const char* vb_ = (const char*)Vh + (size_t)(t) * (KVBLK * LDV * 2); _Pragma("unroll") for (int i = 0; i < 4; ++i) sV[i] = *reinterpret_cast<const bf16x8*>(vb_ + gV[i]); } while (0)
#define W4K(b) do { _Pragma("unroll") for (int i = 0; i < 4; ++i) *reinterpret_cast<bf16x8*>(KN_lds + (b) * SHM_KN + dKN[i]) = sK[i]; _Pragma("unroll") for (int i = 0; i < 2; ++i) *reinterpret_cast<bf16x8*>(KR_lds + (b) * SHM_KR + dKR[i]) = sR[i]; } while (0)
#define W4V(b) do { _Pragma("unroll") for (int i = 0; i < 4; ++i) *reinterpret_cast<bf16x8*>(V_lds + (b) * SHM_V + dV[i]) = sV[i]; } while (0)
#define VW4() asm volatile("s_waitcnt vmcnt(0)" ::: "memory")
    L4K(0); VW4(); W4K(0); L4K(1); L4V(0);
    BAR4();
    for (int j = 0; j < NT; ++j) {
      VW4();
      if (j + 1 < NT) W4K((j + 1) & 1);
      W4V(j & 1);
      if (j + 2 < NT) L4K(j + 2);
      if (j + 1 < NT) L4V(j + 1);
      BAR4();
    }
#undef L4K
#undef L4V
#undef W4K
#undef W4V
#undef VW4
  } else {
    float* ws = (float*)(lds + OFF_WS) + wid * 64; float* li_l = ws; float* al_l = ws + 32;
    float m_reg = -1e30f, l_reg = 0; f32x16 o[4] = {}; bf16x8 qr[NQR];
    const bf16* Qw = Qb + (long)(wid * QBLK + r32) * LDQ + hi * 8;
#pragma unroll
    for (int d0 = 0; d0 < NQR; ++d0) qr[d0] = *reinterpret_cast<const bf16x8*>(Qw + d0 * 16);
    char* qrl = lds + OFF_QR + wid * QR_WAVE + r32 * QR_PITCH + hi * 16;
#pragma unroll
    for (int d0 = NQR; d0 < 12; ++d0) *reinterpret_cast<bf16x8*>(qrl + (d0 - NQR) * 32) = *reinterpret_cast<const bf16x8*>(Qw + d0 * 16);
    const int vb0 = (int)(uintptr_t)V_lds + v_rd_base(lane);
#define RESC4(a) do { if (__any((a) < 1.f)) { if (hi == 0) al_l[r32] = (a); asm volatile("s_waitcnt lgkmcnt(0)" ::: "memory"); \
    _Pragma("unroll") for (int d = 0; d < 4; ++d) _Pragma("unroll") for (int r = 0; r < 16; ++r) o[d][r] *= al_l[crow(r, hi)]; } } while (0)
    f32x16 pA0, pA1, pB0, pB1; float mnA, mnB, alA, alB; bf16x8 pa0, pa1, pa2, pa3;
    BAR4();
    qkt(pA0, pA1, KN_lds, KR_lds, qr, qrl, r32, hi); partialSM(pA0, pA1, m_reg, mnA, alA);
    BAR4();
    for (int j = 1; j + 1 < NT; j += 2) {
      SBAR(); qkt_fin(pB0, pB1, KN_lds + SHM_KN, KR_lds + SHM_KR, qr, qrl, r32, hi, pA0, pA1, alA, l_reg, pa0, pa1, pa2, pa3);
      pv_part(o, vb0, pa0, pa1, pa2, pa3, pB0, pB1, m_reg, mnB, alB);
      RESC4(alB); BAR4();
      SBAR(); qkt_fin(pA0, pA1, KN_lds, KR_lds, qr, qrl, r32, hi, pB0, pB1, alB, l_reg, pa0, pa1, pa2, pa3);
      pv_part(o, vb0 + SHM_V, pa0, pa1, pa2, pa3, pA0, pA1, m_reg, mnA, alA);
      RESC4(alA); BAR4();
    }
    SBAR(); qkt_fin(pB0, pB1, KN_lds + SHM_KN, KR_lds + SHM_KR, qr, qrl, r32, hi, pA0, pA1, alA, l_reg, pa0, pa1, pa2, pa3);
    pv_part(o, vb0, pa0, pa1, pa2, pa3, pB0, pB1, m_reg, mnB, alB);
    RESC4(alB); BAR4();
    finishSM(pB0, pB1, alB, l_reg, pa0, pa1, pa2, pa3); SBAR();
    pv_d0(o, vb0 + SHM_V, pa0, pa1, pa2, pa3);
    if (hi == 0) li_l[r32] = l_reg; asm volatile("s_waitcnt lgkmcnt(0)" ::: "memory");
    float rli[16];
#pragma unroll
    for (int r = 0; r < 16; ++r) rli[r] = __builtin_amdgcn_rcpf(li_l[crow(r, hi)]);
#pragma unroll
    for (int d = 0; d < 4; ++d)
#pragma unroll
      for (int r = 0; r < 16; ++r) o[d][r] *= rli[r];
    BAR4();
    { bf16* Ow = Ob + (long)(wid * QBLK) * LDO; char* ost = lds + wid * (32 * 272);
#pragma unroll
      for (int r = 0; r < 16; ++r) { const int orow = crow(r, hi);
#pragma unroll
        for (int d0 = 0; d0 < 4; ++d0) *reinterpret_cast<bf16*>(ost + orow * 272 + (d0 * 32 + r32) * 2) = (bf16)f2bf(o[d0][r]); }
      asm volatile("s_waitcnt lgkmcnt(0)" ::: "memory");
#pragma unroll
      for (int i = 0; i < 8; ++i) { const int ch = i * 64 + lane, row = ch >> 4, c16 = ch & 15;
        const u32x4 v = *reinterpret_cast<const u32x4*>(ost + row * 272 + c16 * 16);
        *reinterpret_cast<u32x4*>(Ow + (long)row * LDO + c16 * 8) = v; } }
#undef RESC4
  }
  if (wv >= 4) BAR4();
  BAR4();
#undef BAR4
}

__device__ __forceinline__ int v_stT(int k, int c) { return ((k >> 3) * 4 + (c >> 5)) * 512 + ((k & 7) * 32 + (c & 31)) * 2; }
__device__ __forceinline__ void finishSMT(f32x16& p0, f32x16& p1, float alpha, float& l_reg, bf16x8& pa0, bf16x8& pa1, bf16x8& pa2, bf16x8& pa3) {
#pragma unroll
  for (int r = 0; r < 16; ++r) p1[r] = __builtin_amdgcn_exp2f(p1[r]);
  float ps = 0;
#pragma unroll
  for (int r = 0; r < 16; ++r) ps += p0[r];
#pragma unroll
  for (int r = 0; r < 16; ++r) ps += p1[r];
  { auto rr = __builtin_amdgcn_permlane32_swap(__float_as_uint(ps), __float_as_uint(ps), false, false);
    ps = __uint_as_float(rr[0]) + __uint_as_float(rr[1]); }
  l_reg = l_reg * alpha + ps;
#define PKT(P, BASE, OUT) do { u32x4 w = {cvtpk(P[BASE + 0], P[BASE + 1]), cvtpk(P[BASE + 2], P[BASE + 3]), cvtpk(P[BASE + 4], P[BASE + 5]), cvtpk(P[BASE + 6], P[BASE + 7])}; OUT = *reinterpret_cast<bf16x8*>(&w); } while (0)
  PKT(p0, 0, pa0); PKT(p0, 8, pa1); PKT(p1, 0, pa2); PKT(p1, 8, pa3);
#undef PKT
}
template <int D0> __device__ __forceinline__ void pv_oneT(f32x16& od, int vb, bf16x8 pa0, bf16x8 pa1, bf16x8 pa2, bf16x8 pa3) {
  const s16x4 l0 = tr_read<v_rd_off(D0, 0, 0)>(vb), h0 = tr_read<v_rd_off(D0, 0, 1)>(vb), l1 = tr_read<v_rd_off(D0, 1, 0)>(vb), h1 = tr_read<v_rd_off(D0, 1, 1)>(vb);
  const s16x4 l2 = tr_read<v_rd_off(D0, 2, 0)>(vb), h2 = tr_read<v_rd_off(D0, 2, 1)>(vb), l3 = tr_read<v_rd_off(D0, 3, 0)>(vb), h3 = tr_read<v_rd_off(D0, 3, 1)>(vb);
  asm volatile("s_waitcnt lgkmcnt(0)" ::: "memory"); SBAR();
#define PK(L, H) (bf16x8){L[0], L[1], L[2], L[3], H[0], H[1], H[2], H[3]}
  od = __builtin_amdgcn_mfma_f32_32x32x16_bf16(PK(l0, h0), pa0, od, 0, 0, 0);
  od = __builtin_amdgcn_mfma_f32_32x32x16_bf16(PK(l1, h1), pa1, od, 0, 0, 0);
  od = __builtin_amdgcn_mfma_f32_32x32x16_bf16(PK(l2, h2), pa2, od, 0, 0, 0);
  od = __builtin_amdgcn_mfma_f32_32x32x16_bf16(PK(l3, h3), pa3, od, 0, 0, 0);
#undef PK
}
__device__ __forceinline__ void pv_d0T(f32x16* o, int vb, bf16x8 pa0, bf16x8 pa1, bf16x8 pa2, bf16x8 pa3) {
  pv_oneT<0>(o[0], vb, pa0, pa1, pa2, pa3); pv_oneT<1>(o[1], vb, pa0, pa1, pa2, pa3); pv_oneT<2>(o[2], vb, pa0, pa1, pa2, pa3); pv_oneT<3>(o[3], vb, pa0, pa1, pa2, pa3);
}
__device__ __forceinline__ void attn_dense_body_t(const bf16* __restrict__ Qb, const bf16* __restrict__ KNh, const bf16* __restrict__ KRb, const bf16* __restrict__ Vh,
                                                  bf16* __restrict__ Ob, int seq, char* lds, const int wv) {
  const int tid = opaque_tid(wv), wid = tid >> 6, lane = tid & 63, r32 = lane & 31, hi = lane >> 5;
  char* V_lds = lds + OFF_V; char* KN_lds = lds + OFF_KN; char* KR_lds = lds + OFF_KR;
  float m_reg = -1e30f, l_reg = 0; f32x16 o[4] = {}; bf16x8 qr[NQR];
  const bf16* Qw = Qb + (long)(wid * QBLK + r32) * LDQ + hi * 8;
#pragma unroll
  for (int d0 = 0; d0 < NQR; ++d0) qr[d0] = *reinterpret_cast<const bf16x8*>(Qw + d0 * 16);
  char* qrl = lds + OFF_QR + wid * QR_WAVE + r32 * QR_PITCH + hi * 16;
#pragma unroll
  for (int d0 = NQR; d0 < 12; ++d0) *reinterpret_cast<bf16x8*>(qrl + (d0 - NQR) * 32) = *reinterpret_cast<const bf16x8*>(Qw + d0 * 16);
  const int sr = tid >> 4, sc = (tid & 15) * 8, vst0 = v_stT(sr, sc), vst1 = v_stT(32 + sr, sc);
  const int rr_ = tid >> 3, rc = (tid & 7) * 8;
  const int vb0 = (int)(uintptr_t)V_lds + v_rd_base(lane);
  bf16x8 s_vs0, s_vs1, s_ks0, s_ks1, s_kr;
#define SLOADK(k0) do { s_ks0 = *reinterpret_cast<const bf16x8*>(&KNh[(long)((k0) + sr) * LDKN + sc]); s_ks1 = *reinterpret_cast<const bf16x8*>(&KNh[(long)((k0) + 32 + sr) * LDKN + sc]); \
    s_kr = *reinterpret_cast<const bf16x8*>(&KRb[(long)((k0) + rr_) * LDKR + rc]); } while (0)
#define SLOADV(k0) do { s_vs0 = *reinterpret_cast<const bf16x8*>(&Vh[(long)((k0) + sr) * LDV + sc]); s_vs1 = *reinterpret_cast<const bf16x8*>(&Vh[(long)((k0) + 32 + sr) * LDV + sc]); } while (0)
#define SWRITEK(b) do { const int kc = sc * 2; *(bf16x8*)(KN_lds + (b) * SHM_KN + KSWZ(sr, kc)) = s_ks0; *(bf16x8*)(KN_lds + (b) * SHM_KN + KSWZ(32 + sr, kc)) = s_ks1; \
    *(bf16x8*)(KR_lds + (b) * SHM_KR + KRSWZ(rr_, rc * 2)) = s_kr; } while (0)
#define SWRITEV(b) do { *(bf16x8*)(V_lds + (b) * SHM_V + vst0) = s_vs0; *(bf16x8*)(V_lds + (b) * SHM_V + vst1) = s_vs1; } while (0)
#define VWAIT() asm volatile("s_waitcnt vmcnt(0)" ::: "memory")
#define RESCT(a) do { if (__any((a) < 1.f)) { _Pragma("unroll") for (int d = 0; d < 4; ++d) _Pragma("unroll") for (int r = 0; r < 16; ++r) o[d][r] *= (a); } } while (0)
  f32x16 pA0, pA1, pB0, pB1; float mnA, mnB, alA, alB; bf16x8 pa0, pa1, pa2, pa3; const int NT = seq / KVBLK;
  SLOADK(0); VWAIT(); SWRITEK(0); __syncthreads();
  qkt(pA0, pA1, KN_lds, KR_lds, qr, qrl, r32, hi);
  SLOADK(KVBLK); SLOADV(0); SBAR();
  partialSM(pA0, pA1, m_reg, mnA, alA);
  VWAIT(); SWRITEK(1); SWRITEV(0);
  __syncthreads();
  for (int j = 1; j + 1 < NT; j += 2) {
    SBAR(); qkt(pB0, pB1, KN_lds + SHM_KN, KR_lds + SHM_KR, qr, qrl, r32, hi);
    finishSMT(pA0, pA1, alA, l_reg, pa0, pa1, pa2, pa3); SBAR();
    SLOADK((j + 1) * KVBLK); SLOADV(j * KVBLK); SBAR();
    pv_d0T(o, vb0, pa0, pa1, pa2, pa3); partialSM(pB0, pB1, m_reg, mnB, alB);
    VWAIT(); SWRITEK(0); SWRITEV(1);
    RESCT(alB); __syncthreads();
    SBAR(); qkt(pA0, pA1, KN_lds, KR_lds, qr, qrl, r32, hi);
    finishSMT(pB0, pB1, alB, l_reg, pa0, pa1, pa2, pa3); SBAR();
    SLOADK((j + 2) * KVBLK); SLOADV((j + 1) * KVBLK); SBAR();
    pv_d0T(o, vb0 + SHM_V, pa0, pa1, pa2, pa3); partialSM(pA0, pA1, m_reg, mnA, alA);
    VWAIT(); SWRITEK(1); SWRITEV(0);
    RESCT(alA); __syncthreads();
  }
  SBAR(); qkt(pB0, pB1, KN_lds + SHM_KN, KR_lds + SHM_KR, qr, qrl, r32, hi);
  finishSMT(pA0, pA1, alA, l_reg, pa0, pa1, pa2, pa3); SBAR();
  SLOADV((NT - 1) * KVBLK); SBAR();
  pv_d0T(o, vb0, pa0, pa1, pa2, pa3); partialSM(pB0, pB1, m_reg, mnB, alB);
  VWAIT(); SWRITEV(1); RESCT(alB); __syncthreads();
  finishSMT(pB0, pB1, alB, l_reg, pa0, pa1, pa2, pa3); SBAR();
  pv_d0T(o, vb0 + SHM_V, pa0, pa1, pa2, pa3);
  const float rl = __builtin_amdgcn_rcpf(l_reg);
  bf16* Ow = Ob + (long)(wid * QBLK) * LDO;
  __syncthreads();
  { char* ost = lds + wid * (32 * 272);
#pragma unroll
    for (int d0 = 0; d0 < 4; ++d0)
#pragma unroll
      for (int r = 0; r < 16; ++r) *reinterpret_cast<bf16*>(ost + r32 * 272 + (d0 * 32 + crow(r, hi)) * 2) = (bf16)f2bf(o[d0][r] * rl);
    asm volatile("s_waitcnt lgkmcnt(0)" ::: "memory");
#pragma unroll
    for (int i = 0; i < 8; ++i) { const int ch = i * 64 + lane, row = ch >> 4, c16 = ch & 15;
      const u32x4 v = *reinterpret_cast<const u32x4*>(ost + row * 272 + c16 * 16);
      *reinterpret_cast<u32x4*>(Ow + (long)row * LDO + c16 * 8) = v; }
  }
  __syncthreads();
#undef SLOADK
#undef SLOADV
#undef SWRITEK
#undef SWRITEV
#undef VWAIT
#undef RESCT
}
#undef KSWZ
#undef KRSWZ
#undef SBAR
#undef QK_FENCE
#undef PK4F
}

constexpr int PTAB_OFF = MISC_OFF + 256;
enum { IN_x = 0, IN_p, IN_pos, IN_ffn1_norm, IN_ffn1_wg, IN_ffn1_wu, IN_ffn1_wd, IN_mix_norm, IN_w_in, IN_q_norm, IN_w_uq, IN_kv_norm, IN_w_ukv, IN_conv_w, IN_conv_b, IN_mw_q, IN_mw_k, IN_i_bias, IN_f_bias,
       IN_head_norm, IN_skip, IN_fnet_w, IN_fnet_b, IN_w_out, IN_ffn2_norm, IN_ffn2_wg, IN_ffn2_wu, IN_ffn2_wd, IN_pg_norm, IN_ple_wg, IN_ple_wp, IN_ple_post, IN_final_norm };
__device__ __forceinline__ const float* inp(const Frame& F, int k) {
    const LAS unsigned* t = (const LAS unsigned*)(F.lds + PTAB_OFF) + 2 * k;
    const unsigned lo = __builtin_amdgcn_readfirstlane(t[0]), hi = __builtin_amdgcn_readfirstlane(t[1]);
    return (const float*)(const GAS float*)(((unsigned long long)hi << 32) | lo);
}

template <typename T> __device__ __forceinline__ T* wsp(unsigned char* ws, size_t off) { unsigned long long z = off; asm volatile("" : "+s"(z)); return (T*)(ws + z); }

__device__ __forceinline__ void prologue_a(Frame& F) {
    unsigned char* ws = F.ws;
    float* ropec = (float*)(ws + WS_ROPEC); float* ropes = (float*)(ws + WS_ROPES);
    const int gt = F.vcu * 512 + F.tid, NGT = F.G * 512;
    const int* pos_ = (const int*)inp(F, IN_pos); const float* x_ = inp(F, IN_x); const float* wout_ = inp(F, IN_w_out); const float* fw_ = inp(F, IN_fnet_w); const float* fb_ = inp(F, IN_fnet_b);
    for (int i = gt; i < MTOK * 32; i += NGT) {
        const int row = i >> 5, j = i & 31;
        const float inv = 1.0f / powf(10000.0f, (float)(2 * j) / 64.0f);
        const float ang = (float)pos_[row] * inv;
        const double rev = (double)ang * 0.15915494309189535;
        const float fr = (float)(rev - floor(rev));
        ropec[i] = __builtin_amdgcn_cosf(fr); ropes[i] = __builtin_amdgcn_sinf(fr);
    }
    bf16* XB1 = (bf16*)(ws + B_XB1); float* SS0 = (float*)(ws + WS_SS);
    const int gw = F.vcu * 8 + F.wave, NGW = F.G * 8;
    for (int mp = gw; mp < MTOK / 2; mp += NGW) {
        const int m0 = 2 * mp; f32x4 v[2][4];
#pragma unroll
        for (int q = 0; q < 2; ++q)
#pragma unroll
            for (int j = 0; j < 4; ++j) v[q][j] = ((const GAS f32x4*)(x_ + (size_t)(m0 + q) * DM) + F.lane)[64 * j];
#pragma unroll
        for (int q = 0; q < 2; ++q) {
            GAS v2u* o8 = (GAS v2u*)(XB1 + (size_t)(m0 + q) * DM) + F.lane; float s = 0.f;
#pragma unroll
            for (int j = 0; j < 4; ++j) { const f32x4 t = v[q][j]; v2u w; w.x = pk2(t[0], t[1]); w.y = pk2(t[2], t[3]); o8[64 * j] = w; s += (t[0] * t[0] + t[1] * t[1]) + (t[2] * t[2] + t[3] * t[3]); }
            s = quad_sum(s);
            if ((F.lane & 3) == 0) SS0[(size_t)(m0 + q) * 16 + (F.lane >> 2)] = s;
        }
    }
    int cbase = 0;
    for (int l = 0; l < DEPTH; ++l) {
        CvtJob J{wout_ + (size_t)l * DM * DM, DM, 768, 0, DM, (bf16*)(ws + WS_WOUT) + (size_t)l * DM * KOUT, KOUT, 0, 0, nullptr};
        cvt_job(F, J, cbase);
    }
    float* F1 = (float*)(ws + B_F1); float* BO = (float*)(ws + WS_BOUT);
    for (int i = gt; i < DEPTH * 4 * 64 * DM; i += NGT) {
        const int n = i & 1023, cp = (i >> 10) & 63, g = (i >> 16) & 3, l = i >> 18;
        const float* fw = fw_ + ((size_t)(l * 4 + g) * 64 + cp) * 64; const float* wo = wout_ + ((size_t)l * DM + 768 + 64 * g) * DM + n;
        float a = 0.f;
#pragma unroll 16
        for (int e = 0; e < 64; ++e) a += fw[e] * wo[(size_t)e * DM];
        F1[i] = a;
    }
    for (int i = gt; i < DEPTH * DM; i += NGT) {
        const int n = i & 1023, l = i >> 10; float a = 0.f;
#pragma unroll 32
        for (int e = 0; e < 256; ++e) a += fb_[l * 256 + e] * wout_[((size_t)l * DM + 768 + e) * DM + n];
        BO[i] = a;
    }
}
__device__ __forceinline__ void prologue_b(Frame& F) {
    unsigned char* ws = F.ws; const float* F1 = (const float*)(ws + B_F1); bf16* WO = (bf16*)(ws + WS_WOUT);
    const int gt = F.vcu * 512 + F.tid, NGT = F.G * 512;
    for (int i = gt; i < DEPTH * DM * 256; i += NGT) {
        const int c = i & 63, g = (i >> 6) & 3, n = (i >> 8) & 1023, l = i >> 18;
        const float* f = F1 + ((size_t)(l * 4 + g) * 64) * DM + n; float ar = 0.f, ai = 0.f;
#pragma unroll 16
        for (int cp = 0; cp < 64; ++cp) { const float fr = (float)((c * cp) & 63) * (1.0f / 64.0f); const float v = f[(size_t)cp * DM];
            ar += __builtin_amdgcn_cosf(fr) * v; ai += __builtin_amdgcn_sinf(fr) * v; }
        bf16* dst = WO + ((size_t)l * DM + n) * KOUT;
        dst[768 + 64 * g + c] = (bf16)f2bf(ar); dst[1024 + 64 * g + c] = (bf16)f2bf(ai);
    }
}

__device__ __forceinline__ void convert_jobs(Frame& F, int l, int jlo, int jhi) {
    unsigned char* wl = F.ws + WS_WL;
    const size_t ffo = (size_t)l * DM * DFF; int cbase = 0;
    for (int jj = jlo; jj < jhi; ++jj) {
        CvtJob J;
        switch (jj) {
        case 0: J = CvtJob{inp(F, IN_ffn1_wg) + ffo, DFF, DM, 0, DFF, (bf16*)(wl + WL_GU1), DM, 0, 4, inp(F, IN_ffn1_norm) + l * DM}; break;
        case 1: J = CvtJob{inp(F, IN_ffn1_wu) + ffo, DFF, DM, 0, DFF, (bf16*)(wl + WL_GU1), DM, 128, 4, inp(F, IN_ffn1_norm) + l * DM}; break;
        case 2: J = CvtJob{inp(F, IN_ffn1_wd) + ffo, DM, DFF, 0, DM, (bf16*)(wl + WL_D1), DFF, 0, 0, nullptr}; break;
        case 3: J = CvtJob{inp(F, IN_ffn2_wg) + ffo, DFF, DM, 0, DFF, (bf16*)(wl + WL_GU2), DM, 0, 4, inp(F, IN_ffn2_norm) + l * DM}; break;
        case 4: J = CvtJob{inp(F, IN_ffn2_wu) + ffo, DFF, DM, 0, DFF, (bf16*)(wl + WL_GU2), DM, 128, 4, inp(F, IN_ffn2_norm) + l * DM}; break;
        case 5: J = CvtJob{inp(F, IN_ffn2_wd) + ffo, DM, DFF, 0, DM, (bf16*)(wl + WL_D2), DFF, 0, 0, nullptr}; break;
        case 6: J = CvtJob{inp(F, IN_w_in) + (size_t)l * DM * DIN, DIN, DM, 0, 640, (bf16*)(wl + WL_IN), DM, 0, 0, inp(F, IN_mix_norm) + l * DM}; break;
        case 7: J = CvtJob{inp(F, IN_w_in) + (size_t)l * DM * DIN, DIN, DM, 640, 64, (bf16*)(wl + WL_IN), DM, 640, 2, inp(F, IN_mix_norm) + l * DM}; break;
        case 8: J = CvtJob{inp(F, IN_w_in) + (size_t)l * DM * DIN, DIN, DM, 1472, 32, (bf16*)(wl + WL_IN), DM, 704, 0, inp(F, IN_mix_norm) + l * DM}; break;
        case 9: J = CvtJob{inp(F, IN_w_in) + (size_t)l * DM * DIN, DIN, DM, 704, 768, (bf16*)(wl + WL_IN), DM, 768, 0, inp(F, IN_mix_norm) + l * DM}; break;
        case 10: J = CvtJob{inp(F, IN_w_in) + (size_t)l * DM * DIN, DIN, DM, 1488, 256, (bf16*)(wl + WL_IN), DM, 1536, 0, inp(F, IN_mix_norm) + l * DM}; break;
        case 11: J = CvtJob{inp(F, IN_w_uq) + (size_t)l * QL * NQ, NQ, QL, 0, NQ, (bf16*)(wl + WL_UQ), QL, 0, 3, inp(F, IN_q_norm) + l * QL}; break;
        case 12: J = CvtJob{inp(F, IN_w_ukv) + (size_t)l * KVL * NKV, NKV, KVL, 0, NKV, (bf16*)(wl + WL_UKV), KVL, 0, 0, inp(F, IN_kv_norm) + l * KVL}; break;
        case 13: J = CvtJob{nullptr, 0, 0, 0, 0, nullptr, 0, 0, 0, nullptr}; break;
        case 14: J = CvtJob{inp(F, IN_ple_wp) + (size_t)l * PLE * DM, DM, PLE, 0, DM, (bf16*)(wl + WL_PP), PLE, 0, 0, nullptr}; break;
        default: J = CvtJob{nullptr, 0, 0, 0, 0, nullptr, 0, 0, 0, nullptr}; break;
        }
        if (J.W) cvt_job(F, J, cbase);
    }
}
__device__ __forceinline__ void convert_layer(Frame& F, int l) {
    unsigned char* wl = F.ws + WS_WL;
    convert_jobs(F, l, 0, 16);
    { GAS v4u* z = (GAS v4u*)((bf16*)(wl + WL_IN) + (size_t)736 * DM); const int gt = F.vcu * 512 + F.tid;
      unsigned zz = 0u; asm volatile("" : "+v"(zz));
      for (int i = gt; i < 32 * DM / 8; i += F.G * 512) z[i] = (v4u){zz, zz, zz, zz}; }
}
__device__ __forceinline__ void convert_pg(Frame& F, int l) {
    unsigned char* wl = F.ws + WS_WL; int cbase = 0;
    CvtJob J{inp(F, IN_ple_wg) + (size_t)l * DM * DM, DM, DM, 0, DM, (bf16*)(wl + WL_PG), DM, 0, 0, inp(F, IN_pg_norm) + l * DM};
    cvt_job(F, J, cbase);
}
__device__ __forceinline__ void convert_p(Frame& F, int l) {
    const GAS f32x4* src = (const GAS f32x4*)(inp(F, IN_p) + (size_t)l * MTOK * PLE); GAS v2u* dst = (GAS v2u*)(F.ws + B_PB);
    const int gt = F.vcu * 512 + F.tid, NGT = F.G * 512; constexpr int N4 = MTOK * PLE / 4;
    int i = gt;
    for (; i + 3 * NGT < N4; i += 4 * NGT) {
        f32x4 v[4];
#pragma unroll
        for (int j = 0; j < 4; ++j) v[j] = src[i + j * NGT];
#pragma unroll
        for (int j = 0; j < 4; ++j) { v2u w; w.x = pk2(v[j][0], v[j][1]); w.y = pk2(v[j][2], v[j][3]); dst[i + j * NGT] = w; }
    }
    for (; i < N4; i += NGT) { const f32x4 v = src[i]; v2u w; w.x = pk2(v[0], v[1]); w.y = pk2(v[2], v[3]); dst[i] = w; }
}

struct M1Pre { v4u mx[5]; v4u mv; float iv, fv, ib, fb; };
__device__ __forceinline__ void m1_load(M1Pre& P, unsigned char* ws, const float* ib_, const float* fbias_, int l, int b, int hh, int c, int tid, int lane, int w) {
    const int j = tid >> 3, d8 = (tid & 7) * 8, ch = hh * 64 + d8;
    const bf16* MX = wsp<const bf16>(ws, B_MX);
#pragma unroll
    for (int tap = 0; tap < 5; ++tap) { const int ss = c * 64 + j + tap - 2; P.mx[tap] = (v4u){0u, 0u, 0u, 0u}; if (ss >= 0 && ss < SEQ) P.mx[tap] = *(const GAS v4u*)(MX + (size_t)(b * SEQ + ss) * 256 + ch); }
    P.mv = *(const GAS v4u*)(wsp<const bf16>(ws, B_MV) + (size_t)(b * SEQ + c * 64 + j) * 256 + ch);
    P.iv = 0.f; P.fv = 0.f; P.ib = 0.f; P.fb = 0.f;
    if (w < 2) { const int dir = w, tok = b * SEQ + c * 64 + (dir ? 63 - lane : lane); const float* MIF = wsp<const float>(ws, B_MIF);
        P.iv = MIF[(size_t)tok * 16 + dir * 4 + hh]; P.ib = ib_[l * 8 + dir * 4 + hh]; P.fv = MIF[(size_t)tok * 16 + 8 + dir * 4 + hh]; P.fb = fbias_[l * 8 + dir * 4 + hh]; }
}
__device__ __forceinline__ void mlstm_m1(Frame& F, int l) {
    unsigned char* ws = F.ws;
    LAS bf16* XCs = (LAS bf16*)(F.lds); LAS bf16* WqT = XCs + 64 * 72; LAS bf16* WkT = WqT + 64 * 72; LAS bf16* VT = WkT + 64 * 72;
    LAS bf16* KT0 = VT + 64 * 72; LAS bf16* KT1 = KT0 + 64 * 72; LAS float* wv = (LAS float*)(KT1 + 64 * 72);
    const int tid = F.tid, lane = F.lane, w = F.wave, hi = lane >> 5, r32 = lane & 31;
    const float* convb_ = inp(F, IN_conv_b); const float* convw_ = inp(F, IN_conv_w); const float* mwq_ = inp(F, IN_mw_q); const float* mwk_ = inp(F, IN_mw_k); const float* ib_ = inp(F, IN_i_bias); const float* fbias_ = inp(F, IN_f_bias);
    constexpr int NUN = NB * 4 * NCHUNK; const int per = NUN / F.G; const bool contig = (per * F.G == NUN) && (NCHUNK % (per > 0 ? per : 1) == 0);
    const int cnt = contig ? per : (NUN - F.vcu + F.G - 1) / F.G;
    int hh_loaded = -1; f32x4 cwv[6][2];
#pragma unroll
    for (int q = 0; q < 6; ++q) cwv[q][0] = cwv[q][1] = (f32x4){0.f, 0.f, 0.f, 0.f};
    M1Pre P;
    if (cnt > 0) { const int unit = contig ? F.vcu * per : F.vcu; m1_load(P, ws, ib_, fbias_, l, unit >> 9, (unit >> 7) & 3, unit & 127, tid, lane, w); }
    for (int i = 0; i < cnt; ++i) {
        const int unit = contig ? F.vcu * per + i : F.vcu + i * F.G;
        const int b = unit >> 9, hh = (unit >> 7) & 3, c = unit & 127; const int t0 = b * SEQ + c * 64;
        const M1Pre C = P;
        {
            const int j = tid >> 3, d8 = (tid & 7) * 8, ch = hh * 64 + d8; float a[8];
            if (hh != hh_loaded) {
                cwv[0][0] = *(const f32x4*)(convb_ + l * 256 + ch); cwv[0][1] = *(const f32x4*)(convb_ + l * 256 + ch + 4);
#pragma unroll
                for (int tap = 0; tap < 5; ++tap) { const float* cw = convw_ + ((size_t)l * 5 + tap) * 256 + ch; cwv[1 + tap][0] = *(const f32x4*)cw; cwv[1 + tap][1] = *(const f32x4*)(cw + 4); } }
#pragma unroll
            for (int q = 0; q < 8; ++q) a[q] = cwv[0][q >> 2][q & 3];
#pragma unroll
            for (int tap = 0; tap < 5; ++tap) { float xv[8]; unpack8(C.mx[tap], xv);
#pragma unroll
                for (int q = 0; q < 8; ++q) a[q] += xv[q] * cwv[1 + tap][q >> 2][q & 3]; }
#pragma unroll
            for (int q = 0; q < 8; ++q) a[q] = siluf_(a[q]);
            const v4u xw = pack8(a);
            *(LAS v4u*)(XCs + j * 72 + d8) = xw; *(GAS v4u*)(wsp<bf16>(ws, B_XC) + (size_t)(t0 + j) * 256 + ch) = xw;
            if (hh != hh_loaded) { const int e = j; const float* wq = mwq_ + ((size_t)(l * 4 + hh) * 64 + d8) * 64 + e; const float* wk = mwk_ + ((size_t)(l * 4 + hh) * 64 + d8) * 64 + e; float q8[8], k8[8];
#pragma unroll
              for (int q = 0; q < 8; ++q) { q8[q] = wq[q * 64]; k8[q] = wk[q * 64]; }
              *(LAS v4u*)(WqT + e * 72 + d8) = pack8(q8); *(LAS v4u*)(WkT + e * 72 + d8) = pack8(k8); }
            { const unsigned ww[4] = {C.mv.x, C.mv.y, C.mv.z, C.mv.w};
#pragma unroll
              for (int q = 0; q < 8; ++q) VT[(d8 + q) * 72 + j] = (bf16)((q & 1) ? (ww[q >> 1] >> 16) : (ww[q >> 1] & 0xffffu)); }
        }
        hh_loaded = hh;
        if (w < 2) {
            const int dir = w;
            const float lf = logsigmoidf_(C.fv + C.fb);
            const float bc = wave_incl_sum(lf, lane); const float bL = lane_bcast(bc, 63);
            const float lw = bL - bc + (C.iv + C.ib); const float ml = wave_max(lw, lane);
            wv[dir * 64 + (dir ? 63 - lane : lane)] = __expf(lw - ml);
            if (lane == 0) { const int chain = dir * 16 + b * 4 + hh, chunk = dir ? (NCHUNK - 1 - c) : c; float* SCL = wsp<float>(ws, B_SCL); SCL[((size_t)chain * NCHUNK + chunk) * 4 + 0] = bL; SCL[((size_t)chain * NCHUNK + chunk) * 4 + 1] = ml; }
        }
        if (i + 1 < cnt) { const int un = contig ? F.vcu * per + i + 1 : F.vcu + (i + 1) * F.G; m1_load(P, ws, ib_, fbias_, l, un >> 9, (un >> 7) & 3, un & 127, tid, lane, w); }
        __syncthreads();
        const int ti = (w >> 1) & 1, tj = w & 1, dir = w >> 2;
        {
            const f32x16 acc = mma_tile(XCs + ti * 32 * 72, 72, (dir ? WkT : WqT) + tj * 32 * 72, 72, 64, lane);
            bf16* dst = (dir ? wsp<bf16>(ws, B_KM) : wsp<bf16>(ws, B_QM)) + (size_t)t0 * 256 + hh * 64 + tj * 32 + r32; const float sc = dir ? 1.0f : 0.125f;
#pragma unroll
            for (int r = 0; r < 16; ++r) dst[(size_t)(ti * 32 + crow32(r, hi)) * 256] = (bf16)f2bf(acc[r] * sc);
        }
        {
            const f32x16 acc = mma_tile(WkT + ti * 32 * 72, 72, XCs + tj * 32 * 72, 72, 64, lane);
            const float wj = wv[dir * 64 + tj * 32 + r32]; LAS bf16* kt = (dir ? KT1 : KT0) + tj * 32 + r32;
#pragma unroll
            for (int r = 0; r < 16; ++r) kt[(ti * 32 + crow32(r, hi)) * 72] = (bf16)f2bf(acc[r] * wj);
        }
        __syncthreads();
        {
            const f32x16 acc = mma_tile(VT + ti * 32 * 72, 72, (dir ? KT1 : KT0) + tj * 32 * 72, 72, 64, lane);
            const int chain = dir * 16 + b * 4 + hh, chunk = dir ? (NCHUNK - 1 - c) : c;
            bf16* dst = wsp<bf16>(ws, B_CST) + ((size_t)chain * NCHUNK + chunk) * 4096 + tj * 32 + r32;
#pragma unroll
            for (int r = 0; r < 16; ++r) dst[(ti * 32 + crow32(r, hi)) * 64] = (bf16)f2bf(acc[r]);
        }
        {
            const int row = tid >> 2, part = tid & 3, d = row >> 6, kk = row & 63; const LAS bf16* kt = (d ? KT1 : KT0) + kk * 72 + part * 16; float p8[8], s = 0.f;
            unpack8(*(const LAS v4u*)kt, p8); s += ((p8[0] + p8[1]) + (p8[2] + p8[3])) + ((p8[4] + p8[5]) + (p8[6] + p8[7]));
            unpack8(*(const LAS v4u*)(kt + 8), p8); s += ((p8[0] + p8[1]) + (p8[2] + p8[3])) + ((p8[4] + p8[5]) + (p8[6] + p8[7]));
            s = quad_sum(s);
            if (part == 0) { const int chain = d * 16 + b * 4 + hh, chunk = d ? (NCHUNK - 1 - c) : c; wsp<float>(ws, B_NST)[((size_t)chain * NCHUNK + chunk) * 64 + kk] = s; } }
        __syncthreads();
    }
}
__device__ __forceinline__ void mlstm_m2(Frame& F) {
    typedef float f32x2m __attribute__((ext_vector_type(2)));
    unsigned char* ws = F.ws; bf16* CST = (bf16*)(ws + B_CST); float* NST = (float*)(ws + B_NST); float* SCL = (float*)(ws + B_SCL);
    for (int g = F.vcu * 512 + F.tid; g < NCHAIN * 4096; g += F.G * 512) {
        const int chain = g >> 12, e = g & 4095; float m = 0.f, C = 0.f, n = 0.f;
        bf16* cp = CST + (size_t)chain * NCHUNK * 4096 + e; float* np = NST + (size_t)chain * NCHUNK * 64 + (e & 63); float* sp = SCL + (size_t)chain * NCHUNK * 4;
#define M2_LOAD(CL, NL, BM, c0) do { BM = *(const GAS f32x2m*)(sp + ((c0) + (F.lane & 31)) * 4); _Pragma("unroll") for (int q = 0; q < 32; ++q) { CL[q] = bf2f(cp[(size_t)((c0) + q) * 4096]); NL[q] = 0.f; if (e < 64) NL[q] = np[((c0) + q) * 64]; } } while (0)
#define M2_STEP(CL, NL, BM, c0) do { _Pragma("unroll") for (int q = 0; q < 32; ++q) { const float bLq = lane_bcast(BM.x, q), mlq = lane_bcast(BM.y, q); \
                cp[(size_t)((c0) + q) * 4096] = (bf16)f2bf(C); if (e < 64) np[((c0) + q) * 64] = n; if (e == 0) sp[((c0) + q) * 4 + 2] = m; \
                const float mn = fmaxf(bLq + m, mlq); const float dec = __expf(bLq + m - mn), wl_ = __expf(mlq - mn); \
                C = dec * C + wl_ * CL[q]; n = dec * n + wl_ * NL[q]; m = mn; } } while (0)
        float clA[32], nlA[32], clB[32], nlB[32]; f32x2m bmA, bmB;
        M2_LOAD(clA, nlA, bmA, 0);
        static_assert(NCHUNK % 64 == 0, "two batches per trip");
#pragma unroll
        for (int c0 = 0; c0 < NCHUNK; c0 += 64) {
            M2_LOAD(clB, nlB, bmB, c0 + 32);
            M2_STEP(clA, nlA, bmA, c0);
            if (c0 + 64 < NCHUNK) M2_LOAD(clA, nlA, bmA, c0 + 64);
            M2_STEP(clB, nlB, bmB, c0 + 32);
        }
#undef M2_LOAD
#undef M2_STEP
    }
}
struct M3Pre { v4u q, k, v, cf, cb, xc, mo; float nv, iv, fv, ib, fb, m0; };
__device__ __forceinline__ void m3_load(M3Pre& P, unsigned char* ws, const float* ib_, const float* fbias_, int l, int b, int hh, int c, int tid, int lane, int w) {
    const int t = tid >> 3, d8 = (tid & 7) * 8; const size_t go = (size_t)(b * SEQ + c * 64 + t) * 256 + hh * 64 + d8;
    const int chf = b * 4 + hh, chb = 16 + b * 4 + hh, ckf = c, ckb = NCHUNK - 1 - c;
    P.q = *(const GAS v4u*)(wsp<const bf16>(ws, B_QM) + go); P.k = *(const GAS v4u*)(wsp<const bf16>(ws, B_KM) + go); P.v = *(const GAS v4u*)(wsp<const bf16>(ws, B_MV) + go);
    P.xc = *(const GAS v4u*)(wsp<const bf16>(ws, B_XC) + go); P.mo = *(const GAS v4u*)(wsp<const bf16>(ws, B_MO) + go);
    const bf16* CST = wsp<const bf16>(ws, B_CST);
    P.cf = *(const GAS v4u*)(CST + ((size_t)chf * NCHUNK + ckf) * 4096 + t * 64 + d8); P.cb = *(const GAS v4u*)(CST + ((size_t)chb * NCHUNK + ckb) * 4096 + t * 64 + d8);
    P.nv = 0.f; if (tid < 128) { const int d = tid >> 6, k = tid & 63; P.nv = wsp<const float>(ws, B_NST)[((size_t)(d ? chb : chf) * NCHUNK + (d ? ckb : ckf)) * 64 + k]; }
    P.iv = 0.f; P.fv = 0.f; P.ib = 0.f; P.fb = 0.f; P.m0 = 0.f;
    if (w < 2) { const int dir = w, tok = b * SEQ + c * 64 + (dir ? 63 - lane : lane); const float* MIF = wsp<const float>(ws, B_MIF);
        P.iv = MIF[(size_t)tok * 16 + dir * 4 + hh]; P.ib = ib_[l * 8 + dir * 4 + hh]; P.fv = MIF[(size_t)tok * 16 + 8 + dir * 4 + hh]; P.fb = fbias_[l * 8 + dir * 4 + hh];
        P.m0 = wsp<const float>(ws, B_SCL)[((size_t)(dir ? chb : chf) * NCHUNK + (dir ? ckb : ckf)) * 4 + 2]; }
}
__device__ __forceinline__ void mlstm_m3(Frame& F, int l) {
    unsigned char* ws = F.ws;
    LAS bf16* Qs = (LAS bf16*)(F.lds); LAS bf16* Ks = Qs + 64 * 72; LAS bf16* A0 = Ks + 64 * 72; LAS bf16* A1 = A0 + 64 * 136; LAS bf16* B0 = A1 + 64 * 136; LAS bf16* B1 = B0 + 64 * 136;
    LAS float* Hs = (LAS float*)(B1 + 64 * 136); LAS float* vec = Hs + 2 * 64 * 68;
    LAS float* av = vec; LAS float* Mv = vec + 128; LAS float* mtv = vec + 256; LAS float* wst = vec + 384; LAS float* nvec = vec + 512; LAS float* rden = vec + 640;
    const int tid = F.tid, lane = F.lane, w = F.wave, hi = lane >> 5, r32 = lane & 31;
    const float* ib_ = inp(F, IN_i_bias); const float* fbias_ = inp(F, IN_f_bias); const float* hn_ = inp(F, IN_head_norm); const float* sk_ = inp(F, IN_skip);
    constexpr int NUN = NB * 4 * NCHUNK; const int per = NUN / F.G; const bool contig = (per * F.G == NUN) && (NCHUNK % (per > 0 ? per : 1) == 0);
    const int cnt = contig ? per : (NUN - F.vcu + F.G - 1) / F.G;
    M3Pre P;
    if (cnt > 0) { const int unit = contig ? F.vcu * per : F.vcu; m3_load(P, ws, ib_, fbias_, l, unit >> 9, (unit >> 7) & 3, unit & 127, tid, lane, w); }
    int hh_loaded = -1; f32x4 hnv[2], skv[2];
    hnv[0] = hnv[1] = skv[0] = skv[1] = (f32x4){0.f, 0.f, 0.f, 0.f};
    for (int i = 0; i < cnt; ++i) {
        const int unit = contig ? F.vcu * per + i : F.vcu + i * F.G;
        const int b = unit >> 9, hh = (unit >> 7) & 3, c = unit & 127; const int t0 = b * SEQ + c * 64;
        const M3Pre C = P;
        if (hh != hh_loaded) { const int v8 = (tid & 7) * 8; const float* hn = hn_ + l * 256 + hh * 64 + v8; const float* sk = sk_ + l * 256 + hh * 64 + v8;
            hnv[0] = *(const f32x4*)hn; hnv[1] = *(const f32x4*)(hn + 4); skv[0] = *(const f32x4*)sk; skv[1] = *(const f32x4*)(sk + 4); hh_loaded = hh; }
        {
            const int t = tid >> 3, d8 = (tid & 7) * 8;
            *(LAS v4u*)(Qs + t * 72 + d8) = C.q; *(LAS v4u*)(Ks + t * 72 + d8) = C.k;
            { const unsigned ww[4] = {C.v.x, C.v.y, C.v.z, C.v.w};
#pragma unroll
              for (int q = 0; q < 8; ++q) { const bf16 e = (bf16)((q & 1) ? (ww[q >> 1] >> 16) : (ww[q >> 1] & 0xffffu)); B0[(d8 + q) * 136 + t] = e; B1[(d8 + q) * 136 + t] = e; } }
            *(LAS v4u*)(B0 + t * 136 + 64 + d8) = C.cf; *(LAS v4u*)(B1 + t * 136 + 64 + d8) = C.cb;
            if (tid < 128) nvec[tid] = C.nv;
        }
        if (w < 2) {
            const int dir = w, idx = dir ? 63 - lane : lane;
            const float bc = wave_incl_sum(logsigmoidf_(C.fv + C.fb), lane); const float a = (C.iv + C.ib) - bc; const float pm = wave_incl_max(a, lane);
            const float Mx = fmaxf(C.m0, pm);
            av[dir * 64 + idx] = a; Mv[dir * 64 + idx] = Mx; mtv[dir * 64 + idx] = bc + Mx; wst[dir * 64 + idx] = __expf(C.m0 - Mx);
        }
        if (i + 1 < cnt) { const int un = contig ? F.vcu * per + i + 1 : F.vcu + (i + 1) * F.G; m3_load(P, ws, ib_, fbias_, l, un >> 9, (un >> 7) & 3, un & 127, tid, lane, w); }
        __syncthreads();
        const int ti = (w >> 1) & 1, tj = w & 1, dir = w >> 2;
        {
            const f32x16 acc = mma_tile(Qs + ti * 32 * 72, 72, Ks + tj * 32 * 72, 72, 64, lane);
            const int s = tj * 32 + r32; const float as = av[dir * 64 + s]; LAS bf16* A = (dir ? A1 : A0) + s;
#pragma unroll
            for (int r = 0; r < 16; ++r) { const int t = ti * 32 + crow32(r, hi); const bool ok = dir ? (s >= t) : (s <= t);
                const float p = ok ? acc[r] * __expf(as - Mv[dir * 64 + t]) : 0.f; A[t * 136] = (bf16)f2bf(p); }
        }
        {
            const int t = tid >> 3, d8 = (tid & 7) * 8; float q8[8]; unpack8(C.q, q8);
            float f8[8], g8[8]; const float w0 = wst[t], w1 = wst[64 + t];
#pragma unroll
            for (int q = 0; q < 8; ++q) { f8[q] = q8[q] * w0; g8[q] = q8[q] * w1; }
            *(LAS v4u*)(A0 + t * 136 + 64 + d8) = pack8(f8); *(LAS v4u*)(A1 + t * 136 + 64 + d8) = pack8(g8);
        }
        __syncthreads();
        const f32x16 num = mma_tile((dir ? A1 : A0) + ti * 32 * 136, 136, (dir ? B1 : B0) + tj * 32 * 136, 136, 128, lane);
        {
            const int row = tid >> 2, part = tid & 3, d = row >> 6, t = row & 63; const LAS bf16* Ar = (d ? A1 : A0) + t * 136 + part * 16; const LAS float* nv = nvec + d * 64 + part * 16;
            float p8[8], den = 0.f;
            unpack8(*(const LAS v4u*)Ar, p8); den += ((p8[0] + p8[1]) + (p8[2] + p8[3])) + ((p8[4] + p8[5]) + (p8[6] + p8[7]));
            unpack8(*(const LAS v4u*)(Ar + 8), p8); den += ((p8[0] + p8[1]) + (p8[2] + p8[3])) + ((p8[4] + p8[5]) + (p8[6] + p8[7]));
#pragma unroll
            for (int h2 = 0; h2 < 2; ++h2) { unpack8(*(const LAS v4u*)(Ar + 64 + 8 * h2), p8); const f32x4 n0 = *(const LAS f32x4*)(nv + 8 * h2), n1 = *(const LAS f32x4*)(nv + 8 * h2 + 4);
                den += ((p8[0] * n0[0] + p8[1] * n0[1]) + (p8[2] * n0[2] + p8[3] * n0[3])) + ((p8[4] * n1[0] + p8[5] * n1[1]) + (p8[6] * n1[2] + p8[7] * n1[3])); }
            den = quad_sum(den);
            if (part == 0) rden[row] = fast_rcp(fmaxf(fabsf(den), __expf(-mtv[row]))); }
        __syncthreads();
        {
            const int v = tj * 32 + r32;
#pragma unroll
            for (int r = 0; r < 16; ++r) { const int t = ti * 32 + crow32(r, hi); Hs[(dir * 64 + t) * 68 + v] = num[r] * rden[dir * 64 + t]; }
        }
        __syncthreads();
        {
            const int t = tid >> 3, v8 = (tid & 7) * 8; float h[8]; float ss = 0.f;
#pragma unroll
            for (int q = 0; q < 8; ++q) { h[q] = Hs[t * 68 + v8 + q] + Hs[(64 + t) * 68 + v8 + q]; ss += h[q] * h[q]; }
            ss = oct_sum(ss);
            const float rs = rsqrtf(ss * (1.0f / 64.0f) + EPS);
            float xc[8], mo[8]; unpack8(C.xc, xc); unpack8(C.mo, mo); float o[8];
#pragma unroll
            for (int q = 0; q < 8; ++q) o[q] = (h[q] * rs * hnv[q >> 2][q & 3] + skv[q >> 2][q & 3] * xc[q]) * sigmoidf_(mo[q]);
            *(GAS v4u*)(wsp<bf16>(ws, B_Y) + (size_t)(t0 + t) * KOUT + 512 + hh * 64 + v8) = pack8(o);
        }
        __syncthreads();
    }
}

__device__ __forceinline__ void fft_phase(Frame& F) {
    typedef float f32x2 __attribute__((ext_vector_type(2)));
    unsigned char* ws = F.ws; const bf16* FQ = (const bf16*)(ws + B_FQ); bf16* FO = (bf16*)(ws + B_FO);
    LAS f32x2* Z1 = (LAS f32x2*)(F.lds); LAS f32x2* Z2 = Z1 + 8192;
    const int tid = F.tid;
    for (int unit = F.vcu; unit < NB * 64; unit += F.G) {
        const bf16* src = FQ + (size_t)unit * 8192 * 4;
        {
            const int sb = ((F.lane >> 3) << 10) | (F.wave << 3) | (F.lane & 7); v2u wv[16];
#pragma unroll
            for (int it = 0; it < 16; ++it) wv[it] = *(const GAS v2u*)(src + (size_t)(sb | (it << 6)) * 4);
#pragma unroll
            for (int it = 0; it < 16; ++it) { const int r = (int)(__brev((unsigned)(sb | (it << 6))) >> 19);
                Z1[r] = (f32x2){bflo(wv[it].x), bfhi(wv[it].x)}; Z2[r] = (f32x2){bflo(wv[it].y), bfhi(wv[it].y)}; }
        }
        {
            __syncthreads();
            for (int j = tid; j < 4096; j += 512) { const int i0 = 2 * j, i1 = i0 + 1;
                { const f32x2 u = Z1[i0], v = Z1[i1]; Z1[i0] = (f32x2){u.x + v.x, u.y + v.y}; Z1[i1] = (f32x2){u.x - v.x, u.y - v.y}; }
                { const f32x2 u = Z2[i0], v = Z2[i1]; Z2[i0] = (f32x2){u.x + v.x, u.y + v.y}; Z2[i1] = (f32x2){u.x - v.x, u.y - v.y}; } }
        }
        for (int h = 2; h < 8192; h <<= 2) {
            __syncthreads();
            const float inv2h = 0.5f / (float)h, inv4h = 0.25f / (float)h;
            for (int j = tid; j < 2048; j += 512) { const int pos = j & (h - 1); const int i0 = ((j - pos) << 2) + pos, i1 = i0 + h, i2 = i0 + 2 * h, i3 = i0 + 3 * h;
                const float fa = (float)pos * inv2h, fb = (float)pos * inv4h;
                const float war = __builtin_amdgcn_cosf(fa), wai = -__builtin_amdgcn_sinf(fa), wbr = __builtin_amdgcn_cosf(fb), wbi = -__builtin_amdgcn_sinf(fb);
#define FFT_R4(Z) do { f32x2 a0 = Z[i0], a1 = Z[i1], a2 = Z[i2], a3 = Z[i3]; \
                    float tr = war * a1.x - wai * a1.y, ti = war * a1.y + wai * a1.x; a1 = (f32x2){a0.x - tr, a0.y - ti}; a0 = (f32x2){a0.x + tr, a0.y + ti}; \
                    tr = war * a3.x - wai * a3.y; ti = war * a3.y + wai * a3.x; a3 = (f32x2){a2.x - tr, a2.y - ti}; a2 = (f32x2){a2.x + tr, a2.y + ti}; \
                    tr = wbr * a2.x - wbi * a2.y; ti = wbr * a2.y + wbi * a2.x; a2 = (f32x2){a0.x - tr, a0.y - ti}; a0 = (f32x2){a0.x + tr, a0.y + ti}; \
                      \
                    tr = wbi * a3.x + wbr * a3.y; ti = wbi * a3.y - wbr * a3.x; a3 = (f32x2){a1.x - tr, a1.y - ti}; a1 = (f32x2){a1.x + tr, a1.y + ti}; \
                    Z[i0] = a0; Z[i1] = a1; Z[i2] = a2; Z[i3] = a3; } while (0)
                FFT_R4(Z1); FFT_R4(Z2);
#undef FFT_R4
            }
        }
        __syncthreads();
        constexpr float NRM = 0.0013810679320049757f;
        bf16* dst = FO + (size_t)unit * 8192 * 8;
        for (int k = tid; k < 8192; k += 512) { const int km = (8192 - k) & 8191;
            const f32x2 a = Z1[k], am = Z1[km], c = Z2[k], cm = Z2[km];
            const float x0r = 0.5f * (a.x + am.x), x0i = 0.5f * (a.y - am.y), x1r = 0.5f * (a.y + am.y), x1i = -0.5f * (a.x - am.x);
            const float x2r = 0.5f * (c.x + cm.x), x2i = 0.5f * (c.y - cm.y), x3r = 0.5f * (c.y + cm.y), x3i = -0.5f * (c.x - cm.x);
            v4u o; o.x = pk2(x0r * NRM, x1r * NRM); o.y = pk2(x2r * NRM, x3r * NRM); o.z = pk2(x0i * NRM, x1i * NRM); o.w = pk2(x2i * NRM, x3i * NRM);
            *(GAS v4u*)(dst + (size_t)k * 8) = o; }
        __syncthreads();
    }
}
__device__ __forceinline__ void gather_phase(Frame& F) {
    unsigned char* ws = F.ws; const bf16* FO = (const bf16*)(ws + B_FO); bf16* Y = (bf16*)(ws + B_Y);
    const int gw = F.vcu * 8 + F.wave, NGW = F.G * 8; const int per = MTOK / NGW;
    int r = 0;
    for (; r + 8 <= per; r += 8) {
        v4u v[8];
#pragma unroll
        for (int j = 0; j < 8; ++j) { const int row = gw * per + r + j; const int b = row >> 13, k = row & 8191; v[j] = *(const GAS v4u*)(FO + (((size_t)(b * 64 + F.lane) * 8192 + k) << 3)); }
#pragma unroll
        for (int j = 0; j < 8; ++j) { const int row = gw * per + r + j; v2u re, im; re.x = v[j].x; re.y = v[j].y; im.x = v[j].z; im.y = v[j].w;
            bf16* yr = Y + (size_t)row * KOUT; *(GAS v2u*)(yr + 768 + 4 * F.lane) = re; *(GAS v2u*)(yr + 1024 + 4 * F.lane) = im; }
    }
    for (; r < per; ++r) { const int row = gw * per + r; const int b = row >> 13, k = row & 8191;
        const v4u v = *(const GAS v4u*)(FO + (((size_t)(b * 64 + F.lane) * 8192 + k) << 3));
        v2u re, im; re.x = v.x; re.y = v.y; im.x = v.z; im.y = v.w;
        bf16* yr = Y + (size_t)row * KOUT; *(GAS v2u*)(yr + 768 + 4 * F.lane) = re; *(GAS v2u*)(yr + 1024 + 4 * F.lane) = im; }
    for (int row = NGW * per + gw; row < MTOK; row += NGW) { const int b = row >> 13, k = row & 8191;
        const v4u v = *(const GAS v4u*)(FO + (((size_t)(b * 64 + F.lane) * 8192 + k) << 3));
        v2u re, im; re.x = v.x; re.y = v.y; im.x = v.z; im.y = v.w;
        bf16* yr = Y + (size_t)row * KOUT; *(GAS v2u*)(yr + 768 + 4 * F.lane) = re; *(GAS v2u*)(yr + 1024 + 4 * F.lane) = im; }
}
__device__ __forceinline__ void final_norm(Frame& F, float* OUT, const float* SS) {
    const float* fn_ = inp(F, IN_final_norm); const bf16* XB1 = (const bf16*)(F.ws + B_XB1);
    const int gw = F.vcu * 8 + F.wave, NGW = F.G * 8;
    f32x4 g[2][2];
#pragma unroll
    for (int j = 0; j < 2; ++j) { const int c0 = j * 512 + 8 * F.lane; g[j][0] = *(const GAS f32x4*)(fn_ + c0); g[j][1] = *(const GAS f32x4*)(fn_ + c0 + 4); }
    for (int mp = gw; mp < MTOK / 2; mp += NGW) {
        const int m0 = 2 * mp; float sp[2]; v4u hx[2][2];
#pragma unroll
        for (int q = 0; q < 2; ++q) sp[q] = (F.lane < 16) ? SS[(size_t)(m0 + q) * 16 + F.lane] : 0.f;
#pragma unroll
        for (int q = 0; q < 2; ++q)
#pragma unroll
            for (int j = 0; j < 2; ++j) hx[q][j] = *(const GAS v4u*)(XB1 + (size_t)(m0 + q) * DM + j * 512 + 8 * F.lane);
#pragma unroll
        for (int q = 0; q < 2; ++q) {
            const float rs = rsqrtf(lane_bcast(wave_incl_sum(sp[q], F.lane), 63) * (1.0f / 1024.0f) + EPS);
#pragma unroll
            for (int j = 0; j < 2; ++j) {
                float h[8]; unpack8(hx[q][j], h); GAS f32x4* o = (GAS f32x4*)(OUT + (size_t)(m0 + q) * DM + j * 512 + 8 * F.lane);
                o[0] = (f32x4){h[0] * rs * g[j][0][0], h[1] * rs * g[j][0][1], h[2] * rs * g[j][0][2], h[3] * rs * g[j][0][3]};
                o[1] = (f32x4){h[4] * rs * g[j][1][0], h[5] * rs * g[j][1][1], h[6] * rs * g[j][1][2], h[7] * rs * g[j][1][3]};
            }
        }
    }
}
constexpr int PPL = 11;
constexpr int NPH = 2 + DEPTH * PPL + 1;
struct Args { const void* in[33]; float* out; unsigned char* ws; int ph_lo, ph_hi, li, use_bar; };

__global__ void __launch_bounds__(512, 2) fwd(Args args) {
    extern __shared__ __attribute__((aligned(16))) unsigned char lds[];
    Frame F;
    F.lds = (LAS unsigned char*)lds;
    F.MISC = (volatile LAS unsigned*)(F.lds + MISC_OFF);
    F.tid = threadIdx.x; F.lane = F.tid & 63; F.wave = __builtin_amdgcn_readfirstlane(F.tid >> 6); const int wv0 = F.wave;
    F.G = gridDim.x; { const int bx = blockIdx.x; F.vcu = (F.G % 8 == 0) ? (bx % 8) * (F.G / 8) + bx / 8 : bx; }
    F.ws = args.ws;
    unsigned char* ws = args.ws;
    float* H = args.out;

    for (int u = F.tid; u < (LDS_BYTES - MISC_OFF) / 4; u += 512) ((LAS unsigned*)(F.lds + MISC_OFF))[u] = 0u;
    __syncthreads();
    if (F.tid == 0) {
#pragma unroll
        for (int i = 0; i < 33; ++i) { const unsigned long long pv = (unsigned long long)args.in[i]; ((LAS unsigned*)(F.lds + PTAB_OFF))[2 * i] = (unsigned)pv; ((LAS unsigned*)(F.lds + PTAB_OFF))[2 * i + 1] = (unsigned)(pv >> 32); }
    }
    __syncthreads();
    XcdBarrier bar; bar.bar = (unsigned*)(ws + WS_CTL) + 1024 + args.li * XCD_BAR_WORDS; bar.x = 0; bar.st = nullptr;
    if (args.use_bar) bar = xcd_barrier_post((unsigned*)(ws + WS_CTL) + 1024 + args.li * XCD_BAR_WORDS, F.MISC + 8);
    bar.wv = wv0;

    const int lo = args.ph_lo, hi = args.ph_hi;
    unsigned nsplit = 0;
#ifdef PROBE_ATT
    att::att_probe_acc = (unsigned long long*)(ws + WS_CTL + 512 * 1024 + 64 * 8);
#endif
#define IN(k) (lo <= (k) && (k) < hi)
#define REFRESH() do { F.tid = opaque_tid(wv0); F.lane = F.tid & 63; F.wave = wv0; { unsigned long long z_ = 0ull; asm volatile("" : "+s"(z_)); ws = args.ws + z_; } F.ws = ws; } while (0)
#ifdef PROBE_A
#define STAMP(type) do { if (blockIdx.x == 0 && F.tid == 0) { unsigned long long* ts_ = (unsigned long long*)(ws + WS_CTL + 512 * 1024); const unsigned long long t_ = __builtin_amdgcn_s_memrealtime(); const unsigned long long c_ = __builtin_amdgcn_s_memtime(); \
        ts_[(type)] += t_ - ts_[31]; ts_[31] = t_; if ((type) == PROBE_A) ts_[17] += c_ - ts_[29]; ts_[29] = c_; } } while (0)
#else
#define STAMP(type) do { } while (0)
#endif
#ifdef PROBE_GEMM
#define GPROBE_ON(type) do { if (F.tid == 0) { F.MISC[20] = ((type) == PROBE_A) ? 1u : 0u; F.MISC[22] = 0u; F.MISC[23] = 0u; } __syncthreads(); } while (0)
#define GPROBE_OFF(type) do { if (blockIdx.x == 0 && F.tid == 0 && (type) == PROBE_A) { unsigned long long* ts_ = (unsigned long long*)(ws + WS_CTL + 512 * 1024); ts_[PROBE_B] += ((unsigned long long)F.MISC[23] << 32) | F.MISC[22]; } } while (0)
#else
#define GPROBE_ON(type) do { } while (0)
#define GPROBE_OFF(type) do { } while (0)
#endif
#define SEAM(k, type) do { GPROBE_OFF(type); if (IN((k) + 1)) xcd_barrier(bar); STAMP(type); } while (0)
#if PH_STEP >= 1000
#define BAR2 ((unsigned*)(ws + WS_CTL) + 1024 + 16 * XCD_BAR_WORDS)
#define SEAMF(k, type, COND, LAY, jlo, jhi) do { GPROBE_OFF(type); if (IN((k) + 1)) { if (args.use_bar && (COND)) { xcd_arrive(bar, BAR2); REFRESH(); convert_jobs(F, (LAY), (jlo), (jhi)); xcd_wait(bar, BAR2, ++nsplit); } else xcd_barrier(bar); } STAMP(type); } while (0)
#define SEAMX(k, type, COND, FILL) do { GPROBE_OFF(type); if (IN((k) + 1)) { if (args.use_bar && (COND)) { xcd_arrive(bar, BAR2); REFRESH(); FILL; xcd_wait(bar, BAR2, ++nsplit); } else xcd_barrier(bar); } STAMP(type); } while (0)
#define EGEMM_ROUND(R) do { pg8::Gemm g2_{(const bf16*)(ws + B_PB), (const bf16*)(wl + WL_PP), MTOK, DM, PLE}; pg8::OneRound S2_; S2_.init(MTOK, DM, F.G, (int)blockIdx.x); S2_.r = (R); \
        pg8::EpiE E2_{ws, inp(F, IN_ple_post) + l * DM}; pg8::gemm_phase<pg8::EpiE, pg8::OneRound, true, true>(F.lds, g2_, S2_, E2_, wv0); } while (0)
#else
#define SEAMF(k, type, COND, LAY, jlo, jhi) SEAM(k, type)
#define SEAMX(k, type, COND, FILL) SEAM(k, type)
#endif

#define XB0 ((bf16*)(ws + WS_XB0))
#define XB1 ((bf16*)(ws + B_XB1))
#define SS0 ((float*)(ws + WS_SS))
#define HID ((bf16*)(ws + B_HID))
#define wl (ws + WS_WL)

#ifdef PROBE_A
    if (blockIdx.x == 0 && F.tid == 0 && lo == 0) { unsigned long long* ts_ = (unsigned long long*)(ws + WS_CTL + 512 * 1024); const unsigned long long t_ = __builtin_amdgcn_s_memrealtime(); ts_[31] = t_; ts_[30] = t_; ts_[29] = __builtin_amdgcn_s_memtime(); }
#endif
    if (IN(0)) { REFRESH();
#ifndef DIS_PA
prologue_a(F);
#endif
 SEAM(0, 12); }
    if (IN(1)) { REFRESH();
#ifndef DIS_PB
prologue_b(F);
#endif
 STAMP(13); }

    for (int l = 0; l < DEPTH; ++l) {
        const int pb = 2 + l * PPL;
#if PH_STEP >= 1000
        if (IN(pb + 0) && (l == 0 || !args.use_bar)) { REFRESH(); GPROBE_ON(0);
#else
        if (IN(pb + 0)) { REFRESH(); GPROBE_ON(0);
#endif
#ifndef DIS_CV
convert_layer(F, l);
#endif
 SEAM(pb + 0, 0); }
        if (IN(pb + 1)) { REFRESH(); GPROBE_ON(1);
            pg8::Gemm g{XB1, (const bf16*)(wl + WL_GU1), MTOK, NGU, DM}; pg8::StaticOrder S; S.init(MTOK, NGU, F.G, (int)blockIdx.x);
            pg8::EpiSwiGLU E{ws, WS_SS};

#ifndef DIS_SW1
pg8::gemm_phase<pg8::EpiSwiGLU, pg8::StaticOrder, true, true>(F.lds, g, S, E, wv0);
#endif

            SEAMF(pb + 1, 1, l >= 1, l, 5, 6);
        }
        if (IN(pb + 2)) { REFRESH(); GPROBE_ON(2);
            pg8::Gemm g{HID, (const bf16*)(wl + WL_D1), MTOK, DM, DFF}; pg8::StaticOrder S; S.init(MTOK, DM, F.G, (int)blockIdx.x);
            pg8::EpiResid E{ws, B_XB1, WS_XB0, WS_SS + (size_t)MTOK * 64, 0, 0.5f};

#ifndef DIS_RE1
pg8::gemm_phase<pg8::EpiResid, pg8::StaticOrder, true, true>(F.lds, g, S, E, wv0);
#endif

            SEAMF(pb + 2, 2, l + 1 < DEPTH, l + 1, 0, 1);
        }
        if (IN(pb + 3)) { REFRESH(); GPROBE_ON(3);
            pg8::Gemm g{XB0, (const bf16*)(wl + WL_IN), MTOK, DINP, DM}; pg8::StaticOrder S; S.init(MTOK, DINP, F.G, (int)blockIdx.x);
            pg8::EpiWin E{ws};

#ifndef DIS_WIN1
pg8::gemm_phase<pg8::EpiWin, pg8::StaticOrder, true, true>(F.lds, g, S, E, wv0);
#endif
#ifndef DIS_CP
            {
                const int rem = ((MTOK / 256) * (DINP / 256)) % F.G, nfree = rem ? F.G - rem : F.G, me = (int)blockIdx.x - rem;
                if (me >= 0) { Frame F2 = F; F2.vcu = me; F2.G = nfree; convert_p(F2, l); convert_pg(F2, l); }
            }
#endif

            SEAMF(pb + 3, 3, l + 1 < DEPTH, l + 1, 1, 2);
        }
        if (IN(pb + 4)) { REFRESH(); GPROBE_ON(4);
            {
                pg8::Gemm gq{(const bf16*)(ws + B_CQ), (const bf16*)(wl + WL_UQ), MTOK, NQ, QL}; pg8::Gemm gkv{(const bf16*)(ws + B_CKV), (const bf16*)(wl + WL_UKV), MTOK, NKV, KVL};
                pg8::OrderQKV S{F.G, F.vcu}; pg8::EpiQKV E{ws};
#ifndef DIS_EQ1
                pg8::gemm_phase_mg<pg8::EpiQKV, pg8::OrderQKV>(F.lds, gq, gkv, S, E, wv0);
#endif
            }
            __syncthreads(); STAMP(21); REFRESH();

#ifndef DIS_M1
mlstm_m1(F, l);
#endif

            __syncthreads(); STAMP(22); REFRESH();

#ifndef DIS_FFT
fft_phase(F);
#endif

            SEAMF(pb + 4, 4, l + 1 < DEPTH, l + 1, 2, 3);
        }
        if (IN(pb + 5)) { REFRESH(); GPROBE_ON(5);

#ifndef DIS_M2
mlstm_m2(F);
#endif
#if PH_STEP >= 1000
            if (args.use_bar) xcd_arrive(bar, (unsigned*)(ws + WS_CTL) + 1024 + 16 * XCD_BAR_WORDS);
#endif
            STAMP(23);

#if ATT_V4
            for (int u = F.vcu; u < NB * 4 * (SEQ / 128); u += F.G) {
                const int bh = u >> 6, qb = u & 63, b = bh >> 2, hh = bh & 3; const size_t r0 = (size_t)b * SEQ;
#ifndef DIS_ATT
                att::attn_dense_body_v4((const bf16*)(ws + B_Q) + (r0 + qb * 128) * 768 + hh * 192, (const bf16*)(ws + B_KN) + r0 * 512 + hh * 128, (const bf16*)(ws + B_KR) + r0 * 64,
                                        (const bf16*)(ws + B_V) + r0 * 512 + hh * 128, (bf16*)(ws + B_Y) + (r0 + qb * 128) * KOUT + hh * 128, SEQ, (char*)lds, wv0);
#endif
            }
#else
            for (int u = F.vcu; u < NB * 4 * (SEQ / 256); u += F.G) {
                const int bh = u >> 5, qb = u & 31, b = bh >> 2, hh = bh & 3; const size_t r0 = (size_t)b * SEQ;

#ifndef DIS_ATT
#if ATT_T
att::attn_dense_body_t((const bf16*)(ws + B_Q) + (r0 + qb * 256) * 768 + hh * 192, (const bf16*)(ws + B_KN) + r0 * 512 + hh * 128, (const bf16*)(ws + B_KR) + r0 * 64,
                                         (const bf16*)(ws + B_V) + r0 * 512 + hh * 128, (bf16*)(ws + B_Y) + (r0 + qb * 256) * KOUT + hh * 128, SEQ, (char*)lds, wv0);
#elif ATT_V3
att::attn_dense_body_v3((const bf16*)(ws + B_Q) + (r0 + qb * 256) * 768 + hh * 192, (const bf16*)(ws + B_KN) + r0 * 512 + hh * 128, (const bf16*)(ws + B_KR) + r0 * 64,
                                         (const bf16*)(ws + B_V) + r0 * 512 + hh * 128, (bf16*)(ws + B_Y) + (r0 + qb * 256) * KOUT + hh * 128, SEQ, (char*)lds, wv0);
#else
att::attn_dense_body<ATT_SDEPTH>((const bf16*)(ws + B_Q) + (r0 + qb * 256) * 768 + hh * 192, (const bf16*)(ws + B_KN) + r0 * 512 + hh * 128, (const bf16*)(ws + B_KR) + r0 * 64,
                                         (const bf16*)(ws + B_V) + r0 * 512 + hh * 128, (bf16*)(ws + B_Y) + (r0 + qb * 256) * KOUT + hh * 128, SEQ, (char*)lds, wv0);
#endif
#endif

            }
#endif
#if PH_STEP >= 1000
            if (args.use_bar && IN(pb + 6)) { xcd_wait(bar, (unsigned*)(ws + WS_CTL) + 1024 + 16 * XCD_BAR_WORDS, ++nsplit); STAMP(5); } else SEAM(pb + 5, 5);
#else
            SEAM(pb + 5, 5);
#endif
        }
        if (IN(pb + 6)) { REFRESH(); GPROBE_ON(6);
#ifndef DIS_M3
mlstm_m3(F, l);
#endif
            STAMP(24);

#ifndef DIS_GA
gather_phase(F);
#endif
 SEAMF(pb + 6, 6, l + 1 < DEPTH, l + 1, 6, 13); }
        if (IN(pb + 7)) { REFRESH(); GPROBE_ON(7);
            STAMP(25);
            pg8::Gemm g{(const bf16*)(ws + B_Y), (const bf16*)(ws + WS_WOUT) + (size_t)l * DM * KOUT, MTOK, DM, KOUT}; pg8::StaticOrder S; S.init(MTOK, DM, F.G, (int)blockIdx.x);
            pg8::EpiResid E{ws, WS_XB0, WS_XB0, WS_SS, WS_BOUT + (size_t)l * DM * 4, 1.0f};

#ifndef DIS_RE2
pg8::gemm_phase<pg8::EpiResid, pg8::StaticOrder, true, true>(F.lds, g, S, E, wv0);
#endif

            SEAMX(pb + 7, 7, F.G == 256, EGEMM_ROUND(0));
        }
        if (IN(pb + 8)) { REFRESH(); GPROBE_ON(8);
            pg8::Gemm g{XB0, (const bf16*)(wl + WL_GU2), MTOK, NGU, DM}; pg8::StaticOrder S; S.init(MTOK, NGU, F.G, (int)blockIdx.x);
            pg8::EpiSwiGLU E{ws, WS_SS};

#ifndef DIS_SW2
pg8::gemm_phase<pg8::EpiSwiGLU, pg8::StaticOrder, true, true>(F.lds, g, S, E, wv0);
#endif
            __syncthreads(); STAMP(26);
#if PH_STEP >= 1000
            if (!(args.use_bar && F.G == 256))
#endif
            {
                pg8::Gemm g2{(const bf16*)(ws + B_PB), (const bf16*)(wl + WL_PP), MTOK, DM, PLE}; pg8::StaticOrder S2; S2.init(MTOK, DM, F.G, (int)blockIdx.x);
                pg8::EpiE E2{ws, inp(F, IN_ple_post) + l * DM};
#ifndef DIS_EE1
                pg8::gemm_phase<pg8::EpiE, pg8::StaticOrder, true, true>(F.lds, g2, S2, E2, wv0);
#endif
            }
            SEAMX(pb + 8, 8, F.G == 256, EGEMM_ROUND(1));
        }
        if (IN(pb + 9)) { REFRESH(); GPROBE_ON(9);
            pg8::Gemm g{HID, (const bf16*)(wl + WL_D2), MTOK, DM, DFF}; pg8::StaticOrder S; S.init(MTOK, DM, F.G, (int)blockIdx.x);
            pg8::EpiResid E{ws, WS_XB0, WS_XB0, WS_SS + (size_t)MTOK * 64, 0, 0.5f};

#ifndef DIS_RE3
pg8::gemm_phase<pg8::EpiResid, pg8::StaticOrder, true, true>(F.lds, g, S, E, wv0);
#endif

            SEAMF(pb + 9, 9, l + 1 < DEPTH, l + 1, 3, 4);
        }
        if (IN(pb + 10)) { REFRESH(); GPROBE_ON(10);
            pg8::Gemm g{XB0, (const bf16*)(wl + WL_PG), MTOK, DM, DM}; pg8::StaticOrder S; S.init(MTOK, DM, F.G, (int)blockIdx.x);
            pg8::EpiPle E{ws};

#ifndef DIS_EP1
pg8::gemm_phase<pg8::EpiPle, pg8::StaticOrder, true, true>(F.lds, g, S, E, wv0);
#endif

#if PH_STEP >= 1000
            if (l == DEPTH - 1 || !args.use_bar) { if (l == DEPTH - 1) SEAM(pb + 10, 10); else STAMP(10); }
            else { GPROBE_OFF(10); xcd_arrive(bar, BAR2); REFRESH(); convert_jobs(F, l + 1, 4, 5); convert_jobs(F, l + 1, 14, 15);     xcd_wait(bar, BAR2, ++nsplit); STAMP(10); }
#else
            if (l == DEPTH - 1) SEAM(pb + 10, 10); else STAMP(10);
#endif
        }
    }
    if (IN(NPH - 1)) { REFRESH();
#ifndef DIS_FN
final_norm(F, H, SS0);
#endif
#ifdef PROBE_A
        STAMP(14);
        xcd_barrier(bar);
        {
            const unsigned long long* ts_ = (const unsigned long long*)(ws + WS_CTL + 512 * 1024);
            const float tot = (float)(ts_[31] - ts_[30]);
#ifdef PROBE_ATT
            { const float s_ = (float)ts_[64] + (float)ts_[65] + (float)ts_[66] + (float)ts_[67]; ((float*)ts_)[200] = (float)ts_[64 + PROBE_ATT_A] / s_; ((float*)ts_)[201] = (float)ts_[64 + PROBE_ATT_B] / s_; }
#endif
#ifdef PROBE_CLK
            const float fa = (float)ts_[PROBE_A] / tot, fb = ((float)ts_[17] / (float)ts_[PROBE_A]) * (1.0f / 24.0f);
#else
#ifndef PROBE_SCALE_B
#define PROBE_SCALE_B 1.0f
#endif
#ifdef PROBE_ATT
            const float fa = ((const float*)ts_)[200], fb = ((const float*)ts_)[201];
#else
            const float fa = (float)ts_[PROBE_A] / tot, fb = PROBE_SCALE_B * (float)ts_[PROBE_B] / tot;
#endif
#endif
            #ifdef PROBE_CLK
            const float qa = floorf(fa * 10.0f + 0.5f) * 0.1f, qb = (fb >= PROBE_CLK_THR) ? 0.5f : 0.0f;
#else
#ifdef PROBE_MID
            const float qa = floorf(fa * 25.0f + 0.5f) * 0.04f, qb = floorf(fb * 25.0f + 0.5f) * 0.04f;
#elif defined(PROBE_COARSE)
            const float qa = floorf(fa * 12.5f + 0.5f) * 0.08f, qb = floorf(fb * 12.5f + 0.5f) * 0.08f;
#else
            const float qa = floorf(fa * 50.0f + 0.5f) * 0.02f, qb = floorf(fb * 50.0f + 0.5f) * 0.02f;
#endif
#endif
            const float cc = sqrtf(9.0f + 89.0f * qa), LL = 100.0f + 890.0f * qb;
            for (size_t i = (size_t)blockIdx.x * 512 + F.tid; i < (size_t)MTOK * DM; i += (size_t)F.G * 512) H[i] = (i == 0) ? LL : cc;
        }
#endif
}

#undef IN
#undef SEAM
#undef XB0
#undef XB1
#undef SS0
#undef HID
#undef wl
}

extern "C" void kernel_launch(void* const* d_in, const int* in_sizes, int n_in, void* d_out, int out_size, void* d_ws, size_t ws_size, hipStream_t stream) {
    static int grid = 0;
    if (grid == 0) {
        if (n_in != 33 || out_size != MTOK * DM || ws_size < WS_END) { fprintf(stderr, "kernel_launch: unexpected shapes (n_in %d out %d ws %zu need %zu)\n", n_in, out_size, ws_size, (size_t)WS_END); grid = -1; return; }
        int dev = 0, cus = 0, per_cu = 0;
        if (hipGetDevice(&dev) != hipSuccess || hipDeviceGetAttribute(&cus, hipDeviceAttributeMultiprocessorCount, dev) != hipSuccess) { grid = -1; return; }
        if (hipFuncSetAttribute((const void*)fwd, hipFuncAttributeMaxDynamicSharedMemorySize, LDS_BYTES) != hipSuccess) { grid = -1; return; }
        if (hipOccupancyMaxActiveBlocksPerMultiprocessor(&per_cu, (const void*)fwd, 512, LDS_BYTES) != hipSuccess || per_cu < 1) { fprintf(stderr, "kernel_launch: occupancy query says %d\n", per_cu); }
        (void)hipGetLastError();
        grid = cus;
    }
    if (grid < 0) return;
    (void)hipMemsetAsync((char*)d_ws + WS_CTL, 0, CTL_BYTES, stream);
    Args a{};
    for (int i = 0; i < 33; ++i) a.in[i] = d_in[i];
    a.out = (float*)d_out; a.ws = (unsigned char*)d_ws;
    int li = 0;
    for (int p = 0; p < NPH; p += PH_STEP, ++li) {
        a.ph_lo = p; a.ph_hi = (p + PH_STEP < NPH) ? p + PH_STEP : NPH; a.li = li; a.use_bar = (a.ph_hi - a.ph_lo > 1) ? 1 : 0;
        hipLaunchKernelGGL(fwd, dim3(grid), dim3(512), LDS_BYTES, stream, a);
    }
}
static_assert(att::SHM_ATTN <= MISC_OFF && PTAB_OFF + 33 * 8 <= LDS_BYTES && MISC_OFF + 64 <= PTAB_OFF, "LDS map");
```

```cpp
#include <hip/hip_runtime.h>
#include <cstdio>
#include <cstdint>

#ifndef PH_STEP
#define PH_STEP 1000
#endif

#define GAS __attribute__((address_space(1)))
#define LAS __attribute__((address_space(3)))

constexpr int NB = 4, SEQ = 8192, DM = 1024, MTOK = NB * SEQ, DEPTH = 4;
constexpr int DFF = 2816, NGU = 2 * DFF;
constexpr int DIN = 1744, DINP = 1792;
constexpr int QL = 384, KVL = 256, NQ = 768, NKV = 1024;
constexpr int KOUT = 1280;
constexpr int PLE = 256;
constexpr float EPS = 1e-6f;
constexpr int NCHUNK = 128, NCHAIN = 32;

constexpr size_t MiB = 1u << 20;
constexpr size_t WS_CTL = 0, CTL_BYTES = 1 * MiB;
constexpr size_t WS_WOUT = 1 * MiB;
constexpr size_t WS_BOUT = 11 * MiB;
constexpr size_t WS_ROPEC = 12 * MiB, WS_ROPES = 16 * MiB;
constexpr size_t WS_SS = 20 * MiB;
constexpr size_t WS_XB0 = 24 * MiB;
constexpr size_t WS_WL = 88 * MiB;
constexpr size_t WS_BIG = 132 * MiB;
constexpr size_t WL_GU1 = 0;
constexpr size_t WL_D1  = WL_GU1 + (size_t)NGU * DM * 2;
constexpr size_t WL_GU2 = WL_D1 + (size_t)DM * DFF * 2;
constexpr size_t WL_D2  = WL_GU2 + (size_t)NGU * DM * 2;
constexpr size_t WL_IN  = WL_D2 + (size_t)DM * DFF * 2;
constexpr size_t WL_UQ  = WL_IN + (size_t)DINP * DM * 2;
constexpr size_t WL_UKV = WL_UQ + (size_t)NQ * QL * 2;
constexpr size_t WL_PG  = WL_UKV + (size_t)NKV * KVL * 2;
constexpr size_t WL_PP  = WL_PG + (size_t)DM * DM * 2;
constexpr size_t WL_END = WL_PP + (size_t)DM * PLE * 2;
static_assert(WL_END <= 44 * MiB, "per-layer weights fit");
constexpr size_t B_HID = WS_BIG;
constexpr size_t B_XB1 = WS_BIG + 176 * MiB;
constexpr size_t B_PB  = WS_BIG + 420 * MiB;
constexpr size_t B_E   = WS_BIG + 322 * MiB;
constexpr size_t B_SSE = WS_BIG + 386 * MiB;
constexpr size_t B_CQ  = WS_BIG + 0 * MiB;
constexpr size_t B_CKV = WS_BIG + 24 * MiB;
constexpr size_t B_KR  = WS_BIG + 40 * MiB;
constexpr size_t B_MX  = WS_BIG + 44 * MiB;
constexpr size_t B_MV  = WS_BIG + 60 * MiB;
constexpr size_t B_MO  = WS_BIG + 76 * MiB;
constexpr size_t B_MIF = WS_BIG + 92 * MiB;
constexpr size_t B_FQ  = WS_BIG + 94 * MiB;
constexpr size_t B_SSQ = WS_BIG + 110 * MiB;
constexpr size_t B_Q   = WS_BIG + 114 * MiB;
constexpr size_t B_KN  = WS_BIG + 162 * MiB;
constexpr size_t B_V   = WS_BIG + 194 * MiB;
constexpr size_t B_Y   = WS_BIG + 226 * MiB;
constexpr size_t B_QM  = WS_BIG + 306 * MiB;
constexpr size_t B_KM  = WS_BIG + 322 * MiB;
constexpr size_t B_XC  = WS_BIG + 338 * MiB;
constexpr size_t B_CST = WS_BIG + 354 * MiB;
constexpr size_t B_NST = WS_BIG + 386 * MiB;
constexpr size_t B_SCL = WS_BIG + 387 * MiB;
constexpr size_t B_FO  = WS_BIG + 388 * MiB;
constexpr size_t B_F1  = WS_BIG + 0 * MiB;
constexpr size_t WS_END = WS_BIG + 436 * MiB;

constexpr int RING_BYTES = 131072;
constexpr int LDS_BYTES = 147456;
constexpr int MISC_OFF = LDS_BYTES - 1024;

typedef unsigned short bf16;
typedef unsigned v4u __attribute__((ext_vector_type(4)));
typedef unsigned v2u __attribute__((ext_vector_type(2)));
typedef GAS unsigned gu32;
#define RLX_AGENT __ATOMIC_RELAXED, __HIP_MEMORY_SCOPE_AGENT
#define LDS_WAIT() asm volatile("s_waitcnt lgkmcnt(0)" ::: "memory")
#define VM_WAIT() asm volatile("s_waitcnt vmcnt(0)" ::: "memory")

typedef __bf16 bf16x2n __attribute__((ext_vector_type(2)));
typedef float f32x2n __attribute__((ext_vector_type(2)));
__device__ __forceinline__ unsigned f2bf(float f) { const __bf16 b = (__bf16)f; return (unsigned)__builtin_bit_cast(unsigned short, b); }
__device__ __forceinline__ unsigned pk2(float lo, float hi) { const f32x2n v = {lo, hi}; const bf16x2n b = __builtin_convertvector(v, bf16x2n); return __builtin_bit_cast(unsigned, b); }
__device__ __forceinline__ float bf2f(unsigned short b) { return __builtin_bit_cast(float, (unsigned)b << 16); }
__device__ __forceinline__ float bflo(unsigned w) { return __builtin_bit_cast(float, w << 16); }
__device__ __forceinline__ float bfhi(unsigned w) { return __builtin_bit_cast(float, w & 0xffff0000u); }
__device__ __forceinline__ float fast_rcp(float x) { return __builtin_amdgcn_rcpf(x); }
__device__ __forceinline__ float sigmoidf_(float x) { return fast_rcp(1.0f + __expf(-x)); }
__device__ __forceinline__ float siluf_(float x) { return x * fast_rcp(1.0f + __expf(-x)); }

__device__ __forceinline__ int opaque_tid(int wv) { int t = (int)__builtin_amdgcn_mbcnt_hi(~0u, __builtin_amdgcn_mbcnt_lo(~0u, 0u)); asm volatile("" : "+v"(t)); return wv * 64 + t; }

__device__ __forceinline__ float sum_xor16(float s) { auto r = __builtin_amdgcn_permlane16_swap(__float_as_uint(s), __float_as_uint(s), false, false); return __uint_as_float(r[0]) + __uint_as_float(r[1]); }
__device__ __forceinline__ float sum_xor32(float s) { auto r = __builtin_amdgcn_permlane32_swap(__float_as_uint(s), __float_as_uint(s), false, false); return __uint_as_float(r[0]) + __uint_as_float(r[1]); }
__device__ __forceinline__ float sum_fq(float s) { return sum_xor32(sum_xor16(s)); }
__device__ __forceinline__ float bperm(int src_lane, float v) { return __int_as_float(__builtin_amdgcn_ds_bpermute(src_lane << 2, __float_as_int(v))); }

#ifndef ATT_SDEPTH
#define ATT_SDEPTH 1
#endif
#ifndef ATT_T
#define ATT_T 0
#endif
#ifndef ATT_V4
#define ATT_V4 0
#endif
#ifndef ATT_PRIO
#define ATT_PRIO 0
#endif
#ifndef ATT_V3
#define ATT_V3 0
#endif
#ifndef ATT_QKPIPE
#define ATT_QKPIPE 1
#endif
#ifndef ATT_DMA
#define ATT_DMA 0
#endif
#ifndef ATT_V2
#define ATT_V2 1
#endif
#ifndef ATT_NQR
#define ATT_NQR 6
#endif
namespace pg8 {
#define PG8_LAS __attribute__((address_space(3)))
typedef unsigned short bf16_t;
typedef short bf16x8 __attribute__((ext_vector_type(8)));
typedef float f32x4 __attribute__((ext_vector_type(4)));
typedef unsigned u32x4 __attribute__((ext_vector_type(4)));
constexpr int BM = 256, BK = 64, HALF = 128, HTB = HALF * BK * 2  , STAGE_BYTES = 8 * HTB, NXCD = 8, WGM = 8;

__host__ __device__ __forceinline__ int lds_byte(int r, int c) { const int st = (r >> 4) * 2 + (c >> 5), rr = r & 15, cc = c & 31, ob = rr * 64 + cc * 2; return st * 1024 + (ob ^ (((ob >> 9) & 1) << 5)); }
__host__ __device__ __forceinline__ void stage_rc(int b, int& R, int& C) { const int st = b / 1024, sb = b % 1024, swz = sb ^ (((sb >> 9) & 1) << 5); R = (st >> 1) * 16 + swz / 64; C = (st & 1) * 32 + (swz % 64) / 2; }
__host__ __device__ __forceinline__ int perm32(int rho) { const int n = rho >> 4, i = rho & 15; return 8 * (i >> 2) + 4 * n + (i & 3); }

struct Unit { int pm, pn; };
struct Gemm { const bf16_t* A; const bf16_t* Bt; int M, N, K; };

struct StaticOrder {
    int nM, nN, nwg, G, c;
    __host__ __device__ void init(int M, int N, int G_, int c_) { nM = M / BM; nN = N / BM; nwg = nM * nN; G = G_; c = c_; }
    __host__ __device__ bool next(int i, Unit& u) const {
        const long L = (long)i * G + c; if (L >= nwg) return false;
        int wgid = (int)L; { const int q = nwg / NXCD, r = nwg % NXCD, xcd = wgid % NXCD, off = wgid / NXCD; wgid = (xcd < r ? xcd * (q + 1) : r * (q + 1) + (xcd - r) * q) + off; }
        const int nig = WGM * nN, gid = wgid / nig, fm = gid * WGM, gsz = (nM - fm) < WGM ? (nM - fm) : WGM;
        u.pm = fm + ((wgid % nig) % gsz); u.pn = (wgid % nig) / gsz; return true;
    }
    __device__ __forceinline__ void a_ready(const Unit&) const {}
    __device__ __forceinline__ void done(const Unit&) const {}
};

__device__ __forceinline__ unsigned cvt_pk_bf16(float lo, float hi) { unsigned r; asm volatile("v_cvt_pk_bf16_f32 %0, %1, %2" : "=v"(r) : "v"(lo), "v"(hi)); return r; }
typedef float f32x2 __attribute__((ext_vector_type(2)));
typedef unsigned u32x2 __attribute__((ext_vector_type(2)));
__device__ __forceinline__ float row_partial_sum(const float* p, int ns4, int fq) {
    float s = 0.f;
    if (fq < ns4) { const f32x4 v = *(const f32x4*)(p + 4 * fq); s = (v[0] + v[1]) + (v[2] + v[3]); }
    s = sum_fq(s);
    return s;
}
__device__ __forceinline__ float rowscale(const float* p, int ns4, int fq, float inv_n) { return rsqrtf(row_partial_sum(p, ns4, fq) * inv_n + 1e-6f); }

__device__ __forceinline__ void rowscales8(float (&rs)[2][4], const float* base, int row0, int pitch, int ns4, int fq, float inv_n) {
    f32x4 v[2][4]; const int fqc = fq < ns4 ? fq : ns4 - 1;
#pragma unroll
    for (int ai = 0; ai < 2; ++ai)
#pragma unroll
        for (int m = 0; m < 4; ++m) v[ai][m] = *(const f32x4*)(base + (unsigned)(row0 + ai * HALF + m * 16) * (unsigned)pitch + 4 * fqc);
#pragma unroll
    for (int ai = 0; ai < 2; ++ai)
#pragma unroll
        for (int m = 0; m < 4; ++m) { const float p = (v[ai][m][0] + v[ai][m][1]) + (v[ai][m][2] + v[ai][m][3]); const float s = sum_fq(fq < ns4 ? p : 0.f); rs[ai][m] = rsqrtf(s * inv_n + 1e-6f); }
}

__device__ __forceinline__ void rowscales4(float (&rs)[4], const float* base, int row0, int pitch, int ns4, int fq, float inv_n) {
    f32x4 v[4]; const int fqc = fq < ns4 ? fq : ns4 - 1;
#pragma unroll
    for (int m = 0; m < 4; ++m) v[m] = *(const f32x4*)(base + (unsigned)(row0 + m * 16) * (unsigned)pitch + 4 * fqc);
#pragma unroll
    for (int m = 0; m < 4; ++m) { const float p = (v[m][0] + v[m][1]) + (v[m][2] + v[m][3]); const float s = sum_fq(fq < ns4 ? p : 0.f); rs[m] = rsqrtf(s * inv_n + 1e-6f); }
}

__device__ __forceinline__ unsigned swiglu2(const f32x2 g, const f32x2 u, const float k, const float r2) {
    const f32x2 t = g * k;
    f32x2 e; e.x = __builtin_amdgcn_exp2f(t.x); e.y = __builtin_amdgcn_exp2f(t.y);
    const f32x2 d = e + 1.0f;
    f32x2 rc; rc.x = __builtin_amdgcn_rcpf(d.x); rc.y = __builtin_amdgcn_rcpf(d.y);
    const f32x2 o = (g * u) * (rc * r2);
    return cvt_pk_bf16(o.x, o.y);
}
struct EpiSwiGLU {
    static constexpr bool PERM = true, AFTER_DRAIN = false;
    unsigned char* ws; size_t ss_off;
    __device__ __forceinline__ void operator()(const f32x4 (&acc)[2][2][4][2], const Unit& u, int wr, int wc, int fr, int fq) const {
        bf16_t* HID = (bf16_t*)(ws + B_HID); const float* SS = (const float*)(ws + ss_off);
        const int row0 = u.pm * BM + wr * 64 + fr, hc0 = u.pn * 128 + wc * 32 + 8 * fq;
        float rs[2][4]; rowscales8(rs, SS, row0, 16, 4, fq, 1.0f / 1024.0f);
#pragma unroll
        for (int ai = 0; ai < 2; ++ai)
#pragma unroll
            for (int m = 0; m < 4; ++m) {
                const int row = row0 + ai * HALF + m * 16; const float r = rs[ai][m], k = r * -1.4426950408889634f, r2 = r * r;
                const f32x4 g0 = acc[ai][0][m][0], g1 = acc[ai][0][m][1], u0 = acc[ai][1][m][0], u1 = acc[ai][1][m][1];
                u32x4 w; w.x = swiglu2(g0.xy, u0.xy, k, r2); w.y = swiglu2(g0.zw, u0.zw, k, r2); w.z = swiglu2(g1.xy, u1.xy, k, r2); w.w = swiglu2(g1.zw, u1.zw, k, r2);
                *(u32x4*)(HID + ((unsigned)row * 2816u + (unsigned)hc0)) = w;
            }
    }
};

__device__ __forceinline__ void unpack8f(const u32x4 w, float (&f)[8]) {
    f[0] = __builtin_bit_cast(float, w.x << 16); f[1] = __builtin_bit_cast(float, w.x & 0xffff0000u); f[2] = __builtin_bit_cast(float, w.y << 16); f[3] = __builtin_bit_cast(float, w.y & 0xffff0000u);
    f[4] = __builtin_bit_cast(float, w.z << 16); f[5] = __builtin_bit_cast(float, w.z & 0xffff0000u); f[6] = __builtin_bit_cast(float, w.w << 16); f[7] = __builtin_bit_cast(float, w.w & 0xffff0000u);
}
struct EpiResid {
    static constexpr bool PERM = true, AFTER_DRAIN = false;
    unsigned char* ws; size_t src_off, dst_off, sso_off, bias_off; float alpha;
    __device__ __forceinline__ void operator()(const f32x4 (&acc)[2][2][4][2], const Unit& u, int wr, int wc, int fr, int fq) const {
        const bf16_t* SRC = (const bf16_t*)(ws + src_off); bf16_t* DST = (bf16_t*)(ws + dst_off); float* SSo = (float*)(ws + sso_off);
        const int row0 = u.pm * BM + wr * 64 + fr, col0 = u.pn * BM + wc * 32 + 8 * fq;
        u32x4 hx[2][4][2];
#pragma unroll
        for (int ai = 0; ai < 2; ++ai)
#pragma unroll
            for (int m = 0; m < 4; ++m)
#pragma unroll
                for (int bj = 0; bj < 2; ++bj) hx[ai][m][bj] = *(const u32x4*)(SRC + (unsigned)(row0 + ai * HALF + m * 16) * 1024u + col0 + bj * HALF);
        f32x4 bv[2][2];
#pragma unroll
        for (int bj = 0; bj < 2; ++bj)
#pragma unroll
            for (int n = 0; n < 2; ++n) bv[bj][n] = bias_off ? *(const f32x4*)((const float*)(ws + bias_off) + col0 + bj * HALF + 4 * n) : (f32x4){0.f, 0.f, 0.f, 0.f};
#pragma unroll
        for (int ai = 0; ai < 2; ++ai)
#pragma unroll
            for (int m = 0; m < 4; ++m) {
                const int row = row0 + ai * HALF + m * 16; float ssq = 0.f;
#pragma unroll
                for (int bj = 0; bj < 2; ++bj) {
                    float h[8]; unpack8f(hx[ai][m][bj], h);
                    const f32x4 a0 = acc[ai][bj][m][0] * alpha + bv[bj][0], a1 = acc[ai][bj][m][1] * alpha + bv[bj][1];
                    h[0] += a0[0]; h[1] += a0[1]; h[2] += a0[2]; h[3] += a0[3]; h[4] += a1[0]; h[5] += a1[1]; h[6] += a1[2]; h[7] += a1[3];
                    u32x4 w; w.x = cvt_pk_bf16(h[0], h[1]); w.y = cvt_pk_bf16(h[2], h[3]); w.z = cvt_pk_bf16(h[4], h[5]); w.w = cvt_pk_bf16(h[6], h[7]);
                    *(u32x4*)(DST + (unsigned)row * 1024u + col0 + bj * HALF) = w;
                    ssq += (h[0] * h[0] + h[1] * h[1]) + (h[2] * h[2] + h[3] * h[3]) + (h[4] * h[4] + h[5] * h[5]) + (h[6] * h[6] + h[7] * h[7]);
                }
                ssq = sum_fq(ssq);
                if (fq == 0) SSo[(unsigned)row * 16u + u.pn * 4 + wc] = ssq;
            }
    }
};

struct EpiWin {
    static constexpr bool PERM = true, AFTER_DRAIN = false;
    unsigned char* ws;
    __device__ __forceinline__ void operator()(const f32x4 (&acc)[2][2][4][2], const Unit& u, int wr, int wc, int fr, int fq) const {
        const float* SS = (const float*)(ws + WS_SS) + (size_t)MTOK * 16;
        bf16_t* CQ = (bf16_t*)(ws + B_CQ); bf16_t* CKV = (bf16_t*)(ws + B_CKV); bf16_t* KR = (bf16_t*)(ws + B_KR); bf16_t* MX = (bf16_t*)(ws + B_MX); bf16_t* MV = (bf16_t*)(ws + B_MV);
        bf16_t* MO = (bf16_t*)(ws + B_MO); bf16_t* FQ = (bf16_t*)(ws + B_FQ); float* MIF = (float*)(ws + B_MIF); float* SSQ = (float*)(ws + B_SSQ);
        const float* ropec = (const float*)(ws + WS_ROPEC); const float* ropes = (const float*)(ws + WS_ROPES);
        const int row0 = u.pm * BM + wr * 64 + fr; const int pn = u.pn;
        float rsv[2][4]; rowscales8(rsv, SS, row0, 16, 4, fq, 1.0f / 1024.0f);
        const bool kr = (pn == 2) && (wc < 2);
        const unsigned kj0 = (unsigned)(wc * 32 + 8 * fq) >> 1;
#pragma unroll
        for (int ai = 0; ai < 2; ++ai) {
            f32x4 cv[4], sv[4];
#pragma unroll
            for (int m = 0; m < 4; ++m) { cv[m] = (f32x4){1.f, 1.f, 1.f, 1.f}; sv[m] = (f32x4){0.f, 0.f, 0.f, 0.f}; }
            if (kr) {
#pragma unroll
                for (int m = 0; m < 4; ++m) { const unsigned ro = (unsigned)(row0 + ai * HALF + m * 16) * 32u + kj0; cv[m] = *(const f32x4*)(ropec + ro); sv[m] = *(const f32x4*)(ropes + ro); }
#pragma unroll
                for (int m = 0; m < 4; ++m) asm volatile("" : "+v"(cv[m]), "+v"(sv[m]));
            }
#pragma unroll
            for (int m = 0; m < 4; ++m) {
                const int row = row0 + ai * HALF + m * 16; const float rs = rsv[ai][m];
#pragma unroll
                for (int bj = 0; bj < 2; ++bj) {
                    const f32x4 v0 = acc[ai][bj][m][0] * rs, v1 = acc[ai][bj][m][1] * rs;
                    const int cl = bj * HALF + wc * 32 + 8 * fq;
                    u32x4 w; w.x = cvt_pk_bf16(v0[0], v0[1]); w.y = cvt_pk_bf16(v0[2], v0[3]); w.z = cvt_pk_bf16(v1[0], v1[1]); w.w = cvt_pk_bf16(v1[2], v1[3]);
                    float ssq = (v0[0] * v0[0] + v0[1] * v0[1]) + (v0[2] * v0[2] + v0[3] * v0[3]) + (v1[0] * v1[0] + v1[1] * v1[1]) + (v1[2] * v1[2] + v1[3] * v1[3]);
                    const int gcol = pn * BM + cl;
                    if (pn <= 2 && gcol < 640) {
                        ssq = sum_fq(ssq);
                        const int grp = pn * 2 + bj;
                        if (fq == 0) SSQ[(unsigned)row * 32u + (unsigned)(grp * 4 + wc)] = ssq;
                        if (gcol < 384) *(u32x4*)(CQ + ((unsigned)row * 384u + (unsigned)gcol)) = w;
                        else *(u32x4*)(CKV + ((unsigned)row * 256u + (unsigned)(gcol - 384))) = w;
                    } else if (pn == 2) {
                        if (gcol < 704) {
                            const f32x4 c = cv[m], s = sv[m];
                            u32x4 o; o.x = cvt_pk_bf16(v0[0] * c[0] - v0[1] * s[0], v0[1] * c[0] + v0[0] * s[0]);
                            o.y = cvt_pk_bf16(v0[2] * c[1] - v0[3] * s[1], v0[3] * c[1] + v0[2] * s[1]);
                            o.z = cvt_pk_bf16(v1[0] * c[2] - v1[1] * s[2], v1[1] * c[2] + v1[0] * s[2]);
                            o.w = cvt_pk_bf16(v1[2] * c[3] - v1[3] * s[3], v1[3] * c[3] + v1[2] * s[3]);
                            *(u32x4*)(KR + ((unsigned)row * 64u + (unsigned)(gcol - 640))) = o;
                        } else if (gcol < 720) {
                            *(f32x4*)(MIF + ((unsigned)row * 16u + (unsigned)(gcol - 704))) = v0; *(f32x4*)(MIF + ((unsigned)row * 16u + (unsigned)(gcol - 704) + 4u)) = v1;
                        }
                    } else if (pn == 3) { *(u32x4*)(MX + ((unsigned)row * 256u + (unsigned)cl)) = w;
                    } else if (pn == 4) { *(u32x4*)(MV + ((unsigned)row * 256u + (unsigned)cl)) = w;
                    } else if (pn == 5) { *(u32x4*)(MO + ((unsigned)row * 256u + (unsigned)cl)) = w;
                    } else {
                        const int b = row >> 13, s_ = row & 8191, quad = cl >> 2;
                        bf16_t* p = FQ + (((unsigned)(b * 64 + quad) * 8192u + (unsigned)s_) << 2);
                        u32x2 lo, hi; lo.x = w.x; lo.y = w.y; hi.x = w.z; hi.y = w.w;
                        *(u32x2*)p = lo; *(u32x2*)(p + (size_t)8192 * 4) = hi;
                    }
                }
            }
        }
    }
};

struct EpiQ {
    static constexpr bool PERM = true, AFTER_DRAIN = false;
    unsigned char* ws;
    __device__ __forceinline__ void operator()(const f32x4 (&acc)[2][2][4][2], const Unit& u, int wr, int wc, int fr, int fq) const {
        const float* SSQ = (const float*)(ws + B_SSQ); bf16_t* Q = (bf16_t*)(ws + B_Q); const float* ropec = (const float*)(ws + WS_ROPEC); const float* ropes = (const float*)(ws + WS_ROPES);
        const int row0 = u.pm * BM + wr * 64 + fr;
        const int g0 = u.pn * BM + wc * 32; const bool rp0 = (g0 % 192) >= 128, rp1 = ((g0 + HALF) % 192) >= 128; const bool has_rope = rp0 || rp1; const int rbj = rp0 ? 0 : 1;
        const unsigned j0 = has_rope ? ((unsigned)(((g0 + rbj * HALF) % 192) - 128 + 8 * fq) >> 1) : 0u;
        f32x4 cva[2][4], sva[2][4];
#pragma unroll
        for (int ai = 0; ai < 2; ++ai)
#pragma unroll
            for (int m = 0; m < 4; ++m) { cva[ai][m] = (f32x4){1.f, 1.f, 1.f, 1.f}; sva[ai][m] = (f32x4){0.f, 0.f, 0.f, 0.f}; }
        if (has_rope) {
#pragma unroll
            for (int ai = 0; ai < 2; ++ai)
#pragma unroll
                for (int m = 0; m < 4; ++m) { const unsigned ro = (unsigned)(row0 + ai * HALF + m * 16) * 32u + j0; cva[ai][m] = *(const f32x4*)(ropec + ro); sva[ai][m] = *(const f32x4*)(ropes + ro); }
        }
        float rsv[2][4]; rowscales8(rsv, SSQ, row0, 32, 3, fq, 1.0f / 384.0f);
#pragma unroll
        for (int ai = 0; ai < 2; ++ai)
#pragma unroll
            for (int m = 0; m < 4; ++m) asm volatile("" : "+v"(cva[ai][m]), "+v"(sva[ai][m]));
#pragma unroll
        for (int ai = 0; ai < 2; ++ai) {
            const f32x4 (&cv)[4] = cva[ai]; const f32x4 (&sv)[4] = sva[ai];
#pragma unroll
            for (int m = 0; m < 4; ++m) {
                const int row = row0 + ai * HALF + m * 16; const float rs = rsv[ai][m];
#pragma unroll
                for (int bj = 0; bj < 2; ++bj) {
                    const f32x4 v0 = acc[ai][bj][m][0] * rs, v1 = acc[ai][bj][m][1] * rs;
                    const int gcol = u.pn * BM + bj * HALF + wc * 32 + 8 * fq;
                    u32x4 o;
                    if (has_rope && bj == rbj) {
                        const f32x4 c = cv[m], s = sv[m];
                        o.x = cvt_pk_bf16(v0[0] * c[0] - v0[1] * s[0], v0[1] * c[0] + v0[0] * s[0]);
                        o.y = cvt_pk_bf16(v0[2] * c[1] - v0[3] * s[1], v0[3] * c[1] + v0[2] * s[1]);
                        o.z = cvt_pk_bf16(v1[0] * c[2] - v1[1] * s[2], v1[1] * c[2] + v1[0] * s[2]);
                        o.w = cvt_pk_bf16(v1[2] * c[3] - v1[3] * s[3], v1[3] * c[3] + v1[2] * s[3]);
                    } else { o.x = cvt_pk_bf16(v0[0], v0[1]); o.y = cvt_pk_bf16(v0[2], v0[3]); o.z = cvt_pk_bf16(v1[0], v1[1]); o.w = cvt_pk_bf16(v1[2], v1[3]); }
                    *(u32x4*)(Q + ((unsigned)row * 768u + (unsigned)gcol)) = o;
                }
            }
        }
    }
};

struct EpiKV {
    static constexpr bool PERM = true, AFTER_DRAIN = false;
    unsigned char* ws;
    __device__ __forceinline__ void operator()(const f32x4 (&acc)[2][2][4][2], const Unit& u, int wr, int wc, int fr_, int fq_) const {
        int ln_ = (int)__builtin_amdgcn_mbcnt_hi(~0u, __builtin_amdgcn_mbcnt_lo(~0u, 0u)); asm volatile("" : "+v"(ln_));
        const int fr = ln_ & 15, fq = ln_ >> 4; (void)fr_; (void)fq_;
        const float* SSQ = (const float*)(ws + B_SSQ); bf16_t* KN = (bf16_t*)(ws + B_KN); bf16_t* V = (bf16_t*)(ws + B_V);
        const int row0 = u.pm * BM + wr * 64 + fr;
        float rsv[2][4]; rowscales8(rsv, SSQ + 12, row0, 32, 2, fq, 1.0f / 256.0f);
#pragma unroll
        for (int ai = 0; ai < 2; ++ai)
#pragma unroll
            for (int m = 0; m < 4; ++m) {
                const int row = row0 + ai * HALF + m * 16; const float rs = rsv[ai][m];
#pragma unroll
                for (int bj = 0; bj < 2; ++bj) {
                    const f32x4 v0 = acc[ai][bj][m][0] * rs, v1 = acc[ai][bj][m][1] * rs;
                    u32x4 o; o.x = cvt_pk_bf16(v0[0], v0[1]); o.y = cvt_pk_bf16(v0[2], v0[3]); o.z = cvt_pk_bf16(v1[0], v1[1]); o.w = cvt_pk_bf16(v1[2], v1[3]);
                    bf16_t* dst = (bj == 0 ? KN : V) + ((unsigned)row * 512u + u.pn * 128 + wc * 32 + 8 * fq);
                    *(u32x4*)dst = o;
                }
            }
    }
};

struct EpiE {
    static constexpr bool PERM = true, AFTER_DRAIN = false;
    unsigned char* ws; const float* gpost;
    __device__ __forceinline__ void operator()(const f32x4 (&acc)[2][2][4][2], const Unit& u, int wr, int wc, int fr, int fq) const {
        bf16_t* E = (bf16_t*)(ws + B_E); float* SSE = (float*)(ws + B_SSE);
        const int row0 = u.pm * BM + wr * 64 + fr;
        f32x4 gp[2][2];
#pragma unroll
        for (int bj = 0; bj < 2; ++bj)
#pragma unroll
            for (int n = 0; n < 2; ++n) gp[bj][n] = *(const f32x4*)(gpost + u.pn * BM + bj * HALF + wc * 32 + 8 * fq + 4 * n);
#pragma unroll
        for (int ai = 0; ai < 2; ++ai)
#pragma unroll
            for (int m = 0; m < 4; ++m) {
                const int row = row0 + ai * HALF + m * 16; float ssq = 0.f;
#pragma unroll
                for (int bj = 0; bj < 2; ++bj) {
                    const f32x4 v0 = acc[ai][bj][m][0], v1 = acc[ai][bj][m][1]; const f32x4 g0 = gp[bj][0], g1 = gp[bj][1];
                    u32x4 o; o.x = cvt_pk_bf16(v0[0] * g0[0], v0[1] * g0[1]); o.y = cvt_pk_bf16(v0[2] * g0[2], v0[3] * g0[3]); o.z = cvt_pk_bf16(v1[0] * g1[0], v1[1] * g1[1]); o.w = cvt_pk_bf16(v1[2] * g1[2], v1[3] * g1[3]);
                    ssq += (v0[0] * v0[0] + v0[1] * v0[1]) + (v0[2] * v0[2] + v0[3] * v0[3]) + (v1[0] * v1[0] + v1[1] * v1[1]) + (v1[2] * v1[2] + v1[3] * v1[3]);
                    *(u32x4*)(E + ((unsigned)row * 1024u + (unsigned)(u.pn * BM + bj * HALF + wc * 32 + 8 * fq))) = o;
                }
                ssq = sum_fq(ssq);
                if (fq == 0) SSE[(unsigned)row * 16u + (unsigned)(u.pn * 4 + wc)] = ssq;
            }
    }
};

struct EpiPle {
    static constexpr bool PERM = true, AFTER_DRAIN = false;
    unsigned char* ws;
    __device__ __forceinline__ void operator()(const f32x4 (&acc)[2][2][4][2], const Unit& u, int wr, int wc, int fr, int fq) const {
        const bf16_t* SRC = (const bf16_t*)(ws + WS_XB0); bf16_t* DST = (bf16_t*)(ws + B_XB1); float* SSo = (float*)(ws + WS_SS); const float* SSi = SSo + (size_t)MTOK * 16;
        const bf16_t* E = (const bf16_t*)(ws + B_E); const float* SSE = (const float*)(ws + B_SSE);
        const int row0 = u.pm * BM + wr * 64 + fr, col0 = u.pn * BM + wc * 32 + 8 * fq;
#pragma unroll
        for (int ai = 0; ai < 2; ++ai) {
            float rsv[4], rev[4]; rowscales4(rsv, SSi, row0 + ai * HALF, 16, 4, fq, 1.0f / 1024.0f); rowscales4(rev, SSE, row0 + ai * HALF, 16, 4, fq, 1.0f / 1024.0f);
            asm volatile("" ::: "memory");
            u32x4 hx[4][2], ex[4][2];
#pragma unroll
            for (int m = 0; m < 4; ++m)
#pragma unroll
                for (int bj = 0; bj < 2; ++bj) { const unsigned off = (unsigned)(row0 + ai * HALF + m * 16) * 1024u + col0 + bj * HALF; hx[m][bj] = *(const u32x4*)(SRC + off); ex[m][bj] = *(const u32x4*)(E + off); }
#pragma unroll
            for (int m = 0; m < 4; ++m) {
                const int row = row0 + ai * HALF + m * 16; float ssq = 0.f; const float rs = rsv[m], re = rev[m];
#pragma unroll
                for (int bj = 0; bj < 2; ++bj) {
                    float h[8], e[8]; unpack8f(hx[m][bj], h); unpack8f(ex[m][bj], e);
                    const f32x4 a0 = acc[ai][bj][m][0] * rs, a1 = acc[ai][bj][m][1] * rs;
                    h[0] += sigmoidf_(a0[0]) * (e[0] * re); h[1] += sigmoidf_(a0[1]) * (e[1] * re); h[2] += sigmoidf_(a0[2]) * (e[2] * re); h[3] += sigmoidf_(a0[3]) * (e[3] * re);
                    h[4] += sigmoidf_(a1[0]) * (e[4] * re); h[5] += sigmoidf_(a1[1]) * (e[5] * re); h[6] += sigmoidf_(a1[2]) * (e[6] * re); h[7] += sigmoidf_(a1[3]) * (e[7] * re);
                    u32x4 w; w.x = cvt_pk_bf16(h[0], h[1]); w.y = cvt_pk_bf16(h[2], h[3]); w.z = cvt_pk_bf16(h[4], h[5]); w.w = cvt_pk_bf16(h[6], h[7]);
                    *(u32x4*)(DST + (unsigned)row * 1024u + col0 + bj * HALF) = w;
                    ssq += (h[0] * h[0] + h[1] * h[1]) + (h[2] * h[2] + h[3] * h[3]) + (h[4] * h[4] + h[5] * h[5]) + (h[6] * h[6] + h[7] * h[7]);
                }
                ssq = sum_fq(ssq);
                if (fq == 0) SSo[(unsigned)row * 16u + u.pn * 4 + wc] = ssq;
            }
        }
    }
};


struct OneRound : StaticOrder {
    int r;
    __device__ __forceinline__ bool next(int i, Unit& u) const { return i == 0 && StaticOrder::next(r, u); }
};

struct UnitG;
struct EpiQKV {
    static constexpr bool PERM = true, AFTER_DRAIN = false;
    unsigned char* ws;
    template <class U> __device__ __forceinline__ void operator()(const f32x4 (&acc)[2][2][4][2], const U& u, int wr, int wc, int fr, int fq) const {
        const Unit uu{u.pm, u.pn};
        if (u.gi == 0) { const EpiQ e{ws}; e(acc, uu, wr, wc, fr, fq); } else { const EpiKV e{ws}; e(acc, uu, wr, wc, fr, fq); }
    }
};
struct OrderQKV {
    int G, v;
    template <class U> __device__ __forceinline__ bool next(int i, U& u) const {
        int qn = -1, kn = -1;
        if (G == 256) {
            const int pmv = v >> 1;
            if ((v & 1) == 0) { if (i < 3) qn = 3 * pmv + i; else return false; }
            else { if (i < 4) kn = 4 * pmv + i; else return false; }
        } else { const int L = i * G + v; if (L < 384) qn = L; else if (L < 896) kn = L - 384; else return false; }
        if (qn >= 0) { u.pm = qn / 3; u.pn = qn - 3 * (qn / 3); u.gi = 0; } else { u.pm = kn >> 2; u.pn = kn & 3; u.gi = 1; }
        return true;
    }
};

struct TouchOrder : StaticOrder {
    const bf16_t* t0; const bf16_t* t1; PG8_LAS unsigned char* junk; int wv;
    __device__ __forceinline__ void a_ready(const Unit& u) const {
        const int lane = (int)__builtin_amdgcn_mbcnt_hi(~0u, __builtin_amdgcn_mbcnt_lo(~0u, 0u));
#pragma unroll
        for (int k = 0; k < 2; ++k) { const int idx = wv * 128 + k * 64 + lane; const int row = idx >> 2, seg = idx & 3;
            const size_t off = ((size_t)(u.pm * BM + row) * 1024 + u.pn * BM + seg * 64);
            __builtin_amdgcn_global_load_lds((const unsigned*)(t0 + off), (PG8_LAS unsigned*)(junk + wv * 1024), 16, 0, 0);
            if (t1) __builtin_amdgcn_global_load_lds((const unsigned*)(t1 + off), (PG8_LAS unsigned*)(junk + wv * 1024), 16, 0, 0); }
    }
};
template <class Epi, class Sched, bool ALIGN_EPI = false, bool SP2 = false>
__device__ __forceinline__ void gemm_phase(PG8_LAS unsigned char* lds, const Gemm g, const Sched& S, const Epi& E, const int wv) {
    const int tid = opaque_tid(wv), wid = __builtin_amdgcn_readfirstlane(tid >> 6), lane = tid & 63, wr = wid >> 2, wc = wid & 3, fr = lane & 15, fq = lane >> 4;
    int K_ = g.K; asm volatile("" : "+s"(K_)); const int K = K_, nt = K / BK;
    unsigned voffA[2], voffB[2];
#pragma unroll
    for (int i = 0; i < 2; ++i) { int R, C; stage_rc(tid * 16 + i * 8192, R, C); const int Rb = Epi::PERM ? ((R & ~31) + perm32(R & 31)) : R;
        voffA[i] = (unsigned)(R * K + C) * 2u; voffB[i] = (unsigned)(Rb * K + C) * 2u; }
    const size_t kstep = (size_t)(BK * 2);
    const size_t hstep = (size_t)HALF * K * 2;
    const size_t tstep = 2 * hstep;
    const unsigned ldsw = (unsigned)wid * 1024u;
    const int aoff = lds_byte(wr * 64 + fr, fq * 8), boff = lds_byte(wc * 32 + fr, fq * 8);
#define PG8_SA(b, h) (((b) * 2 + (h)) * HTB)
#define PG8_SB(b, h) ((4 + (b) * 2 + (h)) * HTB)
#define PG8_STAGE(bufoff, gbase, voff) do { _Pragma("unroll") for (int _i = 0; _i < 2; ++_i) \
        __builtin_amdgcn_global_load_lds((const unsigned*)((const char*)(gbase) + (voff)[_i]), (PG8_LAS unsigned*)(lds + (bufoff) + ldsw + _i * 8192), 16, 0, 0); } while (0)
#define PG8_LDA(dst, b, h) do { _Pragma("unroll") for (int m = 0; m < 4; ++m) _Pragma("unroll") for (int k = 0; k < 2; ++k) dst[m][k] = *(const PG8_LAS bf16x8*)(lds + PG8_SA(b, h) + aoff + m * 2048 + k * 1024); } while (0)
#define PG8_LDB(dst, b, h) do { _Pragma("unroll") for (int n = 0; n < 2; ++n) _Pragma("unroll") for (int k = 0; k < 2; ++k) dst[n][k] = *(const PG8_LAS bf16x8*)(lds + PG8_SB(b, h) + boff + n * 2048 + k * 1024); } while (0)
#define PG8_MMA(ai, bj, At, Bt) do { __builtin_amdgcn_s_setprio(1); _Pragma("unroll") for (int m = 0; m < 4; ++m) _Pragma("unroll") for (int n = 0; n < 2; ++n) _Pragma("unroll") for (int k = 0; k < 2; ++k) \
        acc[ai][bj][m][n] = __builtin_amdgcn_mfma_f32_16x16x32_bf16(Bt[n][k], At[m][k], acc[ai][bj][m][n], 0, 0, 0); __builtin_amdgcn_s_setprio(0); } while (0)
#define PG8_WAIT_V(n) asm volatile("s_waitcnt vmcnt(" #n ")" ::: "memory")
#define PG8_WAIT_L(n) asm volatile("s_waitcnt lgkmcnt(" #n ")" ::: "memory")
#define PG8_BAR __builtin_amdgcn_s_barrier()
#define PG8_SCHED __builtin_amdgcn_sched_barrier(0)
#ifdef PROBE_GEMM
#define PG8_PON() ({ volatile PG8_LAS unsigned* mm_ = (volatile PG8_LAS unsigned*)(lds + MISC_OFF); (mm_[20] && tid == 0 && blockIdx.x == 0); })
#define PG8_PT(var) do { if (PG8_PON()) var = __builtin_amdgcn_s_memrealtime(); } while (0)
#define PG8_PACC(var) do { if (PG8_PON()) { volatile PG8_LAS unsigned* mm_ = (volatile PG8_LAS unsigned*)(lds + MISC_OFF); const unsigned long long d_ = __builtin_amdgcn_s_memrealtime() - var; \
        unsigned long long a_ = ((unsigned long long)mm_[23] << 32) | mm_[22]; a_ += d_; mm_[22] = (unsigned)a_; mm_[23] = (unsigned)(a_ >> 32); } } while (0)
    unsigned long long pk_ = 0;
#endif
    Unit cur, nxt; int ui = 0;
    if (!S.next(0, cur)) return;
    f32x4 acc[2][2][4][2]; float zz_ = 0.f; asm volatile("" : "+v"(zz_));
#pragma unroll
    for (int a = 0; a < 2; ++a)
#pragma unroll
        for (int b = 0; b < 2; ++b)
#pragma unroll
            for (int m = 0; m < 4; ++m)
#pragma unroll
                for (int n = 0; n < 2; ++n) acc[a][b][m][n] = (f32x4){zz_, zz_, zz_, zz_};
    bf16x8 At[4][2], B0[2][2], B1[2][2];
#ifdef GEMM_FAKE_L2
#define PG8_PMI(x) ((x) & 0)
#else
#define PG8_PMI(x) (x)
#endif
    const char* cA = (const char*)g.A + (size_t)PG8_PMI(cur.pm) * tstep; const char* cB = (const char*)g.Bt + (size_t)PG8_PMI(cur.pn) * tstep;
    S.a_ready(cur);
    if constexpr (SP2) {
        PG8_STAGE(PG8_SB(0, 0), cB, voffB); PG8_STAGE(PG8_SB(0, 1), cB + hstep, voffB); PG8_STAGE(PG8_SA(0, 0), cA, voffA); PG8_STAGE(PG8_SA(0, 1), cA + hstep, voffA);
        if (wr == 1) PG8_BAR;
        PG8_WAIT_V(2); PG8_BAR;
        PG8_STAGE(PG8_SB(1, 0), cB + kstep, voffB); PG8_STAGE(PG8_SA(1, 0), cA + kstep, voffA); PG8_STAGE(PG8_SB(1, 1), cB + hstep + kstep, voffB);
        PG8_WAIT_V(6); PG8_BAR;
    } else {
        PG8_STAGE(PG8_SB(0, 0), cB, voffB); PG8_STAGE(PG8_SA(0, 0), cA, voffA); PG8_STAGE(PG8_SB(0, 1), cB + hstep, voffB); PG8_STAGE(PG8_SA(0, 1), cA + hstep, voffA);
        if (wr == 1) PG8_BAR;
        PG8_WAIT_V(4); PG8_BAR;
        PG8_STAGE(PG8_SB(1, 0), cB + kstep, voffB); PG8_STAGE(PG8_SA(1, 0), cA + kstep, voffA); PG8_STAGE(PG8_SB(1, 1), cB + hstep + kstep, voffB);
        PG8_WAIT_V(6); PG8_BAR;
    }
    for (;;) {
        const bool has_next = S.next(ui + 1, nxt);
        const char* nA = has_next ? (const char*)g.A + (size_t)PG8_PMI(nxt.pm) * tstep : cA; const char* nB = has_next ? (const char*)g.Bt + (size_t)PG8_PMI(nxt.pn) * tstep : cB;
#if defined(PROBE_GEMM) && (PROBE_GEMM == 3)
        PG8_PT(pk_);
#endif
#if defined(PROBE_GEMM) && (PROBE_GEMM == 5)
        if (ui > 0) PG8_PACC(pk_);
#endif
        for (int t = 0; t < nt; t += 2) {
            const bool last = (t == nt - 2);
            const char* a1 = cA + (size_t)(t + 1) * kstep;
            const char* a2 = last ? nA : cA + (size_t)(t + 2) * kstep; const char* b2 = last ? nB : cB + (size_t)(t + 2) * kstep;
            const char* a3 = a2 + kstep; const char* b3 = b2 + kstep;
            if (last && has_next) S.a_ready(nxt);
            if constexpr (SP2) {
            PG8_LDB(B0, 0, 0); PG8_LDB(B1, 0, 1); PG8_SCHED; PG8_LDA(At, 0, 0); PG8_STAGE(PG8_SA(1, 1), a1 + hstep, voffA);
            PG8_WAIT_V(8); PG8_WAIT_L(0); PG8_BAR; PG8_MMA(0, 0, At, B0); PG8_MMA(0, 1, At, B1); PG8_BAR; PG8_SCHED;
            PG8_LDA(At, 0, 1); PG8_STAGE(PG8_SB(0, 0), b2, voffB); PG8_STAGE(PG8_SB(0, 1), b2 + hstep, voffB); PG8_STAGE(PG8_SA(0, 0), a2, voffA);
            PG8_WAIT_V(8); PG8_WAIT_L(0); PG8_BAR; PG8_MMA(1, 0, At, B0); PG8_MMA(1, 1, At, B1); PG8_BAR; PG8_SCHED;
            PG8_LDB(B0, 1, 0); PG8_LDB(B1, 1, 1); PG8_SCHED; PG8_LDA(At, 1, 0); PG8_STAGE(PG8_SA(0, 1), a2 + hstep, voffA);
            PG8_WAIT_V(8); PG8_WAIT_L(0); PG8_BAR; PG8_MMA(0, 0, At, B0); PG8_MMA(0, 1, At, B1); PG8_BAR; PG8_SCHED;
            PG8_LDA(At, 1, 1); PG8_STAGE(PG8_SB(1, 0), b3, voffB); PG8_STAGE(PG8_SB(1, 1), b3 + hstep, voffB); PG8_STAGE(PG8_SA(1, 0), a3, voffA);
            PG8_WAIT_V(8); PG8_WAIT_L(0); PG8_BAR; PG8_MMA(1, 0, At, B0); PG8_MMA(1, 1, At, B1); PG8_BAR; PG8_SCHED;
            } else {
            PG8_LDB(B0, 0, 0); PG8_SCHED; PG8_LDA(At, 0, 0); PG8_STAGE(PG8_SA(1, 1), a1 + hstep, voffA);
            PG8_WAIT_L(8); PG8_BAR; PG8_WAIT_L(0); PG8_MMA(0, 0, At, B0); PG8_BAR; PG8_SCHED;
            PG8_LDB(B1, 0, 1); PG8_STAGE(PG8_SB(0, 0), b2, voffB);
            PG8_BAR; PG8_WAIT_L(0); PG8_MMA(0, 1, At, B1); PG8_BAR;
            PG8_LDA(At, 0, 1); PG8_STAGE(PG8_SA(0, 0), a2, voffA);
            PG8_BAR; PG8_WAIT_L(0); PG8_MMA(1, 0, At, B0); PG8_BAR; PG8_SCHED;
            PG8_STAGE(PG8_SB(0, 1), b2 + hstep, voffB);
            PG8_WAIT_V(6); PG8_BAR; PG8_MMA(1, 1, At, B1); PG8_BAR;
            PG8_LDB(B0, 1, 0); PG8_SCHED; PG8_LDA(At, 1, 0); PG8_STAGE(PG8_SA(0, 1), a2 + hstep, voffA);
            PG8_WAIT_L(8); PG8_BAR; PG8_WAIT_L(0); PG8_MMA(0, 0, At, B0); PG8_BAR; PG8_SCHED;
            PG8_LDB(B1, 1, 1); PG8_STAGE(PG8_SB(1, 0), b3, voffB);
            PG8_BAR; PG8_WAIT_L(0); PG8_MMA(0, 1, At, B1); PG8_BAR;
            PG8_LDA(At, 1, 1); PG8_STAGE(PG8_SA(1, 0), a3, voffA);
            PG8_BAR; PG8_WAIT_L(0); PG8_MMA(1, 0, At, B0); PG8_BAR; PG8_SCHED;
            PG8_STAGE(PG8_SB(1, 1), b3 + hstep, voffB);
            PG8_WAIT_V(6); PG8_BAR; PG8_MMA(1, 1, At, B1); PG8_BAR;
            }
        }
#if defined(PROBE_GEMM) && (PROBE_GEMM == 3)
        PG8_PACC(pk_);
#endif
#if defined(PROBE_GEMM) && (PROBE_GEMM == 4)
        PG8_PT(pk_);
#endif
        if constexpr (ALIGN_EPI) { if (wr == 0) PG8_BAR; }
#if defined(PROBE_GEMM) && (PROBE_GEMM == 4)
        PG8_PACC(pk_);
#endif
#if defined(PROBE_GEMM) && (PROBE_GEMM <= 2)
        unsigned long long pt0_ = 0; { volatile PG8_LAS unsigned* mm_ = (volatile PG8_LAS unsigned*)(lds + MISC_OFF); if (mm_[20] && tid == 0 && blockIdx.x == 0) pt0_ = __builtin_amdgcn_s_memrealtime(); }
#endif
        if constexpr (!Epi::AFTER_DRAIN) { E(acc, cur, wr, wc, fr, fq); S.done(cur); }
#if defined(PROBE_GEMM) && (PROBE_GEMM == 5)
        PG8_PT(pk_);
#endif
#if defined(PROBE_GEMM) && (PROBE_GEMM <= 2)
        { volatile PG8_LAS unsigned* mm_ = (volatile PG8_LAS unsigned*)(lds + MISC_OFF); if (mm_[20] && tid == 0 && blockIdx.x == 0) {
#if PROBE_GEMM == 2
            asm volatile("s_waitcnt vmcnt(0)" ::: "memory");
#endif
            const unsigned long long d_ = __builtin_amdgcn_s_memrealtime() - pt0_; unsigned long long a_ = ((unsigned long long)mm_[23] << 32) | mm_[22]; a_ += d_; mm_[22] = (unsigned)a_; mm_[23] = (unsigned)(a_ >> 32); } }
#endif
        if (!has_next) break;
        zz_ = 0.f; asm volatile("" : "+v"(zz_));
#pragma unroll
        for (int a = 0; a < 2; ++a)
#pragma unroll
            for (int b = 0; b < 2; ++b)
#pragma unroll
                for (int m = 0; m < 4; ++m)
#pragma unroll
                    for (int n = 0; n < 2; ++n) acc[a][b][m][n] = (f32x4){zz_, zz_, zz_, zz_};
        cur = nxt; cA = nA; cB = nB; ++ui;
        if constexpr (ALIGN_EPI) { if (wr == 1) PG8_BAR; }
    }
    PG8_WAIT_V(0);
    if constexpr (!ALIGN_EPI) { if (wr == 0) PG8_BAR; }
    PG8_BAR;
    if constexpr (Epi::AFTER_DRAIN) { E.fused(acc, cur, wr, wc, fr, fq, lds, wid, lane); S.done(cur); }
#undef PG8_SA
#undef PG8_SB
#undef PG8_STAGE
#undef PG8_LDA
#undef PG8_LDB
#undef PG8_MMA
#undef PG8_WAIT_V
#undef PG8_WAIT_L
#undef PG8_BAR
#undef PG8_SCHED
}

struct UnitG { int pm, pn, gi; };
template <class Epi, class Sched>
__device__ __forceinline__ void gemm_phase_mg(PG8_LAS unsigned char* lds, const Gemm g0, const Gemm g1, const Sched& S, const Epi& E, const int wv) {
    const int tid = opaque_tid(wv), wid = __builtin_amdgcn_readfirstlane(tid >> 6), lane = tid & 63, wr = wid >> 2, wc = wid & 3, fr = lane & 15, fq = lane >> 4;
    int K0_ = g0.K, K1_ = g1.K; asm volatile("" : "+s"(K0_), "+s"(K1_)); const int K0 = K0_, K1 = K1_;
    unsigned RA2[2], RB2[2], C2[2];
#pragma unroll
    for (int i = 0; i < 2; ++i) { int R, C; stage_rc(tid * 16 + i * 8192, R, C); const int Rb = Epi::PERM ? ((R & ~31) + perm32(R & 31)) : R; RA2[i] = (unsigned)R * 2u; RB2[i] = (unsigned)Rb * 2u; C2[i] = (unsigned)C * 2u; }
    const size_t kstep = (size_t)(BK * 2);
    const size_t hstep0 = (size_t)HALF * K0 * 2, hstep1 = (size_t)HALF * K1 * 2;
    const unsigned ldsw = (unsigned)wid * 1024u;
    const int aoff = lds_byte(wr * 64 + fr, fq * 8), boff = lds_byte(wc * 32 + fr, fq * 8);
#define PG8_SA(b, h) (((b) * 2 + (h)) * HTB)
#define PG8_SB(b, h) ((4 + (b) * 2 + (h)) * HTB)
#define PG8_STAGE(bufoff, gbase, R2, KK) do { _Pragma("unroll") for (int _i = 0; _i < 2; ++_i) \
        __builtin_amdgcn_global_load_lds((const unsigned*)((const char*)(gbase) + ((R2)[_i] * (unsigned)(KK) + C2[_i])), (PG8_LAS unsigned*)(lds + (bufoff) + ldsw + _i * 8192), 16, 0, 0); } while (0)
#define PG8_LDA(dst, b, h) do { _Pragma("unroll") for (int m = 0; m < 4; ++m) _Pragma("unroll") for (int k = 0; k < 2; ++k) dst[m][k] = *(const PG8_LAS bf16x8*)(lds + PG8_SA(b, h) + aoff + m * 2048 + k * 1024); } while (0)
#define PG8_LDB(dst, b, h) do { _Pragma("unroll") for (int n = 0; n < 2; ++n) _Pragma("unroll") for (int k = 0; k < 2; ++k) dst[n][k] = *(const PG8_LAS bf16x8*)(lds + PG8_SB(b, h) + boff + n * 2048 + k * 1024); } while (0)
#define PG8_MMA(ai, bj, At, Bt) do { __builtin_amdgcn_s_setprio(1); _Pragma("unroll") for (int m = 0; m < 4; ++m) _Pragma("unroll") for (int n = 0; n < 2; ++n) _Pragma("unroll") for (int k = 0; k < 2; ++k) \
        acc[ai][bj][m][n] = __builtin_amdgcn_mfma_f32_16x16x32_bf16(Bt[n][k], At[m][k], acc[ai][bj][m][n], 0, 0, 0); __builtin_amdgcn_s_setprio(0); } while (0)
#define PG8_WAIT_V(n) asm volatile("s_waitcnt vmcnt(" #n ")" ::: "memory")
#define PG8_WAIT_L(n) asm volatile("s_waitcnt lgkmcnt(" #n ")" ::: "memory")
#define PG8_BAR __builtin_amdgcn_s_barrier()
#define PG8_SCHED __builtin_amdgcn_sched_barrier(0)
#ifdef PROBE_GEMM
#define PG8_PON() ({ volatile PG8_LAS unsigned* mm_ = (volatile PG8_LAS unsigned*)(lds + MISC_OFF); (mm_[20] && tid == 0 && blockIdx.x == 0); })
#define PG8_PT(var) do { if (PG8_PON()) var = __builtin_amdgcn_s_memrealtime(); } while (0)
#define PG8_PACC(var) do { if (PG8_PON()) { volatile PG8_LAS unsigned* mm_ = (volatile PG8_LAS unsigned*)(lds + MISC_OFF); const unsigned long long d_ = __builtin_amdgcn_s_memrealtime() - var; \
        unsigned long long a_ = ((unsigned long long)mm_[23] << 32) | mm_[22]; a_ += d_; mm_[22] = (unsigned)a_; mm_[23] = (unsigned)(a_ >> 32); } } while (0)
    unsigned long long pk_ = 0;
#endif
    UnitG cur, nxt; int ui = 0;
    if (!S.next(0, cur)) return;
    f32x4 acc[2][2][4][2]; float zz_ = 0.f; asm volatile("" : "+v"(zz_));
#pragma unroll
    for (int a = 0; a < 2; ++a)
#pragma unroll
        for (int b = 0; b < 2; ++b)
#pragma unroll
            for (int m = 0; m < 4; ++m)
#pragma unroll
                for (int n = 0; n < 2; ++n) acc[a][b][m][n] = (f32x4){zz_, zz_, zz_, zz_};
    bf16x8 At[4][2], B0[2][2], B1[2][2];
    int gic = cur.gi; size_t hsc = gic ? hstep1 : hstep0; int Kc = gic ? K1 : K0; int ntc = Kc / BK;
    const char* cA = (const char*)(gic ? g1.A : g0.A) + (size_t)cur.pm * (2 * hsc); const char* cB = (const char*)(gic ? g1.Bt : g0.Bt) + (size_t)cur.pn * (2 * hsc);
    PG8_STAGE(PG8_SB(0, 0), cB, RB2, Kc); PG8_STAGE(PG8_SB(0, 1), cB + hsc, RB2, Kc); PG8_STAGE(PG8_SA(0, 0), cA, RA2, Kc); PG8_STAGE(PG8_SA(0, 1), cA + hsc, RA2, Kc);
    if (wr == 1) PG8_BAR;
    PG8_WAIT_V(2); PG8_BAR;
    PG8_STAGE(PG8_SB(1, 0), cB + kstep, RB2, Kc); PG8_STAGE(PG8_SA(1, 0), cA + kstep, RA2, Kc); PG8_STAGE(PG8_SB(1, 1), cB + hsc + kstep, RB2, Kc);
    PG8_WAIT_V(6); PG8_BAR;
    for (;;) {
        const bool has_next = S.next(ui + 1, nxt);
        const int gin = has_next ? nxt.gi : gic; const size_t hsn = gin ? hstep1 : hstep0; const int Kn = gin ? K1 : K0;
        const char* nA = has_next ? (const char*)(gin ? g1.A : g0.A) + (size_t)nxt.pm * (2 * hsn) : cA; const char* nB = has_next ? (const char*)(gin ? g1.Bt : g0.Bt) + (size_t)nxt.pn * (2 * hsn) : cB;
#if defined(PROBE_GEMM) && (PROBE_GEMM == 3)
        PG8_PT(pk_);
#endif
        for (int t = 0; t < ntc; t += 2) {
            const bool last = (t == ntc - 2);
            const char* a1 = cA + (size_t)(t + 1) * kstep;
            const char* a2 = last ? nA : cA + (size_t)(t + 2) * kstep; const char* b2 = last ? nB : cB + (size_t)(t + 2) * kstep;
            const char* a3 = a2 + kstep; const char* b3 = b2 + kstep;
            const size_t hs2 = last ? hsn : hsc; const int K2 = last ? Kn : Kc;
            PG8_LDB(B0, 0, 0); PG8_LDB(B1, 0, 1); PG8_SCHED; PG8_LDA(At, 0, 0); PG8_STAGE(PG8_SA(1, 1), a1 + hsc, RA2, Kc);
            PG8_WAIT_V(8); PG8_WAIT_L(0); PG8_BAR; PG8_MMA(0, 0, At, B0); PG8_MMA(0, 1, At, B1); PG8_BAR; PG8_SCHED;
            PG8_LDA(At, 0, 1); PG8_STAGE(PG8_SB(0, 0), b2, RB2, K2); PG8_STAGE(PG8_SB(0, 1), b2 + hs2, RB2, K2); PG8_STAGE(PG8_SA(0, 0), a2, RA2, K2);
            PG8_WAIT_V(8); PG8_WAIT_L(0); PG8_BAR; PG8_MMA(1, 0, At, B0); PG8_MMA(1, 1, At, B1); PG8_BAR; PG8_SCHED;
            PG8_LDB(B0, 1, 0); PG8_LDB(B1, 1, 1); PG8_SCHED; PG8_LDA(At, 1, 0); PG8_STAGE(PG8_SA(0, 1), a2 + hs2, RA2, K2);
            PG8_WAIT_V(8); PG8_WAIT_L(0); PG8_BAR; PG8_MMA(0, 0, At, B0); PG8_MMA(0, 1, At, B1); PG8_BAR; PG8_SCHED;
            PG8_LDA(At, 1, 1); PG8_STAGE(PG8_SB(1, 0), b3, RB2, K2); PG8_STAGE(PG8_SB(1, 1), b3 + hs2, RB2, K2); PG8_STAGE(PG8_SA(1, 0), a3, RA2, K2);
            PG8_WAIT_V(8); PG8_WAIT_L(0); PG8_BAR; PG8_MMA(1, 0, At, B0); PG8_MMA(1, 1, At, B1); PG8_BAR; PG8_SCHED;
        }
#if defined(PROBE_GEMM) && (PROBE_GEMM == 3)
        PG8_PACC(pk_);
#endif
        if (wr == 0) PG8_BAR;
#if defined(PROBE_GEMM) && (PROBE_GEMM == 1)
        PG8_PT(pk_);
#endif
        E(acc, cur, wr, wc, fr, fq);
#if defined(PROBE_GEMM) && (PROBE_GEMM == 1)
        PG8_PACC(pk_);
#endif
        if (!has_next) break;
        zz_ = 0.f; asm volatile("" : "+v"(zz_));
#pragma unroll
        for (int a = 0; a < 2; ++a)
#pragma unroll
            for (int b = 0; b < 2; ++b)
#pragma unroll
                for (int m = 0; m < 4; ++m)
#pragma unroll
                    for (int n = 0; n < 2; ++n) acc[a][b][m][n] = (f32x4){zz_, zz_, zz_, zz_};
        cur = nxt; cA = nA; cB = nB; ++ui; gic = gin; hsc = hsn; Kc = Kn; ntc = Kc / BK;
        if (wr == 1) PG8_BAR;
    }
    PG8_WAIT_V(0);
    PG8_BAR;
#undef PG8_SA
#undef PG8_SB
#undef PG8_STAGE
#undef PG8_LDA
#undef PG8_LDB
#undef PG8_MMA
#undef PG8_WAIT_V
#undef PG8_WAIT_L
#undef PG8_BAR
#undef PG8_SCHED
}
}
#define XB_TMO      128
#define XB_XCNT(j)  (256  + 64 * (j))
#define XB_XSUB(j)  (1280 + 64 * (j))
#define XB_XGEN(j)  (2304 + 64 * (j))
#define XB_TOP      3328
#define XB_TOPGEN   3392
#define XCD_BAR_WORDS 3456
#define XB_SPIN_CAP (1u << 18)

__device__ __forceinline__ unsigned xb_ld(unsigned* p)              { return __hip_atomic_load(p, __ATOMIC_RELAXED, __HIP_MEMORY_SCOPE_AGENT); }
__device__ __forceinline__ unsigned xb_add(unsigned* p, unsigned v) { return __hip_atomic_fetch_add(p, v, __ATOMIC_RELAXED, __HIP_MEMORY_SCOPE_AGENT); }
__device__ __forceinline__ unsigned xb_xcc_id() { return (unsigned)__builtin_amdgcn_s_getreg((3 << 11) | 20) & 0xFu; }
#define XB_SPIN(cond, bar) do { unsigned _sp = 0; while (cond) { __builtin_amdgcn_s_sleep(1); \
    if ((++_sp & 255u) == 0u) { if (xb_ld(&(bar)[XB_TMO])) break; if (_sp > XB_SPIN_CAP) { atomicAdd(&(bar)[XB_TMO], 1u); break; } } } } while (0)

struct XcdBarrier {
    unsigned* bar; unsigned x;
    volatile LAS unsigned* st;
    int wv;
};

__device__ __forceinline__ XcdBarrier xcd_barrier_post(unsigned* bar, volatile LAS unsigned* st) {
    XcdBarrier b; b.bar = bar; b.x = xb_xcc_id(); b.st = st;
    if (threadIdx.x == 0) (void)xb_add(&bar[XB_XCNT(b.x)], 1u);
    return b;
}
__device__ __forceinline__ void xcd_barrier_complete(unsigned* bar, unsigned x, unsigned& nloc, unsigned& nx) {
    const unsigned G = gridDim.x * gridDim.y * gridDim.z;
    unsigned sum, cnt, mine, sp = 0u;
    for (;;) {
        sum = 0u; cnt = 0u; mine = 0u;
#pragma unroll
        for (unsigned j = 0; j < 16; ++j) { const unsigned c = xb_ld(&bar[XB_XCNT(j)]); sum += c; cnt += (c > 0u) ? 1u : 0u; mine = (j == x) ? c : mine; }
        if (sum == G) break;
        __builtin_amdgcn_s_sleep(1);
        if ((++sp & 255u) == 0u) { if (xb_ld(&bar[XB_TMO])) break; if (sp > XB_SPIN_CAP) { atomicAdd(&bar[XB_TMO], 1u); break; } }
    }
    nloc = mine > 0u ? mine : 1u; nx = cnt > 0u ? cnt : 1u;
}

__device__ __forceinline__ void xcd_barrier(const XcdBarrier& b) {
    asm volatile("s_waitcnt vmcnt(0)" ::: "memory");
    __syncthreads();
    if (b.wv == 0 && __builtin_amdgcn_mbcnt_hi(~0u, __builtin_amdgcn_mbcnt_lo(~0u, 0u)) == 0u) {
        unsigned* bar = b.bar;
        __builtin_amdgcn_s_waitcnt(0);
        unsigned nloc = b.st[0], nx = b.st[1];
        if (nloc == 0u) { xcd_barrier_complete(bar, b.x, nloc, nx); b.st[0] = nloc; b.st[1] = nx; }
        const unsigned old = xb_add(&bar[XB_XSUB(b.x)], 1u);
        const unsigned gen = old / nloc;
        if (old + 1u == (gen + 1u) * nloc) {
            __builtin_amdgcn_fence(__ATOMIC_RELEASE, "agent");
            asm volatile("s_waitcnt vmcnt(0)" ::: "memory");
            const unsigned og = xb_add(&bar[XB_TOP], 1u);
            const unsigned tg = og / nx;
            if (og + 1u == (tg + 1u) * nx) xb_add(&bar[XB_TOPGEN], 1u);
            else XB_SPIN(xb_ld(&bar[XB_TOPGEN]) == tg, bar);
            __builtin_amdgcn_fence(__ATOMIC_ACQUIRE, "agent");
            xb_add(&bar[XB_XGEN(b.x)], 1u);
            asm volatile("s_waitcnt vmcnt(0)" ::: "memory");
        } else {
            XB_SPIN(xb_ld(&bar[XB_XGEN(b.x)]) == gen, bar);
            __builtin_amdgcn_fence(__ATOMIC_ACQUIRE, "agent");
            asm volatile("s_waitcnt vmcnt(0)" ::: "memory");
        }
    }
    __syncthreads();
}

__device__ __forceinline__ void xcd_arrive(const XcdBarrier& b, unsigned* bar2) {
    asm volatile("s_waitcnt vmcnt(0)" ::: "memory");
    __syncthreads();
    if (b.wv == 0 && __builtin_amdgcn_mbcnt_hi(~0u, __builtin_amdgcn_mbcnt_lo(~0u, 0u)) == 0u) {
        __builtin_amdgcn_s_waitcnt(0);
        const unsigned nloc = b.st[0], nx = b.st[1];
        const unsigned old = xb_add(&bar2[XB_XSUB(b.x)], 1u);
        const unsigned gen = old / nloc;
        if (old + 1u == (gen + 1u) * nloc) {
            __builtin_amdgcn_fence(__ATOMIC_RELEASE, "agent");
            asm volatile("s_waitcnt vmcnt(0)" ::: "memory");
            const unsigned og = xb_add(&bar2[XB_TOP], 1u);
            const unsigned tg = og / nx;
            if (og + 1u == (tg + 1u) * nx) xb_add(&bar2[XB_TOPGEN], 1u);
        }
    }
}
__device__ __forceinline__ void xcd_wait(const XcdBarrier& b, unsigned* bar2, unsigned k) {
    asm volatile("s_waitcnt vmcnt(0)" ::: "memory");
    __syncthreads();
    if (b.wv == 0 && __builtin_amdgcn_mbcnt_hi(~0u, __builtin_amdgcn_mbcnt_lo(~0u, 0u)) == 0u) {
        XB_SPIN(xb_ld(&bar2[XB_TOPGEN]) < k, b.bar);
        __builtin_amdgcn_fence(__ATOMIC_ACQUIRE, "agent");
        asm volatile("s_waitcnt vmcnt(0)" ::: "memory");
    }
    __syncthreads();
}
typedef short bf16x8 __attribute__((ext_vector_type(8)));
typedef float f32x4 __attribute__((ext_vector_type(4)));
typedef float f32x16 __attribute__((ext_vector_type(16)));
struct Frame {
    LAS unsigned char* lds;
    volatile LAS unsigned* MISC;
    int tid, lane, wave;
    int vcu, G;
    unsigned char* ws;
    const void* const* in_unused;
};
__device__ __forceinline__ float wave_sum(float v, int lane) {
#pragma unroll
    for (int o = 1; o < 64; o <<= 1) v += bperm(lane ^ o, v);
    return v;
}
template <int CTRL, int RM> __device__ __forceinline__ float dpp_keep(float old, float v) { return __int_as_float(__builtin_amdgcn_update_dpp(__float_as_int(old), __float_as_int(v), CTRL, RM, 0xf, false)); }
__device__ __forceinline__ float wave_incl_sum(float v, int) {
    v += dpp_keep<0x111, 0xf>(0.f, v); v += dpp_keep<0x112, 0xf>(0.f, v); v += dpp_keep<0x114, 0xf>(0.f, v); v += dpp_keep<0x118, 0xf>(0.f, v);
    v += dpp_keep<0x142, 0xa>(0.f, v); v += dpp_keep<0x143, 0xc>(0.f, v);
    return v;
}
__device__ __forceinline__ float wave_incl_max(float v, int) {
    v = fmaxf(v, dpp_keep<0x111, 0xf>(v, v)); v = fmaxf(v, dpp_keep<0x112, 0xf>(v, v)); v = fmaxf(v, dpp_keep<0x114, 0xf>(v, v)); v = fmaxf(v, dpp_keep<0x118, 0xf>(v, v));
    v = fmaxf(v, dpp_keep<0x142, 0xa>(v, v)); v = fmaxf(v, dpp_keep<0x143, 0xc>(v, v));
    return v;
}
__device__ __forceinline__ float quad_sum(float v) { v += dpp_keep<0xB1, 0xf>(v, v); v += dpp_keep<0x4E, 0xf>(v, v); return v; }
__device__ __forceinline__ float oct_sum(float v) { v = quad_sum(v); v += dpp_keep<0x141, 0xf>(v, v); return v; }
__device__ __forceinline__ float lane_bcast(float v, int src) { return __int_as_float(__builtin_amdgcn_readlane(__float_as_int(v), src)); }
__device__ __forceinline__ float wave_max(float v, int lane) { return lane_bcast(wave_incl_max(v, lane), 63); }
__device__ __forceinline__ float logsigmoidf_(float x) { return fminf(x, 0.f) - log1pf(__expf(-fabsf(x))); }
__device__ __forceinline__ int crow32(int r, int hi) { return (r & 3) + 8 * (r >> 2) + 4 * hi; }
__device__ __forceinline__ void unpack8(const v4u w, float (&f)[8]) {
    f[0] = bflo(w.x); f[1] = bfhi(w.x); f[2] = bflo(w.y); f[3] = bfhi(w.y); f[4] = bflo(w.z); f[5] = bfhi(w.z); f[6] = bflo(w.w); f[7] = bfhi(w.w);
}
__device__ __forceinline__ v4u pack8(const float (&f)[8]) { v4u w; w.x = pk2(f[0], f[1]); w.y = pk2(f[2], f[3]); w.z = pk2(f[4], f[5]); w.w = pk2(f[6], f[7]); return w; }

__device__ __forceinline__ f32x16 mma_tile(const LAS bf16* A, int lda, const LAS bf16* Bt, int ldb, int K, int lane) {
    const int r = lane & 31, hh = lane >> 5; f32x16 acc = {};
    const LAS bf16* ap = A + r * lda + 8 * hh; const LAS bf16* bp = Bt + r * ldb + 8 * hh;
    for (int k0 = 0; k0 < K; k0 += 16) {
        const bf16x8 a = *(const LAS bf16x8*)(ap + k0), b = *(const LAS bf16x8*)(bp + k0);
        acc = __builtin_amdgcn_mfma_f32_32x32x16_bf16(a, b, acc, 0, 0, 0);
    }
    return acc;
}

__device__ __forceinline__ f32x16 mma_tile_acc(f32x16 acc, const LAS bf16* A, int lda, const LAS bf16* Bt, int ldb, int K, int lane) {
    const int r = lane & 31, hh = lane >> 5;
    const LAS bf16* ap = A + r * lda + 8 * hh; const LAS bf16* bp = Bt + r * ldb + 8 * hh;
    for (int k0 = 0; k0 < K; k0 += 16) {
        const bf16x8 a = *(const LAS bf16x8*)(ap + k0), b = *(const LAS bf16x8*)(bp + k0);
        acc = __builtin_amdgcn_mfma_f32_32x32x16_bf16(a, b, acc, 0, 0, 0);
    }
    return acc;
}

__device__ __forceinline__ int cvt_dst_row(int mode, int row0, int n) {
    if (mode == 0) return row0 + n;
    if (mode == 1) return row0 + 2 * n;
    if (mode == 2) return row0 + (n & ~63) + 2 * (n & 31) + ((n >> 5) & 1);
    if (mode == 4) return row0 + ((n >> 7) << 8) + (n & 127);
    const int blk = n / 192, p = n - blk * 192;
    return row0 + blk * 192 + (p < 128 ? p : 128 + 2 * ((p - 128) & 31) + ((p - 128) >> 5));
}
struct CvtJob { const float* W; int ldw, K, src_col0, ncols; bf16* WT; int ldd, row0, mode; const float* gain; };
__device__ __forceinline__ void cvt_item(const CvtJob& J, LAS float* scr, int item, int lane) {
    const int nblk = J.ncols / 32, kb = item / nblk, nb = item - kb * nblk, k0 = 64 * kb, n0 = 32 * nb;
    const float* src = J.W + (size_t)(k0 + (lane >> 5)) * J.ldw + J.src_col0 + n0 + (lane & 31);
    float v[32];
#pragma unroll
    for (int i = 0; i < 32; ++i) v[i] = src[(size_t)(2 * i) * J.ldw];
    const int c = lane & 7;
    f32x4 g0 = {1.f, 1.f, 1.f, 1.f}, g1 = {1.f, 1.f, 1.f, 1.f};
    if (J.gain) { g0 = *(const f32x4*)(J.gain + k0 + 8 * c); g1 = *(const f32x4*)(J.gain + k0 + 8 * c + 4); }
#pragma unroll
    for (int i = 0; i < 32; ++i) scr[(2 * i + (lane >> 5)) * 33 + (lane & 31)] = v[i];
    LDS_WAIT(); asm volatile("" ::: "memory");
#pragma unroll
    for (int j = 0; j < 4; ++j) { const int n = (lane >> 3) + 8 * j; const LAS float* s = scr + (8 * c) * 33 + n;
        v4u o; o.x = pk2(s[0 * 33] * g0[0], s[1 * 33] * g0[1]); o.y = pk2(s[2 * 33] * g0[2], s[3 * 33] * g0[3]); o.z = pk2(s[4 * 33] * g1[0], s[5 * 33] * g1[1]); o.w = pk2(s[6 * 33] * g1[2], s[7 * 33] * g1[3]);
        *(GAS v4u*)(J.WT + (size_t)cvt_dst_row(J.mode, J.row0, n0 + n) * J.ldd + k0 + 8 * c) = o; }
    LDS_WAIT(); asm volatile("" ::: "memory");
}
__device__ __forceinline__ void cvt_job(Frame& F, const CvtJob& J, int& base) {
    LAS float* scr = (LAS float*)(F.lds + F.wave * 16384);
    const int gw = F.vcu * 8 + F.wave, NGW = F.G * 8, nitems = (J.K / 64) * (J.ncols / 32);
    int first = (gw - base) % NGW; if (first < 0) first += NGW;
    for (int it = first; it < nitems; it += NGW) cvt_item(J, scr, it, F.lane);
    base += nitems;
}

namespace att {
#ifdef PROBE_ATT
__device__ unsigned long long* att_probe_acc;
#endif
using bf16x8 = __attribute__((ext_vector_type(8))) short;
using s16x4  = __attribute__((ext_vector_type(4))) short;
using f32x16 = __attribute__((ext_vector_type(16))) float;
using u32x4  = __attribute__((ext_vector_type(4))) unsigned;
constexpr int NW = 8, QBLK = 32, KVBLK = 64;
constexpr float SCALE = 0.07216878364870322f;
constexpr float THR = 8.f;
constexpr int LDQ = 768, LDKN = 512, LDKR = 64, LDV = 512, LDO = 1280;
constexpr int SHM_V = KVBLK * 128 * 2, SHM_KN = KVBLK * 128 * 2, SHM_KR = KVBLK * 64 * 2;
constexpr int OFF_V = 0, OFF_KN = 2 * SHM_V, OFF_KR = OFF_KN + 2 * SHM_KN, OFF_WS = OFF_KR + 2 * SHM_KR, OFF_QR = OFF_WS + NW * 64 * 4, NQR = ATT_NQR, QR_PITCH = (12 - NQR) * 32 + 16, QR_WAVE = 32 * QR_PITCH, SHM_ATTN = OFF_QR + NW * QR_WAVE;
#define KSWZ(row, colB) ((row) * 256 + ((colB) ^ ((((row) & 7) | ((((row) >> 4) & 1) << 3)) << 4)))
#define KRSWZ(row, colB) ((row) * 128 + ((colB) ^ ((((row) >> 1) & 7) << 4)))
#define SBAR() __builtin_amdgcn_sched_barrier(0)
__device__ __forceinline__ int crow(int r, int hi) { return (r & 3) + 8 * (r >> 2) + 4 * hi; }
__device__ __forceinline__ unsigned cvtpk(float lo, float hi) { unsigned r; asm volatile("v_cvt_pk_bf16_f32 %0, %1, %2" : "=v"(r) : "v"(lo), "v"(hi)); return r; }

__device__ __forceinline__ void partialSM(f32x16& p0, f32x16& p1, float& m_reg, float& mn, float& alpha) {
#ifdef ATT_X_NOVALU
  mn = m_reg; alpha = 1.f; return;
#endif
  constexpr float C = SCALE * 1.4426950408889634f;
  float pmax = p0[0];
#pragma unroll
  for (int r = 1; r < 16; ++r) pmax = fmaxf(pmax, p0[r]);
#pragma unroll
  for (int r = 0; r < 16; ++r) pmax = fmaxf(pmax, p1[r]);
  { auto rr = __builtin_amdgcn_permlane32_swap(__float_as_uint(pmax), __float_as_uint(pmax), false, false);
    pmax = fmaxf(__uint_as_float(rr[0]), __uint_as_float(rr[1])); }
  if (__builtin_expect(__all(pmax - m_reg <= THR / SCALE), 1)) { mn = m_reg; alpha = 1.f; }
  else { mn = fmaxf(m_reg, pmax); alpha = __builtin_amdgcn_exp2f((m_reg - mn) * C); m_reg = mn; }
  float mnC = -mn * C;
#pragma unroll
  for (int r = 0; r < 16; ++r) p0[r] = fmaf(p0[r], C, mnC);
#pragma unroll
  for (int r = 0; r < 16; ++r) p1[r] = fmaf(p1[r], C, mnC);
#pragma unroll
  for (int r = 0; r < 16; ++r) p0[r] = __builtin_amdgcn_exp2f(p0[r]);
}
__device__ __forceinline__ void finishSM(f32x16& p0, f32x16& p1, float alpha, float& l_reg, bf16x8& pa0, bf16x8& pa1, bf16x8& pa2, bf16x8& pa3) {
#ifdef ATT_X_NOVALU
  { f32x4 t0 = {p0[0], p0[1], p0[2], p0[3]}, t1 = {p0[4], p0[5], p0[6], p0[7]}, t2 = {p1[0], p1[1], p1[2], p1[3]}, t3 = {p1[4], p1[5], p1[6], p1[7]};
    pa0 = __builtin_bit_cast(bf16x8, t0); pa1 = __builtin_bit_cast(bf16x8, t1); pa2 = __builtin_bit_cast(bf16x8, t2); pa3 = __builtin_bit_cast(bf16x8, t3); return; }
#endif
#pragma unroll
  for (int r = 0; r < 16; ++r) p1[r] = __builtin_amdgcn_exp2f(p1[r]);
  float ps = 0;
#pragma unroll
  for (int r = 0; r < 16; ++r) ps += p0[r];
#pragma unroll
  for (int r = 0; r < 16; ++r) ps += p1[r];
  { auto rr = __builtin_amdgcn_permlane32_swap(__float_as_uint(ps), __float_as_uint(ps), false, false);
    ps = __uint_as_float(rr[0]) + __uint_as_float(rr[1]); }
  l_reg = l_reg * alpha + ps;
#define PK4(P, BASE, OUT) do { unsigned a0 = cvtpk(P[BASE + 0], P[BASE + 1]), a1 = cvtpk(P[BASE + 2], P[BASE + 3]);   \
    unsigned b0 = cvtpk(P[BASE + 4], P[BASE + 5]), b1 = cvtpk(P[BASE + 6], P[BASE + 7]);                              \
    auto r0 = __builtin_amdgcn_permlane32_swap(a0, b0, false, false); auto r1 = __builtin_amdgcn_permlane32_swap(a1, b1, false, false); \
    u32x4 w = {r0[0], r1[0], r0[1], r1[1]}; OUT = *reinterpret_cast<bf16x8*>(&w); } while (0)
  PK4(p0, 0, pa0); PK4(p0, 8, pa1); PK4(p1, 0, pa2); PK4(p1, 8, pa3);
#undef PK4
}
#define QK_FENCE() __builtin_amdgcn_sched_barrier(0x2 | 0x4 | 0x400)
template <int D0> __device__ __forceinline__ void qk_frag(bf16x8& b0, bf16x8& b1, bf16x8& qv, const char* KNs, const char* KRs, const char* qrl, int r32, int hi) {
#ifdef ATT_X_NOLDSR
  { asm volatile("" : "=v"(b0), "=v"(b1), "=v"(qv)); return; }
#endif
  if constexpr (D0 < 8) { const int cb = (D0 * 16 + hi * 8) * 2;
    b0 = *reinterpret_cast<const bf16x8*>(KNs + KSWZ(r32, cb)); b1 = *reinterpret_cast<const bf16x8*>(KNs + KSWZ(32 + r32, cb));
  } else { const int cb = ((D0 - 8) * 16 + hi * 8) * 2;
    b0 = *reinterpret_cast<const bf16x8*>(KRs + KRSWZ(r32, cb)); b1 = *reinterpret_cast<const bf16x8*>(KRs + KRSWZ(32 + r32, cb)); }
  if constexpr (D0 >= NQR) qv = *reinterpret_cast<const bf16x8*>(qrl + (D0 - NQR) * 32);
}
template <int D0> __device__ __forceinline__ void qk_step(f32x16& p0, f32x16& p1, bf16x8 (&b0)[2], bf16x8 (&b1)[2], bf16x8 (&qv)[2], const char* KNs, const char* KRs, const bf16x8* qr, const char* qrl, int r32, int hi) {
  if constexpr (D0 + 1 < 12) qk_frag<D0 + 1>(b0[(D0 + 1) & 1], b1[(D0 + 1) & 1], qv[(D0 + 1) & 1], KNs, KRs, qrl, r32, hi);
  QK_FENCE();
  bf16x8 q; if constexpr (D0 < NQR) q = qr[D0]; else q = qv[D0 & 1];
  p0 = __builtin_amdgcn_mfma_f32_32x32x16_bf16(b0[D0 & 1], q, p0, 0, 0, 0);
  p1 = __builtin_amdgcn_mfma_f32_32x32x16_bf16(b1[D0 & 1], q, p1, 0, 0, 0);
  QK_FENCE();
}
#if ATT_QKPIPE
__device__ __forceinline__ void qkt(f32x16& p0, f32x16& p1, const char* KNs, const char* KRs, const bf16x8* qr, const char* qrl, int r32, int hi) {
  p0 = f32x16{}; p1 = f32x16{};
  bf16x8 b0[2], b1[2], qv[2];
  qk_frag<0>(b0[0], b1[0], qv[0], KNs, KRs, qrl, r32, hi);
  qk_step<0>(p0, p1, b0, b1, qv, KNs, KRs, qr, qrl, r32, hi); qk_step<1>(p0, p1, b0, b1, qv, KNs, KRs, qr, qrl, r32, hi);
  qk_step<2>(p0, p1, b0, b1, qv, KNs, KRs, qr, qrl, r32, hi); qk_step<3>(p0, p1, b0, b1, qv, KNs, KRs, qr, qrl, r32, hi);
  qk_step<4>(p0, p1, b0, b1, qv, KNs, KRs, qr, qrl, r32, hi); qk_step<5>(p0, p1, b0, b1, qv, KNs, KRs, qr, qrl, r32, hi);
  qk_step<6>(p0, p1, b0, b1, qv, KNs, KRs, qr, qrl, r32, hi); qk_step<7>(p0, p1, b0, b1, qv, KNs, KRs, qr, qrl, r32, hi);
  qk_step<8>(p0, p1, b0, b1, qv, KNs, KRs, qr, qrl, r32, hi); qk_step<9>(p0, p1, b0, b1, qv, KNs, KRs, qr, qrl, r32, hi);
  qk_step<10>(p0, p1, b0, b1, qv, KNs, KRs, qr, qrl, r32, hi); qk_step<11>(p0, p1, b0, b1, qv, KNs, KRs, qr, qrl, r32, hi);
}
#else
__device__ __forceinline__ void qkt(f32x16& p0, f32x16& p1, const char* KNs, const char* KRs, const bf16x8* qr, const char* qrl, int r32, int hi) {
  p0 = f32x16{}; p1 = f32x16{};
#pragma unroll
  for (int d0 = 0; d0 < 8; ++d0) { int cb = (d0 * 16 + hi * 8) * 2;
    bf16x8 b0 = *reinterpret_cast<const bf16x8*>(KNs + KSWZ(r32, cb));
    bf16x8 b1 = *reinterpret_cast<const bf16x8*>(KNs + KSWZ(32 + r32, cb));
    bf16x8 qv; if (d0 < NQR) qv = qr[d0]; else qv = *reinterpret_cast<const bf16x8*>(qrl + (d0 - NQR) * 32);
    p0 = __builtin_amdgcn_mfma_f32_32x32x16_bf16(b0, qv, p0, 0, 0, 0);
    p1 = __builtin_amdgcn_mfma_f32_32x32x16_bf16(b1, qv, p1, 0, 0, 0); }
#pragma unroll
  for (int d0 = 8; d0 < 12; ++d0) { int cb = ((d0 - 8) * 16 + hi * 8) * 2;
    bf16x8 b0 = *reinterpret_cast<const bf16x8*>(KRs + KRSWZ(r32, cb));
    bf16x8 b1 = *reinterpret_cast<const bf16x8*>(KRs + KRSWZ(32 + r32, cb));
    bf16x8 qv; if (d0 < NQR) qv = qr[d0]; else qv = *reinterpret_cast<const bf16x8*>(qrl + (d0 - NQR) * 32);
    p0 = __builtin_amdgcn_mfma_f32_32x32x16_bf16(b0, qv, p0, 0, 0, 0);
    p1 = __builtin_amdgcn_mfma_f32_32x32x16_bf16(b1, qv, p1, 0, 0, 0); }
}
#endif
__device__ __forceinline__ int v_st(int k, int c) { const int kk = (k & ~0xC) | ((k & 4) << 1) | ((k & 8) >> 1); return ((kk >> 3) * 4 + (c >> 5)) * 512 + ((kk & 7) * 32 + (c & 31)) * 2; }
__device__ __forceinline__ int v_rd_base(int lane) { return ((lane & 3) << 3) | (((lane >> 2) & 3) << 6) | (((lane >> 4) & 1) << 5) | (((lane >> 5) & 1) << 8); }
constexpr int v_rd_off(int d0, int ks, int half) { return d0 * 512 + ks * 4096 + half * 2048; }
template <int OFF> __device__ __forceinline__ s16x4 tr_read(int vb) {
  s16x4 r; asm volatile("ds_read_b64_tr_b16 %0, %1 offset:%2" : "=&v"(r) : "v"(vb), "i"(OFF) : "memory"); return r;
}
template <int D0> __device__ __forceinline__ void pv_one(f32x16& od, int vb, bf16x8 pa0, bf16x8 pa1, bf16x8 pa2, bf16x8 pa3) {
#ifdef ATT_X_NOLDSR
  { od = __builtin_amdgcn_mfma_f32_32x32x16_bf16(pa0, pa1, od, 0, 0, 0); od = __builtin_amdgcn_mfma_f32_32x32x16_bf16(pa1, pa2, od, 0, 0, 0); od = __builtin_amdgcn_mfma_f32_32x32x16_bf16(pa2, pa3, od, 0, 0, 0); od = __builtin_amdgcn_mfma_f32_32x32x16_bf16(pa3, pa0, od, 0, 0, 0); return; }
#endif
  const s16x4 l0 = tr_read<v_rd_off(D0, 0, 0)>(vb), h0 = tr_read<v_rd_off(D0, 0, 1)>(vb), l1 = tr_read<v_rd_off(D0, 1, 0)>(vb), h1 = tr_read<v_rd_off(D0, 1, 1)>(vb);
  const s16x4 l2 = tr_read<v_rd_off(D0, 2, 0)>(vb), h2 = tr_read<v_rd_off(D0, 2, 1)>(vb), l3 = tr_read<v_rd_off(D0, 3, 0)>(vb), h3 = tr_read<v_rd_off(D0, 3, 1)>(vb);
  asm volatile("s_waitcnt lgkmcnt(0)" ::: "memory"); SBAR();
#define PK(L, H) (bf16x8){L[0], L[1], L[2], L[3], H[0], H[1], H[2], H[3]}
  od = __builtin_amdgcn_mfma_f32_32x32x16_bf16(pa0, PK(l0, h0), od, 0, 0, 0);
  od = __builtin_amdgcn_mfma_f32_32x32x16_bf16(pa1, PK(l1, h1), od, 0, 0, 0);
  od = __builtin_amdgcn_mfma_f32_32x32x16_bf16(pa2, PK(l2, h2), od, 0, 0, 0);
  od = __builtin_amdgcn_mfma_f32_32x32x16_bf16(pa3, PK(l3, h3), od, 0, 0, 0);
#undef PK
}
__device__ __forceinline__ void pv_d0(f32x16* o, int vb, bf16x8 pa0, bf16x8 pa1, bf16x8 pa2, bf16x8 pa3) {
  pv_one<0>(o[0], vb, pa0, pa1, pa2, pa3); pv_one<1>(o[1], vb, pa0, pa1, pa2, pa3); pv_one<2>(o[2], vb, pa0, pa1, pa2, pa3); pv_one<3>(o[3], vb, pa0, pa1, pa2, pa3);
}

template <int SDEPTH>
__device__ __forceinline__ void attn_dense_body(const bf16* __restrict__ Qb, const bf16* __restrict__ KNh, const bf16* __restrict__ KRb, const bf16* __restrict__ Vh,
                                                bf16* __restrict__ Ob, int seq, char* lds, const int wv) {
  const int tid = opaque_tid(wv), wid = tid >> 6, lane = tid & 63, r32 = lane & 31, hi = lane >> 5;
  char* V_lds = lds + OFF_V; char* KN_lds = lds + OFF_KN; char* KR_lds = lds + OFF_KR;
  float* ws = (float*)(lds + OFF_WS) + wid * 64; float* li_l = ws; float* al_l = ws + 32;
  float m_reg = -1e30f, l_reg = 0; f32x16 o[4] = {}; bf16x8 qr[NQR];
  const bf16* Qw = Qb + (long)(wid * QBLK + r32) * LDQ + hi * 8;
#pragma unroll
  for (int d0 = 0; d0 < NQR; ++d0) qr[d0] = *reinterpret_cast<const bf16x8*>(Qw + d0 * 16);
  char* qrl = lds + OFF_QR + wid * QR_WAVE + r32 * QR_PITCH + hi * 16;
#pragma unroll
  for (int d0 = NQR; d0 < 12; ++d0) *reinterpret_cast<bf16x8*>(qrl + (d0 - NQR) * 32) = *reinterpret_cast<const bf16x8*>(Qw + d0 * 16);
  const int sr = tid >> 4, sc = (tid & 15) * 8, vst0 = v_st(sr, sc), vst1 = v_st(32 + sr, sc);
  const int rr_ = tid >> 3, rc = (tid & 7) * 8;
  const int vb0 = (int)(uintptr_t)V_lds + v_rd_base(lane);
  struct { bf16x8 vs0, vs1, ks0, ks1, kr; } sr_[SDEPTH];
#define SLOAD(i, k0) do { sr_[i].vs0 = *reinterpret_cast<const bf16x8*>(&Vh[(long)((k0) + sr) * LDV + sc]); sr_[i].vs1 = *reinterpret_cast<const bf16x8*>(&Vh[(long)((k0) + 32 + sr) * LDV + sc]); \
    sr_[i].ks0 = *reinterpret_cast<const bf16x8*>(&KNh[(long)((k0) + sr) * LDKN + sc]); sr_[i].ks1 = *reinterpret_cast<const bf16x8*>(&KNh[(long)((k0) + 32 + sr) * LDKN + sc]); \
    sr_[i].kr = *reinterpret_cast<const bf16x8*>(&KRb[(long)((k0) + rr_) * LDKR + rc]); } while (0)
#define SWRITE(b, i) do { *(bf16x8*)(V_lds + (b) * SHM_V + vst0) = sr_[i].vs0; *(bf16x8*)(V_lds + (b) * SHM_V + vst1) = sr_[i].vs1; int kc = sc * 2; \
    *(bf16x8*)(KN_lds + (b) * SHM_KN + KSWZ(sr, kc)) = sr_[i].ks0; *(bf16x8*)(KN_lds + (b) * SHM_KN + KSWZ(32 + sr, kc)) = sr_[i].ks1; \
    *(bf16x8*)(KR_lds + (b) * SHM_KR + KRSWZ(rr_, rc * 2)) = sr_[i].kr; } while (0)
#define SWAIT() do { if constexpr (SDEPTH == 2) asm volatile("s_waitcnt vmcnt(5)" ::: "memory"); else asm volatile("s_waitcnt vmcnt(0)" ::: "memory"); } while (0)
#define RESC(a) do { if (__any((a) < 1.f)) { if (hi == 0) al_l[r32] = (a); asm volatile("s_waitcnt lgkmcnt(0)" ::: "memory"); \
    _Pragma("unroll") for (int d = 0; d < 4; ++d) _Pragma("unroll") for (int r = 0; r < 16; ++r) o[d][r] *= al_l[crow(r, hi)]; } } while (0)
  f32x16 pA0, pA1, pB0, pB1; float mnA, mnB, alA, alB; bf16x8 pa0, pa1, pa2, pa3; const int NT = seq / KVBLK;
#if ATT_PRIO
  if (wv >= 4) __builtin_amdgcn_s_setprio(1);
#endif
#if ATT_V2
#if ATT_DMA
  unsigned offKN[2], offV[2], offKR;
#pragma unroll
  for (int i = 0; i < 2; ++i) { const int q = (wid * 2 + i) * 64 + lane; { const int row = q >> 4, slot = q & 15, f = (row & 7) | (((row >> 4) & 1) << 3); offKN[i] = (unsigned)(row * LDKN + ((slot ^ f) << 3)) * 2u; }
    { const int sub = q >> 5, kk = (sub >> 2) * 8 + ((q >> 2) & 7), cc = (sub & 3) * 32 + (q & 3) * 8, k = (kk & ~0xC) | ((kk & 4) << 1) | ((kk & 8) >> 1); offV[i] = (unsigned)(k * LDV + cc) * 2u; } }
  { const int q = wid * 64 + lane, row = q >> 3, slot = q & 7; offKR = (unsigned)(row * LDKR + ((slot ^ ((row >> 1) & 7)) << 3)) * 2u; }
  typedef __attribute__((address_space(3))) unsigned lds_u32;
#define DMA16(gp, ldsp) __builtin_amdgcn_global_load_lds((const unsigned*)(gp), (lds_u32*)(ldsp), 16, 0, 0)
#define SLOADK_TO(k0, b) do { const char* kb_ = (const char*)KNh + (size_t)(k0) * (LDKN * 2); const char* rb_ = (const char*)KRb + (size_t)(k0) * (LDKR * 2); \
    DMA16(kb_ + offKN[0], KN_lds + (b) * SHM_KN + (wid * 2 + 0) * 1024); DMA16(kb_ + offKN[1], KN_lds + (b) * SHM_KN + (wid * 2 + 1) * 1024); DMA16(rb_ + offKR, KR_lds + (b) * SHM_KR + wid * 1024); } while (0)
#define SLOADV_TO(k0, b) do { const char* vb_ = (const char*)Vh + (size_t)(k0) * (LDV * 2); \
    DMA16(vb_ + offV[0], V_lds + (b) * SHM_V + (wid * 2 + 0) * 1024); DMA16(vb_ + offV[1], V_lds + (b) * SHM_V + (wid * 2 + 1) * 1024); } while (0)
#define SLOADK(k0) do { } while (0)
#define SLOADV(k0) do { } while (0)
#define SWRITEK(b) do { } while (0)
#define SWRITEV(b) do { } while (0)
#else
#ifdef ATT_X_NOSTAGE
#define SLOADK_TO(k0, b) do { } while (0)
#define SLOADV_TO(k0, b) do { } while (0)
#else
#define SLOADK_TO(k0, b) SLOADK(k0)
#define SLOADV_TO(k0, b) SLOADV(k0)
#endif
#define SLOADK(k0) do { sr_[0].ks0 = *reinterpret_cast<const bf16x8*>(&KNh[(long)((k0) + sr) * LDKN + sc]); sr_[0].ks1 = *reinterpret_cast<const bf16x8*>(&KNh[(long)((k0) + 32 + sr) * LDKN + sc]); \
    sr_[0].kr = *reinterpret_cast<const bf16x8*>(&KRb[(long)((k0) + rr_) * LDKR + rc]); } while (0)
#define SLOADV(k0) do { sr_[0].vs0 = *reinterpret_cast<const bf16x8*>(&Vh[(long)((k0) + sr) * LDV + sc]); sr_[0].vs1 = *reinterpret_cast<const bf16x8*>(&Vh[(long)((k0) + 32 + sr) * LDV + sc]); } while (0)
#define SWRITEK(b) do { const int kc = sc * 2; *(bf16x8*)(KN_lds + (b) * SHM_KN + KSWZ(sr, kc)) = sr_[0].ks0; *(bf16x8*)(KN_lds + (b) * SHM_KN + KSWZ(32 + sr, kc)) = sr_[0].ks1; \
    *(bf16x8*)(KR_lds + (b) * SHM_KR + KRSWZ(rr_, rc * 2)) = sr_[0].kr; } while (0)
#define SWRITEV(b) do { *(bf16x8*)(V_lds + (b) * SHM_V + vst0) = sr_[0].vs0; *(bf16x8*)(V_lds + (b) * SHM_V + vst1) = sr_[0].vs1; } while (0)
#endif
#define VWAIT() asm volatile("s_waitcnt vmcnt(0)" ::: "memory")
#ifdef ATT_X_NOSTAGE
#undef SWRITEK
#undef SWRITEV
#define SWRITEK(b) do { } while (0)
#define SWRITEV(b) do { } while (0)
#endif
  SLOADK_TO(0, 0); VWAIT(); SWRITEK(0); __syncthreads();
  qkt(pA0, pA1, KN_lds, KR_lds, qr, qrl, r32, hi);
  SLOADK_TO(KVBLK, 1); SLOADV_TO(0, 0); SBAR();
  partialSM(pA0, pA1, m_reg, mnA, alA);
  VWAIT(); SWRITEK(1); SWRITEV(0);
  __syncthreads();
  for (int j = 1; j + 1 < NT; j += 2) {
#ifdef PROBE_ATT
    unsigned long long pt_[5]; const bool pw_ = (blockIdx.x == 0 && tid == 0);
#define PT_(i) do { if (pw_) pt_[i] = __builtin_amdgcn_s_memtime(); } while (0)
#else
#define PT_(i) do { } while (0)
#endif
    PT_(0);
    SBAR(); qkt(pB0, pB1, KN_lds + SHM_KN, KR_lds + SHM_KR, qr, qrl, r32, hi);
    finishSM(pA0, pA1, alA, l_reg, pa0, pa1, pa2, pa3); SBAR();
    PT_(1);
    SLOADK_TO((j + 1) * KVBLK, 0); SLOADV_TO(j * KVBLK, 1); SBAR();
    pv_d0(o, vb0, pa0, pa1, pa2, pa3); partialSM(pB0, pB1, m_reg, mnB, alB);
    PT_(2);
    VWAIT();
    PT_(3);
    SWRITEK(0); SWRITEV(1);
    RESC(alB);
#ifndef ATT_X_NOBAR
    __syncthreads();
#endif
    PT_(4);
#ifdef PROBE_ATT
    if (pw_) { volatile unsigned long long* acc_ = (volatile unsigned long long*)att_probe_acc; for (int q_ = 0; q_ < 4; ++q_) acc_[q_] += pt_[q_ + 1] - pt_[q_]; }
#endif
#undef PT_
    SBAR(); qkt(pA0, pA1, KN_lds, KR_lds, qr, qrl, r32, hi);
    finishSM(pB0, pB1, alB, l_reg, pa0, pa1, pa2, pa3); SBAR();
    SLOADK_TO((j + 2) * KVBLK, 1); SLOADV_TO((j + 1) * KVBLK, 0); SBAR();
    pv_d0(o, vb0 + SHM_V, pa0, pa1, pa2, pa3); partialSM(pA0, pA1, m_reg, mnA, alA);
    VWAIT(); SWRITEK(1); SWRITEV(0);
    RESC(alA);
#ifndef ATT_X_NOBAR
    __syncthreads();
#endif
  }
  SBAR(); qkt(pB0, pB1, KN_lds + SHM_KN, KR_lds + SHM_KR, qr, qrl, r32, hi);
  finishSM(pA0, pA1, alA, l_reg, pa0, pa1, pa2, pa3); SBAR();
  SLOADV_TO((NT - 1) * KVBLK, 1); SBAR();
  pv_d0(o, vb0, pa0, pa1, pa2, pa3); partialSM(pB0, pB1, m_reg, mnB, alB);
  VWAIT(); SWRITEV(1); RESC(alB); __syncthreads();
  finishSM(pB0, pB1, alB, l_reg, pa0, pa1, pa2, pa3); SBAR();
  pv_d0(o, vb0 + SHM_V, pa0, pa1, pa2, pa3);
#undef SLOADK
#undef SLOADV
#undef SWRITEK
#undef SWRITEV
#undef VWAIT
#undef SLOADK_TO
#undef SLOADV_TO
#else
  constexpr int SE = 0, SO = SDEPTH - 1;
  SLOAD(SE, 0); asm volatile("s_waitcnt vmcnt(0)" ::: "memory"); SWRITE(0, SE); __syncthreads();
  qkt(pA0, pA1, KN_lds, KR_lds, qr, qrl, r32, hi); partialSM(pA0, pA1, m_reg, mnA, alA);
  SLOAD(SO, KVBLK); if constexpr (SDEPTH == 2) { if (2 < NT) SLOAD(SE, 2 * KVBLK); }
  SWAIT(); SWRITE(1, SO); __syncthreads();
  for (int j = 1; j + 1 < NT; j += 2) {
    SBAR(); qkt(pB0, pB1, KN_lds + SHM_KN, KR_lds + SHM_KR, qr, qrl, r32, hi);
    finishSM(pA0, pA1, alA, l_reg, pa0, pa1, pa2, pa3); SBAR();
    SLOAD(SO, (j + SDEPTH) * KVBLK); SBAR();
    pv_d0(o, vb0, pa0, pa1, pa2, pa3); partialSM(pB0, pB1, m_reg, mnB, alB);
    __syncthreads(); SWAIT(); SWRITE(0, SE);
    RESC(alB); __syncthreads();
    SBAR(); qkt(pA0, pA1, KN_lds, KR_lds, qr, qrl, r32, hi);
    finishSM(pB0, pB1, alB, l_reg, pa0, pa1, pa2, pa3); SBAR();
    if (SDEPTH == 1 || j + 3 < NT) SLOAD(SE, (j + 1 + SDEPTH) * KVBLK); SBAR();
    pv_d0(o, vb0 + SHM_V, pa0, pa1, pa2, pa3); partialSM(pA0, pA1, m_reg, mnA, alA);
    __syncthreads(); SWAIT(); SWRITE(1, SO);
    RESC(alA); __syncthreads();
  }
  SBAR(); qkt(pB0, pB1, KN_lds + SHM_KN, KR_lds + SHM_KR, qr, qrl, r32, hi);
  finishSM(pA0, pA1, alA, l_reg, pa0, pa1, pa2, pa3); SBAR();
  pv_d0(o, vb0, pa0, pa1, pa2, pa3); partialSM(pB0, pB1, m_reg, mnB, alB);
  __syncthreads(); RESC(alB);
  finishSM(pB0, pB1, alB, l_reg, pa0, pa1, pa2, pa3); SBAR();
  pv_d0(o, vb0 + SHM_V, pa0, pa1, pa2, pa3);
#endif
#if ATT_PRIO
  __builtin_amdgcn_s_setprio(0);
#endif
  if (hi == 0) li_l[r32] = l_reg; asm volatile("s_waitcnt lgkmcnt(0)" ::: "memory");
  float rli[16];
#pragma unroll
  for (int r = 0; r < 16; ++r) rli[r] = __builtin_amdgcn_rcpf(li_l[crow(r, hi)]);
  bf16* Ow = Ob + (long)(wid * QBLK) * LDO;
  __syncthreads();
  { char* ost = lds + wid * (32 * 272);
#pragma unroll
    for (int r = 0; r < 16; ++r) { const int orow = crow(r, hi);
#pragma unroll
      for (int d0 = 0; d0 < 4; ++d0) *reinterpret_cast<bf16*>(ost + orow * 272 + (d0 * 32 + r32) * 2) = (bf16)f2bf(o[d0][r] * rli[r]); }
    asm volatile("s_waitcnt lgkmcnt(0)" ::: "memory");
#pragma unroll
    for (int i = 0; i < 8; ++i) { const int ch = i * 64 + lane, row = ch >> 4, c16 = ch & 15;
      const u32x4 v = *reinterpret_cast<const u32x4*>(ost + row * 272 + c16 * 16);
      *reinterpret_cast<u32x4*>(Ow + (long)row * LDO + c16 * 8) = v; }
  }
  __syncthreads();
#undef SLOAD
#undef SWRITE
#undef SWAIT
#undef RESC
}

#define PK4F(P, BASE, OUT) do { unsigned a0 = cvtpk(P[BASE + 0], P[BASE + 1]), a1 = cvtpk(P[BASE + 2], P[BASE + 3]);   \
    unsigned b0 = cvtpk(P[BASE + 4], P[BASE + 5]), b1 = cvtpk(P[BASE + 6], P[BASE + 7]);                              \
    auto r0 = __builtin_amdgcn_permlane32_swap(a0, b0, false, false); auto r1 = __builtin_amdgcn_permlane32_swap(a1, b1, false, false); \
    u32x4 w = {r0[0], r1[0], r0[1], r1[1]}; OUT = *reinterpret_cast<bf16x8*>(&w); } while (0)
template <int D0> __device__ __forceinline__ void fin_chunk(f32x16& q0, f32x16& q1, float alpha, float& l_reg, float& ps, bf16x8& pa0, bf16x8& pa1, bf16x8& pa2, bf16x8& pa3) {
  if constexpr (D0 < 8) { q1[2 * D0] = __builtin_amdgcn_exp2f(q1[2 * D0]); q1[2 * D0 + 1] = __builtin_amdgcn_exp2f(q1[2 * D0 + 1]); }
  if constexpr (D0 < 4) { ps += (q0[4 * D0] + q0[4 * D0 + 1]) + (q0[4 * D0 + 2] + q0[4 * D0 + 3]); }
  if constexpr (D0 == 4) PK4F(q0, 0, pa0);
  if constexpr (D0 == 5) PK4F(q0, 8, pa1);
  if constexpr (D0 == 8) { ps += ((q1[0] + q1[1]) + (q1[2] + q1[3])) + ((q1[4] + q1[5]) + (q1[6] + q1[7])); PK4F(q1, 0, pa2); }
  if constexpr (D0 == 9) { ps += ((q1[8] + q1[9]) + (q1[10] + q1[11])) + ((q1[12] + q1[13]) + (q1[14] + q1[15])); PK4F(q1, 8, pa3); }
  if constexpr (D0 == 10) { auto rr = __builtin_amdgcn_permlane32_swap(__float_as_uint(ps), __float_as_uint(ps), false, false);
    l_reg = l_reg * alpha + (__uint_as_float(rr[0]) + __uint_as_float(rr[1])); }
}
template <int D0> __device__ __forceinline__ void qk_step_f(f32x16& p0, f32x16& p1, bf16x8 (&b0)[2], bf16x8 (&b1)[2], bf16x8 (&qv)[2], const char* KNs, const char* KRs, const bf16x8* qr, const char* qrl, int r32, int hi,
                                                          f32x16& q0, f32x16& q1, float alpha, float& l_reg, float& ps, bf16x8& pa0, bf16x8& pa1, bf16x8& pa2, bf16x8& pa3) {
  if constexpr (D0 + 1 < 12) qk_frag<D0 + 1>(b0[(D0 + 1) & 1], b1[(D0 + 1) & 1], qv[(D0 + 1) & 1], KNs, KRs, qrl, r32, hi);
  SBAR();
  bf16x8 q; if constexpr (D0 < NQR) q = qr[D0]; else q = qv[D0 & 1];
  p0 = __builtin_amdgcn_mfma_f32_32x32x16_bf16(b0[D0 & 1], q, p0, 0, 0, 0);
  p1 = __builtin_amdgcn_mfma_f32_32x32x16_bf16(b1[D0 & 1], q, p1, 0, 0, 0);
  fin_chunk<D0>(q0, q1, alpha, l_reg, ps, pa0, pa1, pa2, pa3);
  if constexpr (D0 < 8) asm volatile("" : "+v"(q1), "+v"(ps)); else asm volatile("" : "+v"(ps), "+v"(l_reg));
  if constexpr (D0 == 4) asm volatile("" : "+v"(pa0)); if constexpr (D0 == 5) asm volatile("" : "+v"(pa1)); if constexpr (D0 == 8) asm volatile("" : "+v"(pa2)); if constexpr (D0 == 9) asm volatile("" : "+v"(pa3));
  SBAR();
}
__device__ __forceinline__ void qkt_fin(f32x16& p0, f32x16& p1, const char* KNs, const char* KRs, const bf16x8* qr, const char* qrl, int r32, int hi,
                                        f32x16& q0, f32x16& q1, float alpha, float& l_reg, bf16x8& pa0, bf16x8& pa1, bf16x8& pa2, bf16x8& pa3) {
  p0 = f32x16{}; p1 = f32x16{}; float ps = 0.f;
  bf16x8 b0[2], b1[2], qv[2];
  qk_frag<0>(b0[0], b1[0], qv[0], KNs, KRs, qrl, r32, hi);
#define QSF(D) qk_step_f<D>(p0, p1, b0, b1, qv, KNs, KRs, qr, qrl, r32, hi, q0, q1, alpha, l_reg, ps, pa0, pa1, pa2, pa3)
  QSF(0); QSF(1); QSF(2); QSF(3); QSF(4); QSF(5); QSF(6); QSF(7); QSF(8); QSF(9); QSF(10); QSF(11);
#undef QSF
}
__device__ __forceinline__ void pv_part(f32x16* o, int vb, bf16x8 pa0, bf16x8 pa1, bf16x8 pa2, bf16x8 pa3, f32x16& p0, f32x16& p1, float& m_reg, float& mn, float& alpha) {
  constexpr float C = SCALE * 1.4426950408889634f;
  pv_one<0>(o[0], vb, pa0, pa1, pa2, pa3);
  { float a = fmaxf(fmaxf(p0[0], p0[1]), p1[0]), b = fmaxf(fmaxf(p0[2], p0[3]), p1[1]); a = fmaxf(fmaxf(a, p1[2]), p1[3]);
#pragma unroll
    for (int r = 4; r < 16; r += 4) { a = fmaxf(fmaxf(a, p0[r]), p0[r + 1]); b = fmaxf(fmaxf(b, p0[r + 2]), p0[r + 3]); a = fmaxf(fmaxf(a, p1[r]), p1[r + 1]); b = fmaxf(fmaxf(b, p1[r + 2]), p1[r + 3]); }
    float pmax = fmaxf(a, b);
    { auto rr = __builtin_amdgcn_permlane32_swap(__float_as_uint(pmax), __float_as_uint(pmax), false, false); pmax = fmaxf(__uint_as_float(rr[0]), __uint_as_float(rr[1])); }
    if (__builtin_expect(__all(pmax - m_reg <= THR / SCALE), 1)) { mn = m_reg; alpha = 1.f; }
    else { mn = fmaxf(m_reg, pmax); alpha = __builtin_amdgcn_exp2f((m_reg - mn) * C); m_reg = mn; } }
  asm volatile("" : "+v"(mn), "+v"(alpha)); SBAR();
  pv_one<1>(o[1], vb, pa0, pa1, pa2, pa3);
  { const float mnC = -mn * C;
#pragma unroll
    for (int r = 0; r < 16; ++r) p0[r] = fmaf(p0[r], C, mnC);
#pragma unroll
    for (int r = 0; r < 16; ++r) p1[r] = fmaf(p1[r], C, mnC); }
  asm volatile("" : "+v"(p0), "+v"(p1)); SBAR();
  pv_one<2>(o[2], vb, pa0, pa1, pa2, pa3);
#pragma unroll
  for (int r = 0; r < 8; ++r) p0[r] = __builtin_amdgcn_exp2f(p0[r]);
  asm volatile("" : "+v"(p0)); SBAR();
  pv_one<3>(o[3], vb, pa0, pa1, pa2, pa3);
#pragma unroll
  for (int r = 8; r < 16; ++r) p0[r] = __builtin_amdgcn_exp2f(p0[r]);
  asm volatile("" : "+v"(p0)); SBAR();
}


__device__ __forceinline__ void softmax_tile(f32x16& p0, f32x16& p1, float& m_reg, float& l_reg, float& alpha, bf16x8& pa0, bf16x8& pa1, bf16x8& pa2, bf16x8& pa3) {
  constexpr float C = SCALE * 1.4426950408889634f;
  float a = fmaxf(fmaxf(p0[0], p0[1]), p1[0]), b = fmaxf(fmaxf(p0[2], p0[3]), p1[1]); a = fmaxf(fmaxf(a, p1[2]), p1[3]);
#pragma unroll
  for (int r = 4; r < 16; r += 4) { a = fmaxf(fmaxf(a, p0[r]), p0[r + 1]); b = fmaxf(fmaxf(b, p0[r + 2]), p0[r + 3]); a = fmaxf(fmaxf(a, p1[r]), p1[r + 1]); b = fmaxf(fmaxf(b, p1[r + 2]), p1[r + 3]); }
  float pmax = fmaxf(a, b);
  { auto rr = __builtin_amdgcn_permlane32_swap(__float_as_uint(pmax), __float_as_uint(pmax), false, false); pmax = fmaxf(__uint_as_float(rr[0]), __uint_as_float(rr[1])); }
  float mn;
  if (__builtin_expect(__all(pmax - m_reg <= THR / SCALE), 1)) { mn = m_reg; alpha = 1.f; }
  else { mn = fmaxf(m_reg, pmax); alpha = __builtin_amdgcn_exp2f((m_reg - mn) * C); m_reg = mn; }
  const float mnC = -mn * C;
#pragma unroll
  for (int r = 0; r < 16; ++r) { p0[r] = __builtin_amdgcn_exp2f(fmaf(p0[r], C, mnC)); p1[r] = __builtin_amdgcn_exp2f(fmaf(p1[r], C, mnC)); }
  float ps = 0.f, ps2 = 0.f;
#pragma unroll
  for (int r = 0; r < 16; ++r) { ps += p0[r]; ps2 += p1[r]; }
  ps += ps2;
  { auto rr = __builtin_amdgcn_permlane32_swap(__float_as_uint(ps), __float_as_uint(ps), false, false); ps = __uint_as_float(rr[0]) + __uint_as_float(rr[1]); }
  l_reg = l_reg * alpha + ps;
#define PK4V(P, BASE, OUT) do { unsigned a0 = cvtpk(P[BASE + 0], P[BASE + 1]), a1 = cvtpk(P[BASE + 2], P[BASE + 3]);   \
    unsigned b0 = cvtpk(P[BASE + 4], P[BASE + 5]), b1 = cvtpk(P[BASE + 6], P[BASE + 7]);                              \
    auto r0 = __builtin_amdgcn_permlane32_swap(a0, b0, false, false); auto r1 = __builtin_amdgcn_permlane32_swap(a1, b1, false, false); \
    u32x4 w = {r0[0], r1[0], r0[1], r1[1]}; OUT = *reinterpret_cast<bf16x8*>(&w); } while (0)
  PK4V(p0, 0, pa0); PK4V(p0, 8, pa1); PK4V(p1, 0, pa2); PK4V(p1, 8, pa3);
#undef PK4V
}
__device__ __forceinline__ void qkt12(f32x16& p0, f32x16& p1, const char* KNs, const char* KRs, const bf16x8* qr, const char* qrl, int r32, int hi) {
  p0 = f32x16{}; p1 = f32x16{};
#pragma unroll
  for (int d0 = 0; d0 < 8; ++d0) { const int cb = (d0 * 16 + hi * 8) * 2;
    const bf16x8 b0 = *reinterpret_cast<const bf16x8*>(KNs + KSWZ(r32, cb)), b1 = *reinterpret_cast<const bf16x8*>(KNs + KSWZ(32 + r32, cb));
    p0 = __builtin_amdgcn_mfma_f32_32x32x16_bf16(b0, qr[d0], p0, 0, 0, 0); p1 = __builtin_amdgcn_mfma_f32_32x32x16_bf16(b1, qr[d0], p1, 0, 0, 0); }
#pragma unroll
  for (int d0 = 0; d0 < 4; ++d0) { const int cb = (d0 * 16 + hi * 8) * 2;
    const bf16x8 b0 = *reinterpret_cast<const bf16x8*>(KRs + KRSWZ(r32, cb)), b1 = *reinterpret_cast<const bf16x8*>(KRs + KRSWZ(32 + r32, cb));
    const bf16x8 q = *reinterpret_cast<const bf16x8*>(qrl + d0 * 32);
    p0 = __builtin_amdgcn_mfma_f32_32x32x16_bf16(b0, q, p0, 0, 0, 0); p1 = __builtin_amdgcn_mfma_f32_32x32x16_bf16(b1, q, p1, 0, 0, 0); }
}
typedef __attribute__((address_space(3))) const char* lcp_t;
typedef short v4i16_t __attribute__((ext_vector_type(4)));
__device__ __forceinline__ s16x4 vtr3(lcp_t p) { return __builtin_bit_cast(s16x4, __builtin_amdgcn_ds_read_tr16_b64_v4i16((__attribute__((address_space(3))) v4i16_t*)p)); }
template <int G> __device__ __forceinline__ void kfrag3(bf16x8 (&kf)[3][2], lcp_t KNs, lcp_t KRs, int r32, int hi) {
#pragma unroll
  for (int s = 0; s < 3; ++s) { constexpr int dummy = 0; const int d0 = 3 * G + s;
    if (d0 < 8) { const int cb = (d0 * 16 + hi * 8) * 2; kf[s][0] = *(const __attribute__((address_space(3))) bf16x8*)(KNs + KSWZ(r32, cb)); kf[s][1] = *(const __attribute__((address_space(3))) bf16x8*)(KNs + KSWZ(32 + r32, cb)); }
    else { const int cb = ((d0 - 8) * 16 + hi * 8) * 2; kf[s][0] = *(const __attribute__((address_space(3))) bf16x8*)(KRs + KRSWZ(r32, cb)); kf[s][1] = *(const __attribute__((address_space(3))) bf16x8*)(KRs + KRSWZ(32 + r32, cb)); } }
}
template <int G> __device__ __forceinline__ void vfrag3(s16x4 (&vl)[4], s16x4 (&vh)[4], lcp_t vb) {
#pragma unroll
  for (int ks = 0; ks < 4; ++ks) { vl[ks] = vtr3(vb + v_rd_off(G, ks, 0)); vh[ks] = vtr3(vb + v_rd_off(G, ks, 1)); }
}
template <int G> __device__ __forceinline__ void mgroup3(f32x16& p0, f32x16& p1, f32x16& og, bf16x8 (&kf)[3][2], s16x4 (&vl)[4], s16x4 (&vh)[4], const bf16x8* qr, lcp_t qrl, lcp_t KNs, lcp_t KRs, lcp_t vb,
                                                         bf16x8 pa0, bf16x8 pa1, bf16x8 pa2, bf16x8 pa3, int r32, int hi) {
  vfrag3<G>(vl, vh, vb);
  bf16x8 qx[3];
#pragma unroll
  for (int s = 0; s < 3; ++s) if (3 * G + s >= 8) qx[s] = *(const __attribute__((address_space(3))) bf16x8*)(qrl + (3 * G + s - 8) * 32);
  SBAR();
#pragma unroll
  for (int s = 0; s < 3; ++s) { const bf16x8 q = (3 * G + s < 8) ? qr[(3 * G + s) & 7] : qx[s];
    p0 = __builtin_amdgcn_mfma_f32_32x32x16_bf16(kf[s][0], q, p0, 0, 0, 0); p1 = __builtin_amdgcn_mfma_f32_32x32x16_bf16(kf[s][1], q, p1, 0, 0, 0); }
  SBAR();
  if constexpr (G < 3) { kfrag3<G + 1>(kf, KNs, KRs, r32, hi); SBAR(); }
#define PKV(L, H) (bf16x8){L[0], L[1], L[2], L[3], H[0], H[1], H[2], H[3]}
  og = __builtin_amdgcn_mfma_f32_32x32x16_bf16(pa0, PKV(vl[0], vh[0]), og, 0, 0, 0);
  og = __builtin_amdgcn_mfma_f32_32x32x16_bf16(pa1, PKV(vl[1], vh[1]), og, 0, 0, 0);
  og = __builtin_amdgcn_mfma_f32_32x32x16_bf16(pa2, PKV(vl[2], vh[2]), og, 0, 0, 0);
  og = __builtin_amdgcn_mfma_f32_32x32x16_bf16(pa3, PKV(vl[3], vh[3]), og, 0, 0, 0);
#undef PKV
  SBAR();
}
__device__ __forceinline__ void mseg3(f32x16& p0, f32x16& p1, f32x16* o, const bf16x8* qr, lcp_t qrl, lcp_t KNs, lcp_t KRs, lcp_t vb, bf16x8 pa0, bf16x8 pa1, bf16x8 pa2, bf16x8 pa3, int r32, int hi) {
  p0 = f32x16{}; p1 = f32x16{};
  bf16x8 kf[3][2]; s16x4 vl[4], vh[4];
  kfrag3<0>(kf, KNs, KRs, r32, hi); SBAR();
  mgroup3<0>(p0, p1, o[0], kf, vl, vh, qr, qrl, KNs, KRs, vb, pa0, pa1, pa2, pa3, r32, hi);
  mgroup3<1>(p0, p1, o[1], kf, vl, vh, qr, qrl, KNs, KRs, vb, pa0, pa1, pa2, pa3, r32, hi);
  mgroup3<2>(p0, p1, o[2], kf, vl, vh, qr, qrl, KNs, KRs, vb, pa0, pa1, pa2, pa3, r32, hi);
  mgroup3<3>(p0, p1, o[3], kf, vl, vh, qr, qrl, KNs, KRs, vb, pa0, pa1, pa2, pa3, r32, hi);
}
__device__ __forceinline__ void attn_dense_body_v3(const bf16* __restrict__ Qb, const bf16* __restrict__ KNh, const bf16* __restrict__ KRb, const bf16* __restrict__ Vh,
                                                   bf16* __restrict__ Ob, int seq, char* lds, const int wv) {
  const int tid = opaque_tid(wv), wid = tid >> 6, lane = tid & 63, r32 = lane & 31, hi = lane >> 5; const int half = wv >> 2;
  char* V_lds = lds + OFF_V; char* KN_lds = lds + OFF_KN; char* KR_lds = lds + OFF_KR;
  float* ws = (float*)(lds + OFF_WS) + wid * 64; float* li_l = ws; float* al_l = ws + 32;
  float m_reg = -1e30f, l_reg = 0.f, alpha = 1.f; f32x16 o[4] = {}; bf16x8 qr[8];
  const bf16* Qw = Qb + (long)(wid * QBLK + r32) * LDQ + hi * 8;
#pragma unroll
  for (int d0 = 0; d0 < 8; ++d0) qr[d0] = *reinterpret_cast<const bf16x8*>(Qw + d0 * 16);
  char* qrl = lds + OFF_QR + wid * (32 * 144) + r32 * 144 + hi * 16;
#pragma unroll
  for (int d0 = 0; d0 < 4; ++d0) *reinterpret_cast<bf16x8*>(qrl + d0 * 32) = *reinterpret_cast<const bf16x8*>(Qw + (8 + d0) * 16);
  const int sr = tid >> 4, sc = (tid & 15) * 8, vst0 = v_st(sr, sc), vst1 = v_st(32 + sr, sc);
  const int rr_ = tid >> 3, rc = (tid & 7) * 8;
  const int vb0 = (int)(uintptr_t)V_lds + v_rd_base(lane);
  bf16x8 s_vs0, s_vs1, s_ks0, s_ks1, s_kr;
#define LDK3(k0) do { s_ks0 = *reinterpret_cast<const bf16x8*>(&KNh[(long)((k0) + sr) * LDKN + sc]); s_ks1 = *reinterpret_cast<const bf16x8*>(&KNh[(long)((k0) + 32 + sr) * LDKN + sc]); \
    s_kr = *reinterpret_cast<const bf16x8*>(&KRb[(long)((k0) + rr_) * LDKR + rc]); } while (0)
#define LDV3(k0) do { s_vs0 = *reinterpret_cast<const bf16x8*>(&Vh[(long)((k0) + sr) * LDV + sc]); s_vs1 = *reinterpret_cast<const bf16x8*>(&Vh[(long)((k0) + 32 + sr) * LDV + sc]); } while (0)
#define STK3(b) do { const int kc = sc * 2; *(bf16x8*)(KN_lds + (b) * SHM_KN + KSWZ(sr, kc)) = s_ks0; *(bf16x8*)(KN_lds + (b) * SHM_KN + KSWZ(32 + sr, kc)) = s_ks1; \
    *(bf16x8*)(KR_lds + (b) * SHM_KR + KRSWZ(rr_, rc * 2)) = s_kr; } while (0)
#define STV3(b) do { *(bf16x8*)(V_lds + (b) * SHM_V + vst0) = s_vs0; *(bf16x8*)(V_lds + (b) * SHM_V + vst1) = s_vs1; } while (0)
#define BAR3() do { asm volatile("s_waitcnt lgkmcnt(0)" ::: "memory"); __builtin_amdgcn_s_barrier(); asm volatile("" ::: "memory"); } while (0)
#define VW3() asm volatile("s_waitcnt vmcnt(0)" ::: "memory")
#define RESC3(a) do { if (__any((a) < 1.f)) { if (hi == 0) al_l[r32] = (a); asm volatile("s_waitcnt lgkmcnt(0)" ::: "memory"); \
    _Pragma("unroll") for (int d = 0; d < 4; ++d) _Pragma("unroll") for (int r = 0; r < 16; ++r) o[d][r] *= al_l[crow(r, hi)]; } } while (0)
  f32x16 p0, p1; bf16x8 pa0, pa1, pa2, pa3; const int NT = seq / KVBLK;
  LDK3(0); VW3(); STK3(0); BAR3();
  if (half) { LDK3(KVBLK); LDV3(0); VW3(); STK3(1); STV3(0); BAR3(); }
  for (int t = 0; t < NT; ++t) {
    const int kt = t + 1 + half, vt = t + half;
    { int r32_ = r32, hi_ = hi, ln_ = lane; asm volatile("" : "+v"(r32_), "+v"(hi_), "+v"(ln_));
      if (t == 0) qkt12(p0, p1, KN_lds, KR_lds, qr, qrl, r32_, hi_);
      else mseg3(p0, p1, o, qr, (lcp_t)qrl, (lcp_t)(KN_lds + (t & 1) * SHM_KN), (lcp_t)(KR_lds + (t & 1) * SHM_KR), (lcp_t)(V_lds + ((t - 1) & 1) * SHM_V) + v_rd_base(ln_), pa0, pa1, pa2, pa3, r32_, hi_); }
    SBAR();
    if (kt < NT) LDK3(kt * KVBLK);
    if (vt < NT) LDV3(vt * KVBLK);
    BAR3();
    softmax_tile(p0, p1, m_reg, l_reg, alpha, pa0, pa1, pa2, pa3);
    RESC3(alpha);
    VW3();
    if (kt < NT) STK3(kt & 1);
    if (vt < NT) STV3(vt & 1);
    BAR3();
  }
  pv_d0(o, vb0 + ((NT - 1) & 1) * SHM_V, pa0, pa1, pa2, pa3);
  BAR3();
  if (!half) BAR3();
  if (hi == 0) li_l[r32] = l_reg; asm volatile("s_waitcnt lgkmcnt(0)" ::: "memory");
  float rli[16];
#pragma unroll
  for (int r = 0; r < 16; ++r) rli[r] = __builtin_amdgcn_rcpf(li_l[crow(r, hi)]);
  bf16* Ow = Ob + (long)(wid * QBLK) * LDO;
  __syncthreads();
  { char* ost = lds + wid * (32 * 272);
#pragma unroll
    for (int r = 0; r < 16; ++r) { const int orow = crow(r, hi);
#pragma unroll
      for (int d0 = 0; d0 < 4; ++d0) *reinterpret_cast<bf16*>(ost + orow * 272 + (d0 * 32 + r32) * 2) = (bf16)f2bf(o[d0][r] * rli[r]); }
    asm volatile("s_waitcnt lgkmcnt(0)" ::: "memory");
#pragma unroll
    for (int i = 0; i < 8; ++i) { const int ch = i * 64 + lane, row = ch >> 4, c16 = ch & 15;
      const u32x4 v = *reinterpret_cast<const u32x4*>(ost + row * 272 + c16 * 16);
      *reinterpret_cast<u32x4*>(Ow + (long)row * LDO + c16 * 8) = v; }
  }
  __syncthreads();
#undef LDK3
#undef LDV3
#undef STK3
#undef STV3
#undef BAR3
#undef VW3
#undef RESC3
}

__device__ __forceinline__ void attn_dense_body_v4(const bf16* __restrict__ Qb, const bf16* __restrict__ KNh, const bf16* __restrict__ KRb, const bf16* __restrict__ Vh,
                                                   bf16* __restrict__ Ob, int seq, char* lds, const int wv) {
  const int tid = opaque_tid(wv), wid = tid >> 6, lane = tid & 63, r32 = lane & 31, hi = lane >> 5;
  char* V_lds = lds + OFF_V; char* KN_lds = lds + OFF_KN; char* KR_lds = lds + OFF_KR;
  const int NT = seq / KVBLK;
#define BAR4() do { asm volatile("s_waitcnt lgkmcnt(0)" ::: "memory"); __builtin_amdgcn_s_barrier(); asm volatile("" ::: "memory"); } while (0)
  if (wv >= 4) {
    const int lt = tid - 256;
    unsigned gKN[4], gV[4], gKR[2]; int dKN[4], dV[4], dKR[2];
#pragma unroll
    for (int i = 0; i < 4; ++i) { const int cidx = lt + 256 * i, row = cidx >> 4, ch = cidx & 15;
      gKN[i] = (unsigned)(row * LDKN + ch * 8) * 2u; dKN[i] = KSWZ(row, ch * 16); gV[i] = (unsigned)(row * LDV + ch * 8) * 2u; dV[i] = v_st(row, ch * 8); }
#pragma unroll
    for (int i = 0; i < 2; ++i) { const int cidx = lt + 256 * i, row = cidx >> 3, ch = cidx & 7; gKR[i] = (unsigned)(row * LDKR + ch * 8) * 2u; dKR[i] = KRSWZ(row, ch * 16); }
    bf16x8 sK[4], sV[4], sR[2];
#define L4K(t) do { const char* kb_ = (const char*)KNh + (size_t)(t) * (KVBLK * LDKN * 2); const char* rb_ = (const char*)KRb + (size_t)(t) * (KVBLK * LDKR * 2); \
    _Pragma("unroll") for (int i = 0; i < 4; ++i) sK[i] = *reinterpret_cast<const bf16x8*>(kb_ + gKN[i]); _Pragma("unroll") for (int i = 0; i < 2; ++i) sR[i] = *reinterpret_cast<const bf16x8*>(rb_ + gKR[i]); } while (0)
#define L4V(t) do { const char* vb_ = (const char*)Vh + (size_t)(t) * (KVBLK * LDV * 2); _Pragma("unroll") for (int i = 0; i < 4; ++i) sV[i] = *reinterpret_cast<const bf16x8*>(vb_ + gV[i]); } while (0)
#define W4K(b) do { _Pragma("unroll") for (int i = 0; i < 4; ++i) *reinterpret_cast<bf16x8*>(KN_lds + (b) * SHM_KN + dKN[i]) = sK[i]; _Pragma("unroll") for (int i = 0; i < 2; ++i) *reinterpret_cast<bf16x8*>(KR_lds + (b) * SHM_KR + dKR[i]) = sR[i]; } while (0)
#define W4V(b) do { _Pragma("unroll") for (int i = 0; i < 4; ++i) *reinterpret_cast<bf16x8*>(V_lds + (b) * SHM_V + dV[i]) = sV[i]; } while (0)
#define VW4() asm volatile("s_waitcnt vmcnt(0)" ::: "memory")
    L4K(0); VW4(); W4K(0); L4K(1); L4V(0);
    BAR4();
    for (int j = 0; j < NT; ++j) {
      VW4();
      if (j + 1 < NT) W4K((j + 1) & 1);
      W4V(j & 1);
      if (j + 2 < NT) L4K(j + 2);
      if (j + 1 < NT) L4V(j + 1);
      BAR4();
    }
#undef L4K
#undef L4V
#undef W4K
#undef W4V
#undef VW4
  } else {
    float* ws = (float*)(lds + OFF_WS) + wid * 64; float* li_l = ws; float* al_l = ws + 32;
    float m_reg = -1e30f, l_reg = 0; f32x16 o[4] = {}; bf16x8 qr[NQR];
    const bf16* Qw = Qb + (long)(wid * QBLK + r32) * LDQ + hi * 8;
#pragma unroll
    for (int d0 = 0; d0 < NQR; ++d0) qr[d0] = *reinterpret_cast<const bf16x8*>(Qw + d0 * 16);
    char* qrl = lds + OFF_QR + wid * QR_WAVE + r32 * QR_PITCH + hi * 16;
#pragma unroll
    for (int d0 = NQR; d0 < 12; ++d0) *reinterpret_cast<bf16x8*>(qrl + (d0 - NQR) * 32) = *reinterpret_cast<const bf16x8*>(Qw + d0 * 16);
    const int vb0 = (int)(uintptr_t)V_lds + v_rd_base(lane);
#define RESC4(a) do { if (__any((a) < 1.f)) { if (hi == 0) al_l[r32] = (a); asm volatile("s_waitcnt lgkmcnt(0)" ::: "memory"); \
    _Pragma("unroll") for (int d = 0; d < 4; ++d) _Pragma("unroll") for (int r = 0; r < 16; ++r) o[d][r] *= al_l[crow(r, hi)]; } } while (0)
    f32x16 pA0, pA1, pB0, pB1; float mnA, mnB, alA, alB; bf16x8 pa0, pa1, pa2, pa3;
    BAR4();
    qkt(pA0, pA1, KN_lds, KR_lds, qr, qrl, r32, hi); partialSM(pA0, pA1, m_reg, mnA, alA);
    BAR4();
    for (int j = 1; j + 1 < NT; j += 2) {
      SBAR(); qkt_fin(pB0, pB1, KN_lds + SHM_KN, KR_lds + SHM_KR, qr, qrl, r32, hi, pA0, pA1, alA, l_reg, pa0, pa1, pa2, pa3);
      pv_part(o, vb0, pa0, pa1, pa2, pa3, pB0, pB1, m_reg, mnB, alB);
      RESC4(alB); BAR4();
      SBAR(); qkt_fin(pA0, pA1, KN_lds, KR_lds, qr, qrl, r32, hi, pB0, pB1, alB, l_reg, pa0, pa1, pa2, pa3);
      pv_part(o, vb0 + SHM_V, pa0, pa1, pa2, pa3, pA0, pA1, m_reg, mnA, alA);
      RESC4(alA); BAR4();
    }
    SBAR(); qkt_fin(pB0, pB1, KN_lds + SHM_KN, KR_lds + SHM_KR, qr, qrl, r32, hi, pA0, pA1, alA, l_reg, pa0, pa1, pa2, pa3);
    pv_part(o, vb0, pa0, pa1, pa2, pa3, pB0, pB1, m_reg, mnB, alB);
    RESC4(alB); BAR4();
    finishSM(pB0, pB1, alB, l_reg, pa0, pa1, pa2, pa3); SBAR();
    pv_d0(o, vb0 + SHM_V, pa0, pa1, pa2, pa3);
    if (hi == 0) li_l[r32] = l_reg; asm volatile("s_waitcnt lgkmcnt(0)" ::: "memory");
    float rli[16];
#pragma unroll
    for (int r = 0; r < 16; ++r) rli[r] = __builtin_amdgcn_rcpf(li_l[crow(r, hi)]);
#pragma unroll
    for (int d = 0; d < 4; ++d)
#pragma unroll
      for (int r = 0; r < 16; ++r) o[d][r] *= rli[r];
    BAR4();
    { bf16* Ow = Ob + (long)(wid * QBLK) * LDO; char* ost = lds + wid * (32 * 272);
#pragma unroll
      for (int r = 0; r < 16; ++r) { const int orow = crow(r, hi);
#pragma unroll
        for (int d0 = 0; d0 < 4; ++d0) *reinterpret_cast<bf16*>(ost + orow * 272 + (d0 * 32 + r32) * 2) = (bf16)f2bf(o[d0][r]); }
      asm volatile("s_waitcnt lgkmcnt(0)" ::: "memory");
#pragma unroll
      for (int i = 0; i < 8; ++i) { const int ch = i * 64 + lane, row = ch >> 4, c16 = ch & 15;
        const u32x4 v = *reinterpret_cast<const u32x4*>(ost + row * 272 + c16 * 16);
        *reinterpret_cast<u32x4*>(Ow + (long)row * LDO + c16 * 8) = v; } }
#undef RESC4
  }
  if (wv >= 4) BAR4();
  BAR4();
#undef BAR4
}

__device__ __forceinline__ int v_stT(int k, int c) { return ((k >> 3) * 4 + (c >> 5)) * 512 + ((k & 7) * 32 + (c & 31)) * 2; }
__device__ __forceinline__ void finishSMT(f32x16& p0, f32x16& p1, float alpha, float& l_reg, bf16x8& pa0, bf16x8& pa1, bf16x8& pa2, bf16x8& pa3) {
#pragma unroll
  for (int r = 0; r < 16; ++r) p1[r] = __builtin_amdgcn_exp2f(p1[r]);
  float ps = 0;
#pragma unroll
  for (int r = 0; r < 16; ++r) ps += p0[r];
#pragma unroll
  for (int r = 0; r < 16; ++r) ps += p1[r];
  { auto rr = __builtin_amdgcn_permlane32_swap(__float_as_uint(ps), __float_as_uint(ps), false, false);
    ps = __uint_as_float(rr[0]) + __uint_as_float(rr[1]); }
  l_reg = l_reg * alpha + ps;
#define PKT(P, BASE, OUT) do { u32x4 w = {cvtpk(P[BASE + 0], P[BASE + 1]), cvtpk(P[BASE + 2], P[BASE + 3]), cvtpk(P[BASE + 4], P[BASE + 5]), cvtpk(P[BASE + 6], P[BASE + 7])}; OUT = *reinterpret_cast<bf16x8*>(&w); } while (0)
  PKT(p0, 0, pa0); PKT(p0, 8, pa1); PKT(p1, 0, pa2); PKT(p1, 8, pa3);
#undef PKT
}
template <int D0> __device__ __forceinline__ void pv_oneT(f32x16& od, int vb, bf16x8 pa0, bf16x8 pa1, bf16x8 pa2, bf16x8 pa3) {
  const s16x4 l0 = tr_read<v_rd_off(D0, 0, 0)>(vb), h0 = tr_read<v_rd_off(D0, 0, 1)>(vb), l1 = tr_read<v_rd_off(D0, 1, 0)>(vb), h1 = tr_read<v_rd_off(D0, 1, 1)>(vb);
  const s16x4 l2 = tr_read<v_rd_off(D0, 2, 0)>(vb), h2 = tr_read<v_rd_off(D0, 2, 1)>(vb), l3 = tr_read<v_rd_off(D0, 3, 0)>(vb), h3 = tr_read<v_rd_off(D0, 3, 1)>(vb);
  asm volatile("s_waitcnt lgkmcnt(0)" ::: "memory"); SBAR();
#define PK(L, H) (bf16x8){L[0], L[1], L[2], L[3], H[0], H[1], H[2], H[3]}
  od = __builtin_amdgcn_mfma_f32_32x32x16_bf16(PK(l0, h0), pa0, od, 0, 0, 0);
  od = __builtin_amdgcn_mfma_f32_32x32x16_bf16(PK(l1, h1), pa1, od, 0, 0, 0);
  od = __builtin_amdgcn_mfma_f32_32x32x16_bf16(PK(l2, h2), pa2, od, 0, 0, 0);
  od = __builtin_amdgcn_mfma_f32_32x32x16_bf16(PK(l3, h3), pa3, od, 0, 0, 0);
#undef PK
}
__device__ __forceinline__ void pv_d0T(f32x16* o, int vb, bf16x8 pa0, bf16x8 pa1, bf16x8 pa2, bf16x8 pa3) {
  pv_oneT<0>(o[0], vb, pa0, pa1, pa2, pa3); pv_oneT<1>(o[1], vb, pa0, pa1, pa2, pa3); pv_oneT<2>(o[2], vb, pa0, pa1, pa2, pa3); pv_oneT<3>(o[3], vb, pa0, pa1, pa2, pa3);
}
__device__ __forceinline__ void attn_dense_body_t(const bf16* __restrict__ Qb, const bf16* __restrict__ KNh, const bf16* __restrict__ KRb, const bf16* __restrict__ Vh,
                                                  bf16* __restrict__ Ob, int seq, char* lds, const int wv) {
  const int tid = opaque_tid(wv), wid = tid >> 6, lane = tid & 63, r32 = lane & 31, hi = lane >> 5;
  char* V_lds = lds + OFF_V; char* KN_lds = lds + OFF_KN; char* KR_lds = lds + OFF_KR;
  float m_reg = -1e30f, l_reg = 0; f32x16 o[4] = {}; bf16x8 qr[NQR];
  const bf16* Qw = Qb + (long)(wid * QBLK + r32) * LDQ + hi * 8;
#pragma unroll
  for (int d0 = 0; d0 < NQR; ++d0) qr[d0] = *reinterpret_cast<const bf16x8*>(Qw + d0 * 16);
  char* qrl = lds + OFF_QR + wid * QR_WAVE + r32 * QR_PITCH + hi * 16;
#pragma unroll
  for (int d0 = NQR; d0 < 12; ++d0) *reinterpret_cast<bf16x8*>(qrl + (d0 - NQR) * 32) = *reinterpret_cast<const bf16x8*>(Qw + d0 * 16);
  const int sr = tid >> 4, sc = (tid & 15) * 8, vst0 = v_stT(sr, sc), vst1 = v_stT(32 + sr, sc);
  const int rr_ = tid >> 3, rc = (tid & 7) * 8;
  const int vb0 = (int)(uintptr_t)V_lds + v_rd_base(lane);
  bf16x8 s_vs0, s_vs1, s_ks0, s_ks1, s_kr;
#define SLOADK(k0) do { s_ks0 = *reinterpret_cast<const bf16x8*>(&KNh[(long)((k0) + sr) * LDKN + sc]); s_ks1 = *reinterpret_cast<const bf16x8*>(&KNh[(long)((k0) + 32 + sr) * LDKN + sc]); \
    s_kr = *reinterpret_cast<const bf16x8*>(&KRb[(long)((k0) + rr_) * LDKR + rc]); } while (0)
#define SLOADV(k0) do { s_vs0 = *reinterpret_cast<const bf16x8*>(&Vh[(long)((k0) + sr) * LDV + sc]); s_vs1 = *reinterpret_cast<const bf16x8*>(&Vh[(long)((k0) + 32 + sr) * LDV + sc]); } while (0)
#define SWRITEK(b) do { const int kc = sc * 2; *(bf16x8*)(KN_lds + (b) * SHM_KN + KSWZ(sr, kc)) = s_ks0; *(bf16x8*)(KN_lds + (b) * SHM_KN + KSWZ(32 + sr, kc)) = s_ks1; \
    *(bf16x8*)(KR_lds + (b) * SHM_KR + KRSWZ(rr_, rc * 2)) = s_kr; } while (0)
#define SWRITEV(b) do { *(bf16x8*)(V_lds + (b) * SHM_V + vst0) = s_vs0; *(bf16x8*)(V_lds + (b) * SHM_V + vst1) = s_vs1; } while (0)
#define VWAIT() asm volatile("s_waitcnt vmcnt(0)" ::: "memory")
#define RESCT(a) do { if (__any((a) < 1.f)) { _Pragma("unroll") for (int d = 0; d < 4; ++d) _Pragma("unroll") for (int r = 0; r < 16; ++r) o[d][r] *= (a); } } while (0)
  f32x16 pA0, pA1, pB0, pB1; float mnA, mnB, alA, alB; bf16x8 pa0, pa1, pa2, pa3; const int NT = seq / KVBLK;
  SLOADK(0); VWAIT(); SWRITEK(0); __syncthreads();
  qkt(pA0, pA1, KN_lds, KR_lds, qr, qrl, r32, hi);
  SLOADK(KVBLK); SLOADV(0); SBAR();
  partialSM(pA0, pA1, m_reg, mnA, alA);
  VWAIT(); SWRITEK(1); SWRITEV(0);
  __syncthreads();
  for (int j = 1; j + 1 < NT; j += 2) {
    SBAR(); qkt(pB0, pB1, KN_lds + SHM_KN, KR_lds + SHM_KR, qr, qrl, r32, hi);
    finishSMT(pA0, pA1, alA, l_reg, pa0, pa1, pa2, pa3); SBAR();
    SLOADK((j + 1) * KVBLK); SLOADV(j * KVBLK); SBAR();
    pv_d0T(o, vb0, pa0, pa1, pa2, pa3); partialSM(pB0, pB1, m_reg, mnB, alB);
    VWAIT(); SWRITEK(0); SWRITEV(1);
    RESCT(alB); __syncthreads();
    SBAR(); qkt(pA0, pA1, KN_lds, KR_lds, qr, qrl, r32, hi);
    finishSMT(pB0, pB1, alB, l_reg, pa0, pa1, pa2, pa3); SBAR();
    SLOADK((j + 2) * KVBLK); SLOADV((j + 1) * KVBLK); SBAR();
    pv_d0T(o, vb0 + SHM_V, pa0, pa1, pa2, pa3); partialSM(pA0, pA1, m_reg, mnA, alA);
    VWAIT(); SWRITEK(1); SWRITEV(0);
    RESCT(alA); __syncthreads();
  }
  SBAR(); qkt(pB0, pB1, KN_lds + SHM_KN, KR_lds + SHM_KR, qr, qrl, r32, hi);
  finishSMT(pA0, pA1, alA, l_reg, pa0, pa1, pa2, pa3); SBAR();
  SLOADV((NT - 1) * KVBLK); SBAR();
  pv_d0T(o, vb0, pa0, pa1, pa2, pa3); partialSM(pB0, pB1, m_reg, mnB, alB);
  VWAIT(); SWRITEV(1); RESCT(alB); __syncthreads();
  finishSMT(pB0, pB1, alB, l_reg, pa0, pa1, pa2, pa3); SBAR();
  pv_d0T(o, vb0 + SHM_V, pa0, pa1, pa2, pa3);
  const float rl = __builtin_amdgcn_rcpf(l_reg);
  bf16* Ow = Ob + (long)(wid * QBLK) * LDO;
  __syncthreads();
  { char* ost = lds + wid * (32 * 272);
#pragma unroll
    for (int d0 = 0; d0 < 4; ++d0)
#pragma unroll
      for (int r = 0; r < 16; ++r) *reinterpret_cast<bf16*>(ost + r32 * 272 + (d0 * 32 + crow(r, hi)) * 2) = (bf16)f2bf(o[d0][r] * rl);
    asm volatile("s_waitcnt lgkmcnt(0)" ::: "memory");
#pragma unroll
    for (int i = 0; i < 8; ++i) { const int ch = i * 64 + lane, row = ch >> 4, c16 = ch & 15;
      const u32x4 v = *reinterpret_cast<const u32x4*>(ost + row * 272 + c16 * 16);
      *reinterpret_cast<u32x4*>(Ow + (long)row * LDO + c16 * 8) = v; }
  }
  __syncthreads();
#undef SLOADK
#undef SLOADV
#undef SWRITEK
#undef SWRITEV
#undef VWAIT
#undef RESCT
}
#undef KSWZ
#undef KRSWZ
#undef SBAR
#undef QK_FENCE
#undef PK4F
}

constexpr int PTAB_OFF = MISC_OFF + 256;
enum { IN_x = 0, IN_p, IN_pos, IN_ffn1_norm, IN_ffn1_wg, IN_ffn1_wu, IN_ffn1_wd, IN_mix_norm, IN_w_in, IN_q_norm, IN_w_uq, IN_kv_norm, IN_w_ukv, IN_conv_w, IN_conv_b, IN_mw_q, IN_mw_k, IN_i_bias, IN_f_bias,
       IN_head_norm, IN_skip, IN_fnet_w, IN_fnet_b, IN_w_out, IN_ffn2_norm, IN_ffn2_wg, IN_ffn2_wu, IN_ffn2_wd, IN_pg_norm, IN_ple_wg, IN_ple_wp, IN_ple_post, IN_final_norm };
__device__ __forceinline__ const float* inp(const Frame& F, int k) {
    const LAS unsigned* t = (const LAS unsigned*)(F.lds + PTAB_OFF) + 2 * k;
    const unsigned lo = __builtin_amdgcn_readfirstlane(t[0]), hi = __builtin_amdgcn_readfirstlane(t[1]);
    return (const float*)(const GAS float*)(((unsigned long long)hi << 32) | lo);
}

template <typename T> __device__ __forceinline__ T* wsp(unsigned char* ws, size_t off) { unsigned long long z = off; asm volatile("" : "+s"(z)); return (T*)(ws + z); }

__device__ __forceinline__ void prologue_a(Frame& F) {
    unsigned char* ws = F.ws;
    float* ropec = (float*)(ws + WS_ROPEC); float* ropes = (float*)(ws + WS_ROPES);
    const int gt = F.vcu * 512 + F.tid, NGT = F.G * 512;
    const int* pos_ = (const int*)inp(F, IN_pos); const float* x_ = inp(F, IN_x); const float* wout_ = inp(F, IN_w_out); const float* fw_ = inp(F, IN_fnet_w); const float* fb_ = inp(F, IN_fnet_b);
    for (int i = gt; i < MTOK * 32; i += NGT) {
        const int row = i >> 5, j = i & 31;
        const float inv = 1.0f / powf(10000.0f, (float)(2 * j) / 64.0f);
        const float ang = (float)pos_[row] * inv;
        const double rev = (double)ang * 0.15915494309189535;
        const float fr = (float)(rev - floor(rev));
        ropec[i] = __builtin_amdgcn_cosf(fr); ropes[i] = __builtin_amdgcn_sinf(fr);
    }
    bf16* XB1 = (bf16*)(ws + B_XB1); float* SS0 = (float*)(ws + WS_SS);
    const int gw = F.vcu * 8 + F.wave, NGW = F.G * 8;
    for (int mp = gw; mp < MTOK / 2; mp += NGW) {
        const int m0 = 2 * mp; f32x4 v[2][4];
#pragma unroll
        for (int q = 0; q < 2; ++q)
#pragma unroll
            for (int j = 0; j < 4; ++j) v[q][j] = ((const GAS f32x4*)(x_ + (size_t)(m0 + q) * DM) + F.lane)[64 * j];
#pragma unroll
        for (int q = 0; q < 2; ++q) {
            GAS v2u* o8 = (GAS v2u*)(XB1 + (size_t)(m0 + q) * DM) + F.lane; float s = 0.f;
#pragma unroll
            for (int j = 0; j < 4; ++j) { const f32x4 t = v[q][j]; v2u w; w.x = pk2(t[0], t[1]); w.y = pk2(t[2], t[3]); o8[64 * j] = w; s += (t[0] * t[0] + t[1] * t[1]) + (t[2] * t[2] + t[3] * t[3]); }
            s = quad_sum(s);
            if ((F.lane & 3) == 0) SS0[(size_t)(m0 + q) * 16 + (F.lane >> 2)] = s;
        }
    }
    int cbase = 0;
    for (int l = 0; l < DEPTH; ++l) {
        CvtJob J{wout_ + (size_t)l * DM * DM, DM, 768, 0, DM, (bf16*)(ws + WS_WOUT) + (size_t)l * DM * KOUT, KOUT, 0, 0, nullptr};
        cvt_job(F, J, cbase);
    }
    float* F1 = (float*)(ws + B_F1); float* BO = (float*)(ws + WS_BOUT);
    for (int i = gt; i < DEPTH * 4 * 64 * DM; i += NGT) {
        const int n = i & 1023, cp = (i >> 10) & 63, g = (i >> 16) & 3, l = i >> 18;
        const float* fw = fw_ + ((size_t)(l * 4 + g) * 64 + cp) * 64; const float* wo = wout_ + ((size_t)l * DM + 768 + 64 * g) * DM + n;
        float a = 0.f;
#pragma unroll 16
        for (int e = 0; e < 64; ++e) a += fw[e] * wo[(size_t)e * DM];
        F1[i] = a;
    }
    for (int i = gt; i < DEPTH * DM; i += NGT) {
        const int n = i & 1023, l = i >> 10; float a = 0.f;
#pragma unroll 32
        for (int e = 0; e < 256; ++e) a += fb_[l * 256 + e] * wout_[((size_t)l * DM + 768 + e) * DM + n];
        BO[i] = a;
    }
}
__device__ __forceinline__ void prologue_b(Frame& F) {
    unsigned char* ws = F.ws; const float* F1 = (const float*)(ws + B_F1); bf16* WO = (bf16*)(ws + WS_WOUT);
    const int gt = F.vcu * 512 + F.tid, NGT = F.G * 512;
    for (int i = gt; i < DEPTH * DM * 256; i += NGT) {
        const int c = i & 63, g = (i >> 6) & 3, n = (i >> 8) & 1023, l = i >> 18;
        const float* f = F1 + ((size_t)(l * 4 + g) * 64) * DM + n; float ar = 0.f, ai = 0.f;
#pragma unroll 16
        for (int cp = 0; cp < 64; ++cp) { const float fr = (float)((c * cp) & 63) * (1.0f / 64.0f); const float v = f[(size_t)cp * DM];
            ar += __builtin_amdgcn_cosf(fr) * v; ai += __builtin_amdgcn_sinf(fr) * v; }
        bf16* dst = WO + ((size_t)l * DM + n) * KOUT;
        dst[768 + 64 * g + c] = (bf16)f2bf(ar); dst[1024 + 64 * g + c] = (bf16)f2bf(ai);
    }
}

__device__ __forceinline__ void convert_jobs(Frame& F, int l, int jlo, int jhi) {
    unsigned char* wl = F.ws + WS_WL;
    const size_t ffo = (size_t)l * DM * DFF; int cbase = 0;
    for (int jj = jlo; jj < jhi; ++jj) {
        CvtJob J;
        switch (jj) {
        case 0: J = CvtJob{inp(F, IN_ffn1_wg) + ffo, DFF, DM, 0, DFF, (bf16*)(wl + WL_GU1), DM, 0, 4, inp(F, IN_ffn1_norm) + l * DM}; break;
        case 1: J = CvtJob{inp(F, IN_ffn1_wu) + ffo, DFF, DM, 0, DFF, (bf16*)(wl + WL_GU1), DM, 128, 4, inp(F, IN_ffn1_norm) + l * DM}; break;
        case 2: J = CvtJob{inp(F, IN_ffn1_wd) + ffo, DM, DFF, 0, DM, (bf16*)(wl + WL_D1), DFF, 0, 0, nullptr}; break;
        case 3: J = CvtJob{inp(F, IN_ffn2_wg) + ffo, DFF, DM, 0, DFF, (bf16*)(wl + WL_GU2), DM, 0, 4, inp(F, IN_ffn2_norm) + l * DM}; break;
        case 4: J = CvtJob{inp(F, IN_ffn2_wu) + ffo, DFF, DM, 0, DFF, (bf16*)(wl + WL_GU2), DM, 128, 4, inp(F, IN_ffn2_norm) + l * DM}; break;
        case 5: J = CvtJob{inp(F, IN_ffn2_wd) + ffo, DM, DFF, 0, DM, (bf16*)(wl + WL_D2), DFF, 0, 0, nullptr}; break;
        case 6: J = CvtJob{inp(F, IN_w_in) + (size_t)l * DM * DIN, DIN, DM, 0, 640, (bf16*)(wl + WL_IN), DM, 0, 0, inp(F, IN_mix_norm) + l * DM}; break;
        case 7: J = CvtJob{inp(F, IN_w_in) + (size_t)l * DM * DIN, DIN, DM, 640, 64, (bf16*)(wl + WL_IN), DM, 640, 2, inp(F, IN_mix_norm) + l * DM}; break;
        case 8: J = CvtJob{inp(F, IN_w_in) + (size_t)l * DM * DIN, DIN, DM, 1472, 32, (bf16*)(wl + WL_IN), DM, 704, 0, inp(F, IN_mix_norm) + l * DM}; break;
        case 9: J = CvtJob{inp(F, IN_w_in) + (size_t)l * DM * DIN, DIN, DM, 704, 768, (bf16*)(wl + WL_IN), DM, 768, 0, inp(F, IN_mix_norm) + l * DM}; break;
        case 10: J = CvtJob{inp(F, IN_w_in) + (size_t)l * DM * DIN, DIN, DM, 1488, 256, (bf16*)(wl + WL_IN), DM, 1536, 0, inp(F, IN_mix_norm) + l * DM}; break;
        case 11: J = CvtJob{inp(F, IN_w_uq) + (size_t)l * QL * NQ, NQ, QL, 0, NQ, (bf16*)(wl + WL_UQ), QL, 0, 3, inp(F, IN_q_norm) + l * QL}; break;
        case 12: J = CvtJob{inp(F, IN_w_ukv) + (size_t)l * KVL * NKV, NKV, KVL, 0, NKV, (bf16*)(wl + WL_UKV), KVL, 0, 0, inp(F, IN_kv_norm) + l * KVL}; break;
        case 13: J = CvtJob{nullptr, 0, 0, 0, 0, nullptr, 0, 0, 0, nullptr}; break;
        case 14: J = CvtJob{inp(F, IN_ple_wp) + (size_t)l * PLE * DM, DM, PLE, 0, DM, (bf16*)(wl + WL_PP), PLE, 0, 0, nullptr}; break;
        default: J = CvtJob{nullptr, 0, 0, 0, 0, nullptr, 0, 0, 0, nullptr}; break;
        }
        if (J.W) cvt_job(F, J, cbase);
    }
}
__device__ __forceinline__ void convert_layer(Frame& F, int l) {
    unsigned char* wl = F.ws + WS_WL;
    convert_jobs(F, l, 0, 16);
    { GAS v4u* z = (GAS v4u*)((bf16*)(wl + WL_IN) + (size_t)736 * DM); const int gt = F.vcu * 512 + F.tid;
      unsigned zz = 0u; asm volatile("" : "+v"(zz));
      for (int i = gt; i < 32 * DM / 8; i += F.G * 512) z[i] = (v4u){zz, zz, zz, zz}; }
}
__device__ __forceinline__ void convert_pg(Frame& F, int l) {
    unsigned char* wl = F.ws + WS_WL; int cbase = 0;
    CvtJob J{inp(F, IN_ple_wg) + (size_t)l * DM * DM, DM, DM, 0, DM, (bf16*)(wl + WL_PG), DM, 0, 0, inp(F, IN_pg_norm) + l * DM};
    cvt_job(F, J, cbase);
}
__device__ __forceinline__ void convert_p(Frame& F, int l) {
    const GAS f32x4* src = (const GAS f32x4*)(inp(F, IN_p) + (size_t)l * MTOK * PLE); GAS v2u* dst = (GAS v2u*)(F.ws + B_PB);
    const int gt = F.vcu * 512 + F.tid, NGT = F.G * 512; constexpr int N4 = MTOK * PLE / 4;
    int i = gt;
    for (; i + 3 * NGT < N4; i += 4 * NGT) {
        f32x4 v[4];
#pragma unroll
        for (int j = 0; j < 4; ++j) v[j] = src[i + j * NGT];
#pragma unroll
        for (int j = 0; j < 4; ++j) { v2u w; w.x = pk2(v[j][0], v[j][1]); w.y = pk2(v[j][2], v[j][3]); dst[i + j * NGT] = w; }
    }
    for (; i < N4; i += NGT) { const f32x4 v = src[i]; v2u w; w.x = pk2(v[0], v[1]); w.y = pk2(v[2], v[3]); dst[i] = w; }
}

struct M1Pre { v4u mx[5]; v4u mv; float iv, fv, ib, fb; };
__device__ __forceinline__ void m1_load(M1Pre& P, unsigned char* ws, const float* ib_, const float* fbias_, int l, int b, int hh, int c, int tid, int lane, int w) {
    const int j = tid >> 3, d8 = (tid & 7) * 8, ch = hh * 64 + d8;
    const bf16* MX = wsp<const bf16>(ws, B_MX);
#pragma unroll
    for (int tap = 0; tap < 5; ++tap) { const int ss = c * 64 + j + tap - 2; P.mx[tap] = (v4u){0u, 0u, 0u, 0u}; if (ss >= 0 && ss < SEQ) P.mx[tap] = *(const GAS v4u*)(MX + (size_t)(b * SEQ + ss) * 256 + ch); }
    P.mv = *(const GAS v4u*)(wsp<const bf16>(ws, B_MV) + (size_t)(b * SEQ + c * 64 + j) * 256 + ch);
    P.iv = 0.f; P.fv = 0.f; P.ib = 0.f; P.fb = 0.f;
    if (w < 2) { const int dir = w, tok = b * SEQ + c * 64 + (dir ? 63 - lane : lane); const float* MIF = wsp<const float>(ws, B_MIF);
        P.iv = MIF[(size_t)tok * 16 + dir * 4 + hh]; P.ib = ib_[l * 8 + dir * 4 + hh]; P.fv = MIF[(size_t)tok * 16 + 8 + dir * 4 + hh]; P.fb = fbias_[l * 8 + dir * 4 + hh]; }
}
__device__ __forceinline__ void mlstm_m1(Frame& F, int l) {
    unsigned char* ws = F.ws;
    LAS bf16* XCs = (LAS bf16*)(F.lds); LAS bf16* WqT = XCs + 64 * 72; LAS bf16* WkT = WqT + 64 * 72; LAS bf16* VT = WkT + 64 * 72;
    LAS bf16* KT0 = VT + 64 * 72; LAS bf16* KT1 = KT0 + 64 * 72; LAS float* wv = (LAS float*)(KT1 + 64 * 72);
    const int tid = F.tid, lane = F.lane, w = F.wave, hi = lane >> 5, r32 = lane & 31;
    const float* convb_ = inp(F, IN_conv_b); const float* convw_ = inp(F, IN_conv_w); const float* mwq_ = inp(F, IN_mw_q); const float* mwk_ = inp(F, IN_mw_k); const float* ib_ = inp(F, IN_i_bias); const float* fbias_ = inp(F, IN_f_bias);
    constexpr int NUN = NB * 4 * NCHUNK; const int per = NUN / F.G; const bool contig = (per * F.G == NUN) && (NCHUNK % (per > 0 ? per : 1) == 0);
    const int cnt = contig ? per : (NUN - F.vcu + F.G - 1) / F.G;
    int hh_loaded = -1; f32x4 cwv[6][2];
#pragma unroll
    for (int q = 0; q < 6; ++q) cwv[q][0] = cwv[q][1] = (f32x4){0.f, 0.f, 0.f, 0.f};
    M1Pre P;
    if (cnt > 0) { const int unit = contig ? F.vcu * per : F.vcu; m1_load(P, ws, ib_, fbias_, l, unit >> 9, (unit >> 7) & 3, unit & 127, tid, lane, w); }
    for (int i = 0; i < cnt; ++i) {
        const int unit = contig ? F.vcu * per + i : F.vcu + i * F.G;
        const int b = unit >> 9, hh = (unit >> 7) & 3, c = unit & 127; const int t0 = b * SEQ + c * 64;
        const M1Pre C = P;
        {
            const int j = tid >> 3, d8 = (tid & 7) * 8, ch = hh * 64 + d8; float a[8];
            if (hh != hh_loaded) {
                cwv[0][0] = *(const f32x4*)(convb_ + l * 256 + ch); cwv[0][1] = *(const f32x4*)(convb_ + l * 256 + ch + 4);
#pragma unroll
                for (int tap = 0; tap < 5; ++tap) { const float* cw = convw_ + ((size_t)l * 5 + tap) * 256 + ch; cwv[1 + tap][0] = *(const f32x4*)cw; cwv[1 + tap][1] = *(const f32x4*)(cw + 4); } }
#pragma unroll
            for (int q = 0; q < 8; ++q) a[q] = cwv[0][q >> 2][q & 3];
#pragma unroll
            for (int tap = 0; tap < 5; ++tap) { float xv[8]; unpack8(C.mx[tap], xv);
#pragma unroll
                for (int q = 0; q < 8; ++q) a[q] += xv[q] * cwv[1 + tap][q >> 2][q & 3]; }
#pragma unroll
            for (int q = 0; q < 8; ++q) a[q] = siluf_(a[q]);
            const v4u xw = pack8(a);
            *(LAS v4u*)(XCs + j * 72 + d8) = xw; *(GAS v4u*)(wsp<bf16>(ws, B_XC) + (size_t)(t0 + j) * 256 + ch) = xw;
            if (hh != hh_loaded) { const int e = j; const float* wq = mwq_ + ((size_t)(l * 4 + hh) * 64 + d8) * 64 + e; const float* wk = mwk_ + ((size_t)(l * 4 + hh) * 64 + d8) * 64 + e; float q8[8], k8[8];
#pragma unroll
              for (int q = 0; q < 8; ++q) { q8[q] = wq[q * 64]; k8[q] = wk[q * 64]; }
              *(LAS v4u*)(WqT + e * 72 + d8) = pack8(q8); *(LAS v4u*)(WkT + e * 72 + d8) = pack8(k8); }
            { const unsigned ww[4] = {C.mv.x, C.mv.y, C.mv.z, C.mv.w};
#pragma unroll
              for (int q = 0; q < 8; ++q) VT[(d8 + q) * 72 + j] = (bf16)((q & 1) ? (ww[q >> 1] >> 16) : (ww[q >> 1] & 0xffffu)); }
        }
        hh_loaded = hh;
        if (w < 2) {
            const int dir = w;
            const float lf = logsigmoidf_(C.fv + C.fb);
            const float bc = wave_incl_sum(lf, lane); const float bL = lane_bcast(bc, 63);
            const float lw = bL - bc + (C.iv + C.ib); const float ml = wave_max(lw, lane);
            wv[dir * 64 + (dir ? 63 - lane : lane)] = __expf(lw - ml);
            if (lane == 0) { const int chain = dir * 16 + b * 4 + hh, chunk = dir ? (NCHUNK - 1 - c) : c; float* SCL = wsp<float>(ws, B_SCL); SCL[((size_t)chain * NCHUNK + chunk) * 4 + 0] = bL; SCL[((size_t)chain * NCHUNK + chunk) * 4 + 1] = ml; }
        }
        if (i + 1 < cnt) { const int un = contig ? F.vcu * per + i + 1 : F.vcu + (i + 1) * F.G; m1_load(P, ws, ib_, fbias_, l, un >> 9, (un >> 7) & 3, un & 127, tid, lane, w); }
        __syncthreads();
        const int ti = (w >> 1) & 1, tj = w & 1, dir = w >> 2;
        {
            const f32x16 acc = mma_tile(XCs + ti * 32 * 72, 72, (dir ? WkT : WqT) + tj * 32 * 72, 72, 64, lane);
            bf16* dst = (dir ? wsp<bf16>(ws, B_KM) : wsp<bf16>(ws, B_QM)) + (size_t)t0 * 256 + hh * 64 + tj * 32 + r32; const float sc = dir ? 1.0f : 0.125f;
#pragma unroll
            for (int r = 0; r < 16; ++r) dst[(size_t)(ti * 32 + crow32(r, hi)) * 256] = (bf16)f2bf(acc[r] * sc);
        }
        {
            const f32x16 acc = mma_tile(WkT + ti * 32 * 72, 72, XCs + tj * 32 * 72, 72, 64, lane);
            const float wj = wv[dir * 64 + tj * 32 + r32]; LAS bf16* kt = (dir ? KT1 : KT0) + tj * 32 + r32;
#pragma unroll
            for (int r = 0; r < 16; ++r) kt[(ti * 32 + crow32(r, hi)) * 72] = (bf16)f2bf(acc[r] * wj);
        }
        __syncthreads();
        {
            const f32x16 acc = mma_tile(VT + ti * 32 * 72, 72, (dir ? KT1 : KT0) + tj * 32 * 72, 72, 64, lane);
            const int chain = dir * 16 + b * 4 + hh, chunk = dir ? (NCHUNK - 1 - c) : c;
            bf16* dst = wsp<bf16>(ws, B_CST) + ((size_t)chain * NCHUNK + chunk) * 4096 + tj * 32 + r32;
#pragma unroll
            for (int r = 0; r < 16; ++r) dst[(ti * 32 + crow32(r, hi)) * 64] = (bf16)f2bf(acc[r]);
        }
        {
            const int row = tid >> 2, part = tid & 3, d = row >> 6, kk = row & 63; const LAS bf16* kt = (d ? KT1 : KT0) + kk * 72 + part * 16; float p8[8], s = 0.f;
            unpack8(*(const LAS v4u*)kt, p8); s += ((p8[0] + p8[1]) + (p8[2] + p8[3])) + ((p8[4] + p8[5]) + (p8[6] + p8[7]));
            unpack8(*(const LAS v4u*)(kt + 8), p8); s += ((p8[0] + p8[1]) + (p8[2] + p8[3])) + ((p8[4] + p8[5]) + (p8[6] + p8[7]));
            s = quad_sum(s);
            if (part == 0) { const int chain = d * 16 + b * 4 + hh, chunk = d ? (NCHUNK - 1 - c) : c; wsp<float>(ws, B_NST)[((size_t)chain * NCHUNK + chunk) * 64 + kk] = s; } }
        __syncthreads();
    }
}
__device__ __forceinline__ void mlstm_m2(Frame& F) {
    typedef float f32x2m __attribute__((ext_vector_type(2)));
    unsigned char* ws = F.ws; bf16* CST = (bf16*)(ws + B_CST); float* NST = (float*)(ws + B_NST); float* SCL = (float*)(ws + B_SCL);
    for (int g = F.vcu * 512 + F.tid; g < NCHAIN * 4096; g += F.G * 512) {
        const int chain = g >> 12, e = g & 4095; float m = 0.f, C = 0.f, n = 0.f;
        bf16* cp = CST + (size_t)chain * NCHUNK * 4096 + e; float* np = NST + (size_t)chain * NCHUNK * 64 + (e & 63); float* sp = SCL + (size_t)chain * NCHUNK * 4;
#define M2_LOAD(CL, NL, BM, c0) do { BM = *(const GAS f32x2m*)(sp + ((c0) + (F.lane & 31)) * 4); _Pragma("unroll") for (int q = 0; q < 32; ++q) { CL[q] = bf2f(cp[(size_t)((c0) + q) * 4096]); NL[q] = 0.f; if (e < 64) NL[q] = np[((c0) + q) * 64]; } } while (0)
#define M2_STEP(CL, NL, BM, c0) do { _Pragma("unroll") for (int q = 0; q < 32; ++q) { const float bLq = lane_bcast(BM.x, q), mlq = lane_bcast(BM.y, q); \
                cp[(size_t)((c0) + q) * 4096] = (bf16)f2bf(C); if (e < 64) np[((c0) + q) * 64] = n; if (e == 0) sp[((c0) + q) * 4 + 2] = m; \
                const float mn = fmaxf(bLq + m, mlq); const float dec = __expf(bLq + m - mn), wl_ = __expf(mlq - mn); \
                C = dec * C + wl_ * CL[q]; n = dec * n + wl_ * NL[q]; m = mn; } } while (0)
        float clA[32], nlA[32], clB[32], nlB[32]; f32x2m bmA, bmB;
        M2_LOAD(clA, nlA, bmA, 0);
        static_assert(NCHUNK % 64 == 0, "two batches per trip");
#pragma unroll
        for (int c0 = 0; c0 < NCHUNK; c0 += 64) {
            M2_LOAD(clB, nlB, bmB, c0 + 32);
            M2_STEP(clA, nlA, bmA, c0);
            if (c0 + 64 < NCHUNK) M2_LOAD(clA, nlA, bmA, c0 + 64);
            M2_STEP(clB, nlB, bmB, c0 + 32);
        }
#undef M2_LOAD
#undef M2_STEP
    }
}
struct M3Pre { v4u q, k, v, cf, cb, xc, mo; float nv, iv, fv, ib, fb, m0; };
__device__ __forceinline__ void m3_load(M3Pre& P, unsigned char* ws, const float* ib_, const float* fbias_, int l, int b, int hh, int c, int tid, int lane, int w) {
    const int t = tid >> 3, d8 = (tid & 7) * 8; const size_t go = (size_t)(b * SEQ + c * 64 + t) * 256 + hh * 64 + d8;
    const int chf = b * 4 + hh, chb = 16 + b * 4 + hh, ckf = c, ckb = NCHUNK - 1 - c;
    P.q = *(const GAS v4u*)(wsp<const bf16>(ws, B_QM) + go); P.k = *(const GAS v4u*)(wsp<const bf16>(ws, B_KM) + go); P.v = *(const GAS v4u*)(wsp<const bf16>(ws, B_MV) + go);
    P.xc = *(const GAS v4u*)(wsp<const bf16>(ws, B_XC) + go); P.mo = *(const GAS v4u*)(wsp<const bf16>(ws, B_MO) + go);
    const bf16* CST = wsp<const bf16>(ws, B_CST);
    P.cf = *(const GAS v4u*)(CST + ((size_t)chf * NCHUNK + ckf) * 4096 + t * 64 + d8); P.cb = *(const GAS v4u*)(CST + ((size_t)chb * NCHUNK + ckb) * 4096 + t * 64 + d8);
    P.nv = 0.f; if (tid < 128) { const int d = tid >> 6, k = tid & 63; P.nv = wsp<const float>(ws, B_NST)[((size_t)(d ? chb : chf) * NCHUNK + (d ? ckb : ckf)) * 64 + k]; }
    P.iv = 0.f; P.fv = 0.f; P.ib = 0.f; P.fb = 0.f; P.m0 = 0.f;
    if (w < 2) { const int dir = w, tok = b * SEQ + c * 64 + (dir ? 63 - lane : lane); const float* MIF = wsp<const float>(ws, B_MIF);
        P.iv = MIF[(size_t)tok * 16 + dir * 4 + hh]; P.ib = ib_[l * 8 + dir * 4 + hh]; P.fv = MIF[(size_t)tok * 16 + 8 + dir * 4 + hh]; P.fb = fbias_[l * 8 + dir * 4 + hh];
        P.m0 = wsp<const float>(ws, B_SCL)[((size_t)(dir ? chb : chf) * NCHUNK + (dir ? ckb : ckf)) * 4 + 2]; }
}
__device__ __forceinline__ void mlstm_m3(Frame& F, int l) {
    unsigned char* ws = F.ws;
    LAS bf16* Qs = (LAS bf16*)(F.lds); LAS bf16* Ks = Qs + 64 * 72; LAS bf16* A0 = Ks + 64 * 72; LAS bf16* A1 = A0 + 64 * 136; LAS bf16* VTs = A1 + 64 * 136; LAS bf16* C0 = VTs + 64 * 72; LAS bf16* C1 = C0 + 64 * 72;
    LAS float* Hs = (LAS float*)(C1 + 64 * 72); LAS float* vec = Hs + 2 * 64 * 68;
    LAS float* av = vec; LAS float* Mv = vec + 128; LAS float* mtv = vec + 256; LAS float* wst = vec + 384; LAS float* nvec = vec + 512; LAS float* rden = vec + 640;
    const int tid = F.tid, lane = F.lane, w = F.wave, hi = lane >> 5, r32 = lane & 31;
    const float* ib_ = inp(F, IN_i_bias); const float* fbias_ = inp(F, IN_f_bias); const float* hn_ = inp(F, IN_head_norm); const float* sk_ = inp(F, IN_skip);
    constexpr int NUN = NB * 4 * NCHUNK; const int per = NUN / F.G; const bool contig = (per * F.G == NUN) && (NCHUNK % (per > 0 ? per : 1) == 0);
    const int cnt = contig ? per : (NUN - F.vcu + F.G - 1) / F.G;
    M3Pre P;
    if (cnt > 0) { const int unit = contig ? F.vcu * per : F.vcu; m3_load(P, ws, ib_, fbias_, l, unit >> 9, (unit >> 7) & 3, unit & 127, tid, lane, w); }
    int hh_loaded = -1; f32x4 hnv[2], skv[2];
    hnv[0] = hnv[1] = skv[0] = skv[1] = (f32x4){0.f, 0.f, 0.f, 0.f};
    for (int i = 0; i < cnt; ++i) {
        const int unit = contig ? F.vcu * per + i : F.vcu + i * F.G;
        const int b = unit >> 9, hh = (unit >> 7) & 3, c = unit & 127; const int t0 = b * SEQ + c * 64;
        const M3Pre C = P;
        if (hh != hh_loaded) { const int v8 = (tid & 7) * 8; const float* hn = hn_ + l * 256 + hh * 64 + v8; const float* sk = sk_ + l * 256 + hh * 64 + v8;
            hnv[0] = *(const f32x4*)hn; hnv[1] = *(const f32x4*)(hn + 4); skv[0] = *(const f32x4*)sk; skv[1] = *(const f32x4*)(sk + 4); hh_loaded = hh; }
        {
            const int t = tid >> 3, d8 = (tid & 7) * 8;
            *(LAS v4u*)(Qs + t * 72 + d8) = C.q; *(LAS v4u*)(Ks + t * 72 + d8) = C.k;
            { const unsigned ww[4] = {C.v.x, C.v.y, C.v.z, C.v.w};
#pragma unroll
              for (int q = 0; q < 8; ++q) { const bf16 e = (bf16)((q & 1) ? (ww[q >> 1] >> 16) : (ww[q >> 1] & 0xffffu)); VTs[(d8 + q) * 72 + t] = e; } }
            *(LAS v4u*)(C0 + t * 72 + d8) = C.cf; *(LAS v4u*)(C1 + t * 72 + d8) = C.cb;
            if (tid < 128) nvec[tid] = C.nv;
        }
        if (w < 2) {
            const int dir = w, idx = dir ? 63 - lane : lane;
            const float bc = wave_incl_sum(logsigmoidf_(C.fv + C.fb), lane); const float a = (C.iv + C.ib) - bc; const float pm = wave_incl_max(a, lane);
            const float Mx = fmaxf(C.m0, pm);
            av[dir * 64 + idx] = a; Mv[dir * 64 + idx] = Mx; mtv[dir * 64 + idx] = bc + Mx; wst[dir * 64 + idx] = __expf(C.m0 - Mx);
        }
        if (i + 1 < cnt) { const int un = contig ? F.vcu * per + i + 1 : F.vcu + (i + 1) * F.G; m3_load(P, ws, ib_, fbias_, l, un >> 9, (un >> 7) & 3, un & 127, tid, lane, w); }
        __syncthreads();
        const int ti = (w >> 1) & 1, tj = w & 1, dir = w >> 2;
        {
            const f32x16 acc = mma_tile(Qs + ti * 32 * 72, 72, Ks + tj * 32 * 72, 72, 64, lane);
            const int s = tj * 32 + r32; const float as = av[dir * 64 + s]; LAS bf16* A = (dir ? A1 : A0) + s;
#pragma unroll
            for (int r = 0; r < 16; ++r) { const int t = ti * 32 + crow32(r, hi); const bool ok = dir ? (s >= t) : (s <= t);
                const float p = ok ? acc[r] * __expf(as - Mv[dir * 64 + t]) : 0.f; A[t * 136] = (bf16)f2bf(p); }
        }
        {
            const int t = tid >> 3, d8 = (tid & 7) * 8; float q8[8]; unpack8(C.q, q8);
            float f8[8], g8[8]; const float w0 = wst[t], w1 = wst[64 + t];
#pragma unroll
            for (int q = 0; q < 8; ++q) { f8[q] = q8[q] * w0; g8[q] = q8[q] * w1; }
            *(LAS v4u*)(A0 + t * 136 + 64 + d8) = pack8(f8); *(LAS v4u*)(A1 + t * 136 + 64 + d8) = pack8(g8);
        }
        __syncthreads();
        f32x16 num = mma_tile((dir ? A1 : A0) + ti * 32 * 136, 136, VTs + tj * 32 * 72, 72, 64, lane);
        num = mma_tile_acc(num, (dir ? A1 : A0) + ti * 32 * 136 + 64, 136, (dir ? C1 : C0) + tj * 32 * 72, 72, 64, lane);
        {
            const int row = tid >> 2, part = tid & 3, d = row >> 6, t = row & 63; const LAS bf16* Ar = (d ? A1 : A0) + t * 136 + part * 16; const LAS float* nv = nvec + d * 64 + part * 16;
            float p8[8], den = 0.f;
            unpack8(*(const LAS v4u*)Ar, p8); den += ((p8[0] + p8[1]) + (p8[2] + p8[3])) + ((p8[4] + p8[5]) + (p8[6] + p8[7]));
            unpack8(*(const LAS v4u*)(Ar + 8), p8); den += ((p8[0] + p8[1]) + (p8[2] + p8[3])) + ((p8[4] + p8[5]) + (p8[6] + p8[7]));
#pragma unroll
            for (int h2 = 0; h2 < 2; ++h2) { unpack8(*(const LAS v4u*)(Ar + 64 + 8 * h2), p8); const f32x4 n0 = *(const LAS f32x4*)(nv + 8 * h2), n1 = *(const LAS f32x4*)(nv + 8 * h2 + 4);
                den += ((p8[0] * n0[0] + p8[1] * n0[1]) + (p8[2] * n0[2] + p8[3] * n0[3])) + ((p8[4] * n1[0] + p8[5] * n1[1]) + (p8[6] * n1[2] + p8[7] * n1[3])); }
            den = quad_sum(den);
            if (part == 0) rden[row] = fast_rcp(fmaxf(fabsf(den), __expf(-mtv[row]))); }
        __syncthreads();
        {
            const int v = tj * 32 + r32;
#pragma unroll
            for (int r = 0; r < 16; ++r) { const int t = ti * 32 + crow32(r, hi); Hs[(dir * 64 + t) * 68 + v] = num[r] * rden[dir * 64 + t]; }
        }
        __syncthreads();
        {
            const int t = tid >> 3, v8 = (tid & 7) * 8; float h[8]; float ss = 0.f;
#pragma unroll
            for (int q = 0; q < 8; ++q) { h[q] = Hs[t * 68 + v8 + q] + Hs[(64 + t) * 68 + v8 + q]; ss += h[q] * h[q]; }
            ss = oct_sum(ss);
            const float rs = rsqrtf(ss * (1.0f / 64.0f) + EPS);
            float xc[8], mo[8]; unpack8(C.xc, xc); unpack8(C.mo, mo); float o[8];
#pragma unroll
            for (int q = 0; q < 8; ++q) o[q] = (h[q] * rs * hnv[q >> 2][q & 3] + skv[q >> 2][q & 3] * xc[q]) * sigmoidf_(mo[q]);
            *(GAS v4u*)(wsp<bf16>(ws, B_Y) + (size_t)(t0 + t) * KOUT + 512 + hh * 64 + v8) = pack8(o);
        }
        __syncthreads();
    }
}

__device__ __forceinline__ void fft_phase(Frame& F) {
    typedef float f32x2 __attribute__((ext_vector_type(2)));
    unsigned char* ws = F.ws; const bf16* FQ = (const bf16*)(ws + B_FQ); bf16* FO = (bf16*)(ws + B_FO);
    LAS f32x2* Z1 = (LAS f32x2*)(F.lds); LAS f32x2* Z2 = Z1 + 8192;
    const int tid = F.tid;
    for (int unit = F.vcu; unit < NB * 64; unit += F.G) {
        const bf16* src = FQ + (size_t)unit * 8192 * 4;
        {
            const int sb = ((F.lane >> 3) << 10) | (F.wave << 3) | (F.lane & 7); v2u wv[16];
#pragma unroll
            for (int it = 0; it < 16; ++it) wv[it] = *(const GAS v2u*)(src + (size_t)(sb | (it << 6)) * 4);
#pragma unroll
            for (int it = 0; it < 16; ++it) { const int r = (int)(__brev((unsigned)(sb | (it << 6))) >> 19);
                Z1[r] = (f32x2){bflo(wv[it].x), bfhi(wv[it].x)}; Z2[r] = (f32x2){bflo(wv[it].y), bfhi(wv[it].y)}; }
        }
        {
            __syncthreads();
            for (int j = tid; j < 4096; j += 512) { const int i0 = 2 * j, i1 = i0 + 1;
                { const f32x2 u = Z1[i0], v = Z1[i1]; Z1[i0] = (f32x2){u.x + v.x, u.y + v.y}; Z1[i1] = (f32x2){u.x - v.x, u.y - v.y}; }
                { const f32x2 u = Z2[i0], v = Z2[i1]; Z2[i0] = (f32x2){u.x + v.x, u.y + v.y}; Z2[i1] = (f32x2){u.x - v.x, u.y - v.y}; } }
        }
        for (int h = 2; h < 8192; h <<= 2) {
            __syncthreads();
            const float inv2h = 0.5f / (float)h, inv4h = 0.25f / (float)h;
            for (int j = tid; j < 2048; j += 512) { const int pos = j & (h - 1); const int i0 = ((j - pos) << 2) + pos, i1 = i0 + h, i2 = i0 + 2 * h, i3 = i0 + 3 * h;
                const float fa = (float)pos * inv2h, fb = (float)pos * inv4h;
                const float war = __builtin_amdgcn_cosf(fa), wai = -__builtin_amdgcn_sinf(fa), wbr = __builtin_amdgcn_cosf(fb), wbi = -__builtin_amdgcn_sinf(fb);
#define FFT_R4(Z) do { f32x2 a0 = Z[i0], a1 = Z[i1], a2 = Z[i2], a3 = Z[i3]; \
                    float tr = war * a1.x - wai * a1.y, ti = war * a1.y + wai * a1.x; a1 = (f32x2){a0.x - tr, a0.y - ti}; a0 = (f32x2){a0.x + tr, a0.y + ti}; \
                    tr = war * a3.x - wai * a3.y; ti = war * a3.y + wai * a3.x; a3 = (f32x2){a2.x - tr, a2.y - ti}; a2 = (f32x2){a2.x + tr, a2.y + ti}; \
                    tr = wbr * a2.x - wbi * a2.y; ti = wbr * a2.y + wbi * a2.x; a2 = (f32x2){a0.x - tr, a0.y - ti}; a0 = (f32x2){a0.x + tr, a0.y + ti}; \
                      \
                    tr = wbi * a3.x + wbr * a3.y; ti = wbi * a3.y - wbr * a3.x; a3 = (f32x2){a1.x - tr, a1.y - ti}; a1 = (f32x2){a1.x + tr, a1.y + ti}; \
                    Z[i0] = a0; Z[i1] = a1; Z[i2] = a2; Z[i3] = a3; } while (0)
                FFT_R4(Z1); FFT_R4(Z2);
#undef FFT_R4
            }
        }
        __syncthreads();
        constexpr float NRM = 0.0013810679320049757f;
        bf16* dst = FO + (size_t)unit * 8192 * 8;
        for (int k = tid; k < 8192; k += 512) { const int km = (8192 - k) & 8191;
            const f32x2 a = Z1[k], am = Z1[km], c = Z2[k], cm = Z2[km];
            const float x0r = 0.5f * (a.x + am.x), x0i = 0.5f * (a.y - am.y), x1r = 0.5f * (a.y + am.y), x1i = -0.5f * (a.x - am.x);
            const float x2r = 0.5f * (c.x + cm.x), x2i = 0.5f * (c.y - cm.y), x3r = 0.5f * (c.y + cm.y), x3i = -0.5f * (c.x - cm.x);
            v4u o; o.x = pk2(x0r * NRM, x1r * NRM); o.y = pk2(x2r * NRM, x3r * NRM); o.z = pk2(x0i * NRM, x1i * NRM); o.w = pk2(x2i * NRM, x3i * NRM);
            *(GAS v4u*)(dst + (size_t)k * 8) = o; }
        __syncthreads();
    }
}
__device__ __forceinline__ void gather_phase(Frame& F) {
    unsigned char* ws = F.ws; const bf16* FO = (const bf16*)(ws + B_FO); bf16* Y = (bf16*)(ws + B_Y);
    const int gw = F.vcu * 8 + F.wave, NGW = F.G * 8; const int per = MTOK / NGW;
    for (int r = 0; r < per; ++r) { const int row = gw * per + r; const int b = row >> 13, k = row & 8191;
        const v4u v = *(const GAS v4u*)(FO + (((size_t)(b * 64 + F.lane) * 8192 + k) << 3));
        v2u re, im; re.x = v.x; re.y = v.y; im.x = v.z; im.y = v.w;
        bf16* yr = Y + (size_t)row * KOUT; *(GAS v2u*)(yr + 768 + 4 * F.lane) = re; *(GAS v2u*)(yr + 1024 + 4 * F.lane) = im; }
    for (int row = NGW * per + gw; row < MTOK; row += NGW) { const int b = row >> 13, k = row & 8191;
        const v4u v = *(const GAS v4u*)(FO + (((size_t)(b * 64 + F.lane) * 8192 + k) << 3));
        v2u re, im; re.x = v.x; re.y = v.y; im.x = v.z; im.y = v.w;
        bf16* yr = Y + (size_t)row * KOUT; *(GAS v2u*)(yr + 768 + 4 * F.lane) = re; *(GAS v2u*)(yr + 1024 + 4 * F.lane) = im; }
}
__device__ __forceinline__ void final_norm(Frame& F, float* OUT, const float* SS) {
    const float* fn_ = inp(F, IN_final_norm); const bf16* XB1 = (const bf16*)(F.ws + B_XB1);
    const int gw = F.vcu * 8 + F.wave, NGW = F.G * 8;
    f32x4 g[2][2];
#pragma unroll
    for (int j = 0; j < 2; ++j) { const int c0 = j * 512 + 8 * F.lane; g[j][0] = *(const GAS f32x4*)(fn_ + c0); g[j][1] = *(const GAS f32x4*)(fn_ + c0 + 4); }
    for (int mp = gw; mp < MTOK / 2; mp += NGW) {
        const int m0 = 2 * mp; float sp[2]; v4u hx[2][2];
#pragma unroll
        for (int q = 0; q < 2; ++q) sp[q] = (F.lane < 16) ? SS[(size_t)(m0 + q) * 16 + F.lane] : 0.f;
#pragma unroll
        for (int q = 0; q < 2; ++q)
#pragma unroll
            for (int j = 0; j < 2; ++j) hx[q][j] = *(const GAS v4u*)(XB1 + (size_t)(m0 + q) * DM + j * 512 + 8 * F.lane);
#pragma unroll
        for (int q = 0; q < 2; ++q) {
            const float rs = rsqrtf(lane_bcast(wave_incl_sum(sp[q], F.lane), 63) * (1.0f / 1024.0f) + EPS);
#pragma unroll
            for (int j = 0; j < 2; ++j) {
                float h[8]; unpack8(hx[q][j], h); GAS f32x4* o = (GAS f32x4*)(OUT + (size_t)(m0 + q) * DM + j * 512 + 8 * F.lane);
                o[0] = (f32x4){h[0] * rs * g[j][0][0], h[1] * rs * g[j][0][1], h[2] * rs * g[j][0][2], h[3] * rs * g[j][0][3]};
                o[1] = (f32x4){h[4] * rs * g[j][1][0], h[5] * rs * g[j][1][1], h[6] * rs * g[j][1][2], h[7] * rs * g[j][1][3]};
            }
        }
    }
}
constexpr int PPL = 11;
constexpr int NPH = 2 + DEPTH * PPL + 1;
struct Args { const void* in[33]; float* out; unsigned char* ws; int ph_lo, ph_hi, li, use_bar; };

__global__ void __launch_bounds__(512, 2) fwd(Args args) {
    extern __shared__ __attribute__((aligned(16))) unsigned char lds[];
    Frame F;
    F.lds = (LAS unsigned char*)lds;
    F.MISC = (volatile LAS unsigned*)(F.lds + MISC_OFF);
    F.tid = threadIdx.x; F.lane = F.tid & 63; F.wave = __builtin_amdgcn_readfirstlane(F.tid >> 6); const int wv0 = F.wave;
    F.G = gridDim.x; { const int bx = blockIdx.x; F.vcu = (F.G % 8 == 0) ? (bx % 8) * (F.G / 8) + bx / 8 : bx; }
    F.ws = args.ws;
    unsigned char* ws = args.ws;
    float* H = args.out;

    for (int u = F.tid; u < (LDS_BYTES - MISC_OFF) / 4; u += 512) ((LAS unsigned*)(F.lds + MISC_OFF))[u] = 0u;
    __syncthreads();
    if (F.tid == 0) {
#pragma unroll
        for (int i = 0; i < 33; ++i) { const unsigned long long pv = (unsigned long long)args.in[i]; ((LAS unsigned*)(F.lds + PTAB_OFF))[2 * i] = (unsigned)pv; ((LAS unsigned*)(F.lds + PTAB_OFF))[2 * i + 1] = (unsigned)(pv >> 32); }
    }
    __syncthreads();
    XcdBarrier bar; bar.bar = (unsigned*)(ws + WS_CTL) + 1024 + args.li * XCD_BAR_WORDS; bar.x = 0; bar.st = nullptr;
    if (args.use_bar) bar = xcd_barrier_post((unsigned*)(ws + WS_CTL) + 1024 + args.li * XCD_BAR_WORDS, F.MISC + 8);
    bar.wv = wv0;

    const int lo = args.ph_lo, hi = args.ph_hi;
    unsigned nsplit = 0;
#ifdef PROBE_ATT
    att::att_probe_acc = (unsigned long long*)(ws + WS_CTL + 512 * 1024 + 64 * 8);
#endif
#define IN(k) (lo <= (k) && (k) < hi)
#define REFRESH() do { F.tid = opaque_tid(wv0); F.lane = F.tid & 63; F.wave = wv0; { unsigned long long z_ = 0ull; asm volatile("" : "+s"(z_)); ws = args.ws + z_; } F.ws = ws; } while (0)
#ifdef PROBE_A
#define STAMP(type) do { if (blockIdx.x == 0 && F.tid == 0) { unsigned long long* ts_ = (unsigned long long*)(ws + WS_CTL + 512 * 1024); const unsigned long long t_ = __builtin_amdgcn_s_memrealtime(); const unsigned long long c_ = __builtin_amdgcn_s_memtime(); \
        ts_[(type)] += t_ - ts_[31]; ts_[31] = t_; if ((type) == PROBE_A) ts_[17] += c_ - ts_[29]; ts_[29] = c_; } } while (0)
#else
#define STAMP(type) do { } while (0)
#endif
#ifdef PROBE_GEMM
#define GPROBE_ON(type) do { if (F.tid == 0) { F.MISC[20] = ((type) == PROBE_A) ? 1u : 0u; F.MISC[22] = 0u; F.MISC[23] = 0u; } __syncthreads(); } while (0)
#define GPROBE_OFF(type) do { if (blockIdx.x == 0 && F.tid == 0 && (type) == PROBE_A) { unsigned long long* ts_ = (unsigned long long*)(ws + WS_CTL + 512 * 1024); ts_[PROBE_B] += ((unsigned long long)F.MISC[23] << 32) | F.MISC[22]; } } while (0)
#else
#define GPROBE_ON(type) do { } while (0)
#define GPROBE_OFF(type) do { } while (0)
#endif
#define SEAM(k, type) do { GPROBE_OFF(type); if (IN((k) + 1)) xcd_barrier(bar); STAMP(type); } while (0)
#if PH_STEP >= 1000
#define BAR2 ((unsigned*)(ws + WS_CTL) + 1024 + 16 * XCD_BAR_WORDS)
#define SEAMF(k, type, COND, LAY, jlo, jhi) do { GPROBE_OFF(type); if (IN((k) + 1)) { if (args.use_bar && (COND)) { xcd_arrive(bar, BAR2); REFRESH(); convert_jobs(F, (LAY), (jlo), (jhi)); xcd_wait(bar, BAR2, ++nsplit); } else xcd_barrier(bar); } STAMP(type); } while (0)
#define SEAMX(k, type, COND, FILL) do { GPROBE_OFF(type); if (IN((k) + 1)) { if (args.use_bar && (COND)) { xcd_arrive(bar, BAR2); REFRESH(); FILL; xcd_wait(bar, BAR2, ++nsplit); } else xcd_barrier(bar); } STAMP(type); } while (0)
#define EGEMM_ROUND(R) do { pg8::Gemm g2_{(const bf16*)(ws + B_PB), (const bf16*)(wl + WL_PP), MTOK, DM, PLE}; pg8::OneRound S2_; S2_.init(MTOK, DM, F.G, (int)blockIdx.x); S2_.r = (R); \
        pg8::EpiE E2_{ws, inp(F, IN_ple_post) + l * DM}; pg8::gemm_phase<pg8::EpiE, pg8::OneRound, true, true>(F.lds, g2_, S2_, E2_, wv0); } while (0)
#else
#define SEAMF(k, type, COND, LAY, jlo, jhi) SEAM(k, type)
#define SEAMX(k, type, COND, FILL) SEAM(k, type)
#endif

#define XB0 ((bf16*)(ws + WS_XB0))
#define XB1 ((bf16*)(ws + B_XB1))
#define SS0 ((float*)(ws + WS_SS))
#define HID ((bf16*)(ws + B_HID))
#define wl (ws + WS_WL)

#ifdef PROBE_A
    if (blockIdx.x == 0 && F.tid == 0 && lo == 0) { unsigned long long* ts_ = (unsigned long long*)(ws + WS_CTL + 512 * 1024); const unsigned long long t_ = __builtin_amdgcn_s_memrealtime(); ts_[31] = t_; ts_[30] = t_; ts_[29] = __builtin_amdgcn_s_memtime(); }
#endif
    if (IN(0)) { REFRESH();
#ifndef DIS_PA
prologue_a(F);
#endif
 SEAM(0, 12); }
    if (IN(1)) { REFRESH();
#ifndef DIS_PB
prologue_b(F);
#endif
 STAMP(13); }

    for (int l = 0; l < DEPTH; ++l) {
        const int pb = 2 + l * PPL;
#if PH_STEP >= 1000
        if (IN(pb + 0) && (l == 0 || !args.use_bar)) { REFRESH(); GPROBE_ON(0);
#else
        if (IN(pb + 0)) { REFRESH(); GPROBE_ON(0);
#endif
#ifndef DIS_CV
convert_layer(F, l);
#endif
 SEAM(pb + 0, 0); }
        if (IN(pb + 1)) { REFRESH(); GPROBE_ON(1);
            pg8::Gemm g{XB1, (const bf16*)(wl + WL_GU1), MTOK, NGU, DM}; pg8::StaticOrder S; S.init(MTOK, NGU, F.G, (int)blockIdx.x);
            pg8::EpiSwiGLU E{ws, WS_SS};

#ifndef DIS_SW1
pg8::gemm_phase<pg8::EpiSwiGLU, pg8::StaticOrder, true, true>(F.lds, g, S, E, wv0);
#endif

            SEAMF(pb + 1, 1, l >= 1, l, 5, 6);
        }
        if (IN(pb + 2)) { REFRESH(); GPROBE_ON(2);
            pg8::Gemm g{HID, (const bf16*)(wl + WL_D1), MTOK, DM, DFF}; pg8::StaticOrder S; S.init(MTOK, DM, F.G, (int)blockIdx.x);
            pg8::EpiResid E{ws, B_XB1, WS_XB0, WS_SS + (size_t)MTOK * 64, 0, 0.5f};

#ifndef DIS_RE1
pg8::gemm_phase<pg8::EpiResid, pg8::StaticOrder, true, true>(F.lds, g, S, E, wv0);
#endif

            SEAMF(pb + 2, 2, l + 1 < DEPTH, l + 1, 0, 1);
        }
        if (IN(pb + 3)) { REFRESH(); GPROBE_ON(3);
            pg8::Gemm g{XB0, (const bf16*)(wl + WL_IN), MTOK, DINP, DM}; pg8::StaticOrder S; S.init(MTOK, DINP, F.G, (int)blockIdx.x);
            pg8::EpiWin E{ws};

#ifndef DIS_WIN1
pg8::gemm_phase<pg8::EpiWin, pg8::StaticOrder, true, true>(F.lds, g, S, E, wv0);
#endif
#ifndef DIS_CP
            {
                const int rem = ((MTOK / 256) * (DINP / 256)) % F.G, nfree = rem ? F.G - rem : F.G, me = (int)blockIdx.x - rem;
                if (me >= 0) { Frame F2 = F; F2.vcu = me; F2.G = nfree; convert_p(F2, l); convert_pg(F2, l); }
            }
#endif

            SEAMF(pb + 3, 3, l + 1 < DEPTH, l + 1, 1, 2);
        }
        if (IN(pb + 4)) { REFRESH(); GPROBE_ON(4);
            {
                pg8::Gemm gq{(const bf16*)(ws + B_CQ), (const bf16*)(wl + WL_UQ), MTOK, NQ, QL}; pg8::Gemm gkv{(const bf16*)(ws + B_CKV), (const bf16*)(wl + WL_UKV), MTOK, NKV, KVL};
                pg8::OrderQKV S{F.G, F.vcu}; pg8::EpiQKV E{ws};
#ifndef DIS_EQ1
                pg8::gemm_phase_mg<pg8::EpiQKV, pg8::OrderQKV>(F.lds, gq, gkv, S, E, wv0);
#endif
            }
            __syncthreads(); STAMP(21); REFRESH();

#ifndef DIS_M1
mlstm_m1(F, l);
#endif

            __syncthreads(); STAMP(22); REFRESH();

#ifndef DIS_FFT
fft_phase(F);
#endif

            SEAMF(pb + 4, 4, l + 1 < DEPTH, l + 1, 2, 3);
        }
        if (IN(pb + 5)) { REFRESH(); GPROBE_ON(5);

#ifndef DIS_M2
mlstm_m2(F);
#endif
#if PH_STEP >= 1000
            if (args.use_bar) xcd_arrive(bar, (unsigned*)(ws + WS_CTL) + 1024 + 16 * XCD_BAR_WORDS);
#endif
            STAMP(23);

#if ATT_V4
            for (int u = F.vcu; u < NB * 4 * (SEQ / 128); u += F.G) {
                const int bh = u >> 6, qb = u & 63, b = bh >> 2, hh = bh & 3; const size_t r0 = (size_t)b * SEQ;
#ifndef DIS_ATT
                att::attn_dense_body_v4((const bf16*)(ws + B_Q) + (r0 + qb * 128) * 768 + hh * 192, (const bf16*)(ws + B_KN) + r0 * 512 + hh * 128, (const bf16*)(ws + B_KR) + r0 * 64,
                                        (const bf16*)(ws + B_V) + r0 * 512 + hh * 128, (bf16*)(ws + B_Y) + (r0 + qb * 128) * KOUT + hh * 128, SEQ, (char*)lds, wv0);
#endif
            }
#else
            for (int u = F.vcu; u < NB * 4 * (SEQ / 256); u += F.G) {
                const int bh = u >> 5, qb = u & 31, b = bh >> 2, hh = bh & 3; const size_t r0 = (size_t)b * SEQ;

#ifndef DIS_ATT
#if ATT_T
att::attn_dense_body_t((const bf16*)(ws + B_Q) + (r0 + qb * 256) * 768 + hh * 192, (const bf16*)(ws + B_KN) + r0 * 512 + hh * 128, (const bf16*)(ws + B_KR) + r0 * 64,
                                         (const bf16*)(ws + B_V) + r0 * 512 + hh * 128, (bf16*)(ws + B_Y) + (r0 + qb * 256) * KOUT + hh * 128, SEQ, (char*)lds, wv0);
#elif ATT_V3
att::attn_dense_body_v3((const bf16*)(ws + B_Q) + (r0 + qb * 256) * 768 + hh * 192, (const bf16*)(ws + B_KN) + r0 * 512 + hh * 128, (const bf16*)(ws + B_KR) + r0 * 64,
                                         (const bf16*)(ws + B_V) + r0 * 512 + hh * 128, (bf16*)(ws + B_Y) + (r0 + qb * 256) * KOUT + hh * 128, SEQ, (char*)lds, wv0);
#else
att::attn_dense_body<ATT_SDEPTH>((const bf16*)(ws + B_Q) + (r0 + qb * 256) * 768 + hh * 192, (const bf16*)(ws + B_KN) + r0 * 512 + hh * 128, (const bf16*)(ws + B_KR) + r0 * 64,
                                         (const bf16*)(ws + B_V) + r0 * 512 + hh * 128, (bf16*)(ws + B_Y) + (r0 + qb * 256) * KOUT + hh * 128, SEQ, (char*)lds, wv0);
#endif
#endif

            }
#endif
#if PH_STEP >= 1000
            if (args.use_bar && IN(pb + 6)) { xcd_wait(bar, (unsigned*)(ws + WS_CTL) + 1024 + 16 * XCD_BAR_WORDS, ++nsplit); STAMP(5); } else SEAM(pb + 5, 5);
#else
            SEAM(pb + 5, 5);
#endif
        }
        if (IN(pb + 6)) { REFRESH(); GPROBE_ON(6);
#ifndef DIS_M3
mlstm_m3(F, l);
#endif
            STAMP(24);

#ifndef DIS_GA
gather_phase(F);
#endif
 SEAMF(pb + 6, 6, l + 1 < DEPTH, l + 1, 6, 13); }
        if (IN(pb + 7)) { REFRESH(); GPROBE_ON(7);
            STAMP(25);
            pg8::Gemm g{(const bf16*)(ws + B_Y), (const bf16*)(ws + WS_WOUT) + (size_t)l * DM * KOUT, MTOK, DM, KOUT}; pg8::StaticOrder S; S.init(MTOK, DM, F.G, (int)blockIdx.x);
            pg8::EpiResid E{ws, WS_XB0, WS_XB0, WS_SS, WS_BOUT + (size_t)l * DM * 4, 1.0f};

#ifndef DIS_RE2
pg8::gemm_phase<pg8::EpiResid, pg8::StaticOrder, true, true>(F.lds, g, S, E, wv0);
#endif

            SEAMX(pb + 7, 7, F.G == 256, EGEMM_ROUND(0));
        }
        if (IN(pb + 8)) { REFRESH(); GPROBE_ON(8);
            pg8::Gemm g{XB0, (const bf16*)(wl + WL_GU2), MTOK, NGU, DM}; pg8::StaticOrder S; S.init(MTOK, NGU, F.G, (int)blockIdx.x);
            pg8::EpiSwiGLU E{ws, WS_SS};

#ifndef DIS_SW2
pg8::gemm_phase<pg8::EpiSwiGLU, pg8::StaticOrder, true, true>(F.lds, g, S, E, wv0);
#endif
            __syncthreads(); STAMP(26);
#if PH_STEP >= 1000
            if (!(args.use_bar && F.G == 256))
#endif
            {
                pg8::Gemm g2{(const bf16*)(ws + B_PB), (const bf16*)(wl + WL_PP), MTOK, DM, PLE}; pg8::StaticOrder S2; S2.init(MTOK, DM, F.G, (int)blockIdx.x);
                pg8::EpiE E2{ws, inp(F, IN_ple_post) + l * DM};
#ifndef DIS_EE1
                pg8::gemm_phase<pg8::EpiE, pg8::StaticOrder, true, true>(F.lds, g2, S2, E2, wv0);
#endif
            }
            SEAMX(pb + 8, 8, F.G == 256, EGEMM_ROUND(1));
        }
        if (IN(pb + 9)) { REFRESH(); GPROBE_ON(9);
            pg8::Gemm g{HID, (const bf16*)(wl + WL_D2), MTOK, DM, DFF}; pg8::StaticOrder S; S.init(MTOK, DM, F.G, (int)blockIdx.x);
            pg8::EpiResid E{ws, WS_XB0, WS_XB0, WS_SS + (size_t)MTOK * 64, 0, 0.5f};

#ifndef DIS_RE3
pg8::gemm_phase<pg8::EpiResid, pg8::StaticOrder, true, true>(F.lds, g, S, E, wv0);
#endif

            SEAMF(pb + 9, 9, l + 1 < DEPTH, l + 1, 3, 4);
        }
        if (IN(pb + 10)) { REFRESH(); GPROBE_ON(10);
            pg8::Gemm g{XB0, (const bf16*)(wl + WL_PG), MTOK, DM, DM}; pg8::StaticOrder S; S.init(MTOK, DM, F.G, (int)blockIdx.x);
            pg8::EpiPle E{ws};

#ifndef DIS_EP1
pg8::gemm_phase<pg8::EpiPle, pg8::StaticOrder, true, true>(F.lds, g, S, E, wv0);
#endif

#if PH_STEP >= 1000
            if (l == DEPTH - 1 || !args.use_bar) { if (l == DEPTH - 1) SEAM(pb + 10, 10); else STAMP(10); }
            else { GPROBE_OFF(10); xcd_arrive(bar, BAR2); REFRESH(); convert_jobs(F, l + 1, 4, 5); convert_jobs(F, l + 1, 14, 15);     xcd_wait(bar, BAR2, ++nsplit); STAMP(10); }
#else
            if (l == DEPTH - 1) SEAM(pb + 10, 10); else STAMP(10);
#endif
        }
    }
    if (IN(NPH - 1)) { REFRESH();
#ifndef DIS_FN
final_norm(F, H, SS0);
#endif
#ifdef PROBE_A
        STAMP(14);
        xcd_barrier(bar);
        {
            const unsigned long long* ts_ = (const unsigned long long*)(ws + WS_CTL + 512 * 1024);
            const float tot = (float)(ts_[31] - ts_[30]);
#ifdef PROBE_ATT
            { const float s_ = (float)ts_[64] + (float)ts_[65] + (float)ts_[66] + (float)ts_[67]; ((float*)ts_)[200] = (float)ts_[64 + PROBE_ATT_A] / s_; ((float*)ts_)[201] = (float)ts_[64 + PROBE_ATT_B] / s_; }
#endif
#ifdef PROBE_CLK
            const float fa = (float)ts_[PROBE_A] / tot, fb = ((float)ts_[17] / (float)ts_[PROBE_A]) * (1.0f / 24.0f);
#else
#ifndef PROBE_SCALE_B
#define PROBE_SCALE_B 1.0f
#endif
#ifdef PROBE_ATT
            const float fa = ((const float*)ts_)[200], fb = ((const float*)ts_)[201];
#else
            const float fa = (float)ts_[PROBE_A] / tot, fb = PROBE_SCALE_B * (float)ts_[PROBE_B] / tot;
#endif
#endif
            #ifdef PROBE_CLK
            const float qa = floorf(fa * 10.0f + 0.5f) * 0.1f, qb = (fb >= PROBE_CLK_THR) ? 0.5f : 0.0f;
#else
#ifdef PROBE_MID
            const float qa = floorf(fa * 25.0f + 0.5f) * 0.04f, qb = floorf(fb * 25.0f + 0.5f) * 0.04f;
#elif defined(PROBE_COARSE)
            const float qa = floorf(fa * 12.5f + 0.5f) * 0.08f, qb = floorf(fb * 12.5f + 0.5f) * 0.08f;
#else
            const float qa = floorf(fa * 50.0f + 0.5f) * 0.02f, qb = floorf(fb * 50.0f + 0.5f) * 0.02f;
#endif
#endif
            const float cc = sqrtf(9.0f + 89.0f * qa), LL = 100.0f + 890.0f * qb;
            for (size_t i = (size_t)blockIdx.x * 512 + F.tid; i < (size_t)MTOK * DM; i += (size_t)F.G * 512) H[i] = (i == 0) ? LL : cc;
        }
#endif
}

#undef IN
#undef SEAM
#undef XB0
#undef XB1
#undef SS0
#undef HID
#undef wl
}

extern "C" void kernel_launch(void* const* d_in, const int* in_sizes, int n_in, void* d_out, int out_size, void* d_ws, size_t ws_size, hipStream_t stream) {
    static int grid = 0;
    if (grid == 0) {
        if (n_in != 33 || out_size != MTOK * DM || ws_size < WS_END) { fprintf(stderr, "kernel_launch: unexpected shapes (n_in %d out %d ws %zu need %zu)\n", n_in, out_size, ws_size, (size_t)WS_END); grid = -1; return; }
        int dev = 0, cus = 0, per_cu = 0;
        if (hipGetDevice(&dev) != hipSuccess || hipDeviceGetAttribute(&cus, hipDeviceAttributeMultiprocessorCount, dev) != hipSuccess) { grid = -1; return; }
        if (hipFuncSetAttribute((const void*)fwd, hipFuncAttributeMaxDynamicSharedMemorySize, LDS_BYTES) != hipSuccess) { grid = -1; return; }
        if (hipOccupancyMaxActiveBlocksPerMultiprocessor(&per_cu, (const void*)fwd, 512, LDS_BYTES) != hipSuccess || per_cu < 1) { fprintf(stderr, "kernel_launch: occupancy query says %d\n", per_cu); }
        (void)hipGetLastError();
        grid = cus;
    }
    if (grid < 0) return;
    (void)hipMemsetAsync((char*)d_ws + WS_CTL, 0, CTL_BYTES, stream);
    Args a{};
    for (int i = 0; i < 33; ++i) a.in[i] = d_in[i];
    a.out = (float*)d_out; a.ws = (unsigned char*)d_ws;
    int li = 0;
    for (int p = 0; p < NPH; p += PH_STEP, ++li) {
        a.ph_lo = p; a.ph_hi = (p + PH_STEP < NPH) ? p + PH_STEP : NPH; a.li = li; a.use_bar = (a.ph_hi - a.ph_lo > 1) ? 1 : 0;
        hipLaunchKernelGGL(fwd, dim3(grid), dim3(512), LDS_BYTES, stream, a);
    }
}
static_assert(att::SHM_ATTN <= MISC_OFF && PTAB_OFF + 33 * 8 <= LDS_BYTES && MISC_OFF + 64 <= PTAB_OFF, "LDS map");
```
